# Optimizing an MI355X kernel written in HIP

```python
import jax, jax.numpy as jnp
from jax import lax
import numpy as np

D_MODEL = 1024
BATCH = 4
SEQ = 4096
DEPTH = 2

GRID_W = 64
HEAD_DIM = 64
NA_HEADS = (D_MODEL // 2) // HEAD_DIM
GQA_Q_HEADS = (D_MODEL // 2) // HEAD_DIM
GQA_KV_HEADS = GQA_Q_HEADS // 4
NA_KH_MAX = 8
NA_KW = 16
ROPE_THETA = 10000.0
Q_BLOCK = 128
NA_WIDTH = NA_HEADS * HEAD_DIM
GQA_WIDTH = GQA_Q_HEADS * HEAD_DIM
KV_WIDTH = GQA_KV_HEADS * HEAD_DIM
MIX_WIDTH = NA_WIDTH + GQA_WIDTH
IN_SPLITS = [NA_WIDTH, NA_WIDTH, NA_WIDTH, GQA_WIDTH, KV_WIDTH, KV_WIDTH]
IN_WIDTH = sum(IN_SPLITS)
IN_SPLIT_POINTS = [int(p) for p in np.cumsum(IN_SPLITS)[:-1]]
MEM_LEN = 256
MEM_HEADS = 4
MEM_HEAD_DIM = 128
MEM_WIDTH = MEM_HEADS * MEM_HEAD_DIM
D_FF = ((8 * D_MODEL // 3 + 127) // 128) * 128
CONV_W = 3
EPS = 1e-6
NEG_INF = -1e30

kernel_name = "hybrid_na_gqa_memxattn_convffn_encoder"


def rms_norm(x, g):
    x32 = x.astype(jnp.float32)
    y = x32 * lax.rsqrt(jnp.mean(x32 * x32, axis=-1, keepdims=True) + EPS)
    return (y * g.astype(jnp.float32)).astype(x.dtype)


def rope_tables(s):
    t = jnp.arange(s)
    pos = jnp.stack([t // GRID_W, t % GRID_W], axis=-1).astype(jnp.float32)
    n_f = HEAD_DIM // 4
    inv_freq = ROPE_THETA ** (-jnp.arange(n_f, dtype=jnp.float32) / n_f)
    ang = pos[:, :, None] * inv_freq
    return jnp.cos(ang), jnp.sin(ang)


def apply_axial_rope(x, cos, sin):
    b, s, h, dh = x.shape
    xr = x.astype(jnp.float32).reshape(b, s, h, 2, 2, dh // 4)
    x1, x2 = xr[..., 0, :], xr[..., 1, :]
    c = cos[None, :, None]
    sn = sin[None, :, None]
    out = jnp.stack([x1 * c - x2 * sn, x1 * sn + x2 * c], axis=-2)
    return out.reshape(b, s, h, dh).astype(x.dtype)


def neighbourhood_attention(q, k, v, rpb, rows):
    b, s, h, dh = q.shape
    kh = min(NA_KH_MAX, rows)
    q = q.reshape(b, rows, GRID_W, h, dh)
    k = k.reshape(b, rows, GRID_W, h, dh)
    v = v.reshape(b, rows, GRID_W, h, dh)
    r = jnp.arange(rows)
    row_start = jnp.clip(r - kh // 2, 0, rows - kh)
    row_idx = row_start[:, None] + jnp.arange(kh)[None, :]
    k_rows = k[:, row_idx]
    v_rows = v[:, row_idx]
    scores = jnp.einsum('brqhd,brikhd->bhrqik', q, k_rows,
                        preferred_element_type=jnp.float32) * (dh ** -0.5)
    c = jnp.arange(GRID_W)
    col_start = jnp.clip(c - NA_KW // 2, 0, GRID_W - NA_KW)
    col_valid = (c[None, :] >= col_start[:, None]) & (c[None, :] < col_start[:, None] + NA_KW)
    row_off = row_idx - r[:, None] + (NA_KH_MAX - 1)
    col_off = jnp.clip(c[None, :] - c[:, None], -(NA_KW - 1), NA_KW - 1) + (NA_KW - 1)
    bias = rpb[:, row_off[:, None, :, None], col_off[None, :, None, :]]
    scores = scores + bias[None].astype(jnp.float32)
    scores = jnp.where(col_valid[None, None, None, :, None, :], scores, NEG_INF)
    p = jax.nn.softmax(scores, axis=(-2, -1))
    o = jnp.einsum('bhrqik,brikhd->brqhd', p.astype(v.dtype), v_rows)
    return o.reshape(b, s, h * dh)


def gqa_block_attention(q, k, v):
    b, s, hq, dh = q.shape
    hkv = k.shape[2]
    g = hq // hkv
    nblk = s // Q_BLOCK
    qb = q.reshape(b, nblk, Q_BLOCK, hkv, g, dh).transpose(1, 0, 2, 3, 4, 5)
    scale = dh ** -0.5

    def one_block(qi):
        sc = jnp.einsum('bqkgd,bskd->bkgqs', qi, k, preferred_element_type=jnp.float32) * scale
        p = jax.nn.softmax(sc, axis=-1)
        return jnp.einsum('bkgqs,bskd->bqkgd', p.astype(v.dtype), v)

    o = lax.map(one_block, qb)
    return o.transpose(1, 0, 2, 3, 4, 5).reshape(b, s, hq * dh)


def hybrid_mixer(h, w_in, rpb, q_norm, k_norm, w_out, rows, cos, sin):
    b, s, _ = h.shape
    proj = h @ w_in
    na_q, na_k, na_v, g_q, g_k, g_v = jnp.split(proj, IN_SPLIT_POINTS, axis=-1)
    na_shape = (b, s, NA_HEADS, HEAD_DIM)
    na_out = neighbourhood_attention(na_q.reshape(na_shape), na_k.reshape(na_shape),
                                     na_v.reshape(na_shape), rpb, rows)
    g_q = apply_axial_rope(rms_norm(g_q.reshape(b, s, GQA_Q_HEADS, HEAD_DIM), q_norm), cos, sin)
    g_k = apply_axial_rope(rms_norm(g_k.reshape(b, s, GQA_KV_HEADS, HEAD_DIM), k_norm), cos, sin)
    g_v = g_v.reshape(b, s, GQA_KV_HEADS, HEAD_DIM)
    gqa_out = gqa_block_attention(g_q, g_k, g_v)
    return jnp.concatenate([na_out, gqa_out], axis=-1) @ w_out


def memory_cross_attention(h, mem_n, w_q, w_kv, w_o):
    b, s, _ = h.shape
    m = mem_n.shape[1]
    q = (h @ w_q).reshape(b, s, MEM_HEADS, MEM_HEAD_DIM)
    kv = (mem_n @ w_kv).reshape(b, m, 2, MEM_HEADS, MEM_HEAD_DIM)
    k, v = kv[:, :, 0], kv[:, :, 1]
    sc = jnp.einsum('bqhd,bmhd->bhqm', q, k, preferred_element_type=jnp.float32) * (MEM_HEAD_DIM ** -0.5)
    p = jax.nn.softmax(sc, axis=-1)
    o = jnp.einsum('bhqm,bmhd->bqhd', p.astype(v.dtype), v).reshape(b, s, MEM_WIDTH)
    return o @ w_o


def conv_ffn(h, w_up, conv_w, conv_b, w_down):
    u = h @ w_up
    up = jnp.pad(u, ((0, 0), (1, 1), (0, 0)))
    u = up[:, :-2] * conv_w[0] + up[:, 1:-1] * conv_w[1] + up[:, 2:] * conv_w[2] + conv_b
    gate, val = jnp.split(u, 2, axis=-1)
    return (jax.nn.silu(gate) * val) @ w_down


def setup_inputs(seed: int = 0) -> dict:
    key = jax.random.key(seed)
    ks = jax.random.split(key, 24)
    f32 = jnp.float32

    def normal(k, shape, scale):
        return jax.random.normal(k, shape, f32) * scale

    def gain(k, shape):
        return 1.0 + 0.02 * jax.random.normal(k, shape, f32)

    L = DEPTH
    return {
        "x": normal(ks[0], (BATCH, SEQ, D_MODEL), 1.0),
        "mem": normal(ks[1], (BATCH, MEM_LEN, D_MODEL), 1.0),
        "norm_mix": gain(ks[2], (L, D_MODEL)),
        "w_in": normal(ks[3], (L, D_MODEL, IN_WIDTH), D_MODEL ** -0.5),
        "na_rpb": normal(ks[4], (L, NA_HEADS, 2 * NA_KH_MAX - 1, 2 * NA_KW - 1), 0.1),
        "gqa_q_norm": gain(ks[5], (L, HEAD_DIM)),
        "gqa_k_norm": gain(ks[6], (L, HEAD_DIM)),
        "w_out": normal(ks[7], (L, MIX_WIDTH, D_MODEL), MIX_WIDTH ** -0.5),
        "norm_mem_q": gain(ks[8], (L, D_MODEL)),
        "norm_mem_kv": gain(ks[9], (L, D_MODEL)),
        "w_mem_q": normal(ks[10], (L, D_MODEL, MEM_WIDTH), D_MODEL ** -0.5),
        "w_mem_kv": normal(ks[11], (L, D_MODEL, 2 * MEM_WIDTH), D_MODEL ** -0.5),
        "w_mem_o": normal(ks[12], (L, MEM_WIDTH, D_MODEL), MEM_WIDTH ** -0.5),
        "norm_ffn": gain(ks[13], (L, D_MODEL)),
        "w_up": normal(ks[14], (L, D_MODEL, 2 * D_FF), D_MODEL ** -0.5),
        "conv_w": normal(ks[15], (L, CONV_W, 2 * D_FF), CONV_W ** -0.5),
        "conv_b": normal(ks[16], (L, 2 * D_FF), 0.02),
        "w_down": normal(ks[17], (L, D_FF, D_MODEL), D_FF ** -0.5),
        "norm_final": gain(ks[18], (D_MODEL,)),
    }


def reference(x, mem, norm_mix, w_in, na_rpb, gqa_q_norm, gqa_k_norm, w_out,
              norm_mem_q, norm_mem_kv, w_mem_q, w_mem_kv, w_mem_o,
              norm_ffn, w_up, conv_w, conv_b, w_down, norm_final):
    s = x.shape[1]
    rows = s // GRID_W
    cos, sin = rope_tables(s)
    for l in range(DEPTH):
        x = x + hybrid_mixer(rms_norm(x, norm_mix[l]), w_in[l], na_rpb[l],
                             gqa_q_norm[l], gqa_k_norm[l], w_out[l], rows, cos, sin)
        x = x + memory_cross_attention(rms_norm(x, norm_mem_q[l]), rms_norm(mem, norm_mem_kv[l]),
                                       w_mem_q[l], w_mem_kv[l], w_mem_o[l])
        x = x + conv_ffn(rms_norm(x, norm_ffn[l]), w_up[l], conv_w[l], conv_b[l], w_down[l])
    return rms_norm(x, norm_final)
```

```cpp
#include <hip/hip_runtime.h>
#include <hip/hip_bf16.h>
#include <cstdio>
#include <cstdint>
namespace pg8 {
#define PG8_LAS __attribute__((address_space(3)))
typedef unsigned short bf16_t;
typedef short bf16x8 __attribute__((ext_vector_type(8)));
typedef float f32x4 __attribute__((ext_vector_type(4)));
typedef unsigned u32x4 __attribute__((ext_vector_type(4)));
constexpr int BM = 256, BK = 64, HALF = 128, HTB = HALF * BK * 2  , STAGE_BYTES = 8 * HTB, NXCD = 8, WGM = 8;

__host__ __device__ __forceinline__ int lds_byte(int r, int c) { const int st = (r >> 4) * 2 + (c >> 5), rr = r & 15, cc = c & 31, ob = rr * 64 + cc * 2; return st * 1024 + (ob ^ (((ob >> 9) & 1) << 5)); }
__host__ __device__ __forceinline__ void stage_rc(int b, int& R, int& C) { const int st = b / 1024, sb = b % 1024, swz = sb ^ (((sb >> 9) & 1) << 5); R = (st >> 1) * 16 + swz / 64; C = (st & 1) * 32 + (swz % 64) / 2; }
__host__ __device__ __forceinline__ int perm32(int rho) { const int n = rho >> 4, i = rho & 15; return 8 * (i >> 2) + 4 * n + (i & 3); }

struct Unit { int pm, pn; };
struct Gemm { const bf16_t* A; const bf16_t* Bt; int M, N, K; };

struct StaticOrder {
    int nM, nN, nwg, G, c;
    __host__ __device__ void init(int M, int N, int G_, int c_) { nM = M / BM; nN = N / BM; nwg = nM * nN; G = G_; c = c_; }
    __host__ __device__ bool next(int i, Unit& u) const {
        const long L = (long)i * G + c; if (L >= nwg) return false;
        int wgid = (int)L; { const int q = nwg / NXCD, r = nwg % NXCD, xcd = wgid % NXCD, off = wgid / NXCD; wgid = (xcd < r ? xcd * (q + 1) : r * (q + 1) + (xcd - r) * q) + off; }
        const int nig = WGM * nN, gid = wgid / nig, fm = gid * WGM, gsz = (nM - fm) < WGM ? (nM - fm) : WGM;
        u.pm = fm + ((wgid % nig) % gsz); u.pn = (wgid % nig) / gsz; return true;
    }
    __device__ __forceinline__ void a_ready(const Unit&) const {}
    __device__ __forceinline__ void done(const Unit&) const {}
};

__device__ __forceinline__ unsigned cvt_pk_bf16(float lo, float hi) { unsigned r; asm volatile("v_cvt_pk_bf16_f32 %0, %1, %2" : "=v"(r) : "v"(lo), "v"(hi)); return r; }
typedef float f32x2 __attribute__((ext_vector_type(2)));
typedef unsigned u32x2 __attribute__((ext_vector_type(2)));
__device__ __forceinline__ float row_rs(const float* SS, int row, int fq) {
    const f32x4 v = *(const f32x4*)(SS + (size_t)row * 16 + fq * 4);
    float s = (v[0] + v[1]) + (v[2] + v[3]);
    s += __shfl_xor(s, 16); s += __shfl_xor(s, 32);
    return __builtin_amdgcn_rsqf(s * (1.0f / 1024.0f) + 1e-6f);
}
struct EpiSB {
    static constexpr bool PERM = true, AFTER_DRAIN = false;
    bf16_t* O; int ldc; const float* SS; int split_cols; size_t split_stride; float scale0;
    __device__ __forceinline__ void operator()(const f32x4 (&acc)[2][2][4][2], const Unit& u, int wr, int wc, int fr, int fq) const {
        const int row0 = u.pm * BM + wr * 64 + fr; int colt = u.pn * BM; bf16_t* base = O;
        float sc = 1.f; if (split_cols) { const int t = colt / split_cols; base += (size_t)t * split_stride; colt -= t * split_cols; if (t == 0) sc = scale0; }
        const int col0 = colt + wc * 32 + 8 * fq;
#pragma unroll
        for (int ai = 0; ai < 2; ++ai)
#pragma unroll
            for (int m = 0; m < 4; ++m) { const int row = row0 + ai * HALF + m * 16; const float rs = SS ? row_rs(SS, row, fq) * sc : sc;
                bf16_t* rowp = base + (size_t)row * ldc + col0;
#pragma unroll
                for (int bj = 0; bj < 2; ++bj) { const f32x4 v0 = acc[ai][bj][m][0] * rs, v1 = acc[ai][bj][m][1] * rs;
                    u32x4 w; w.x = cvt_pk_bf16(v0[0], v0[1]); w.y = cvt_pk_bf16(v0[2], v0[3]); w.z = cvt_pk_bf16(v1[0], v1[1]); w.w = cvt_pk_bf16(v1[2], v1[3]);
                    *(u32x4*)(rowp + bj * HALF) = w; } }
    }
};
struct EpiRes {
    static constexpr bool PERM = true, AFTER_DRAIN = false;
    const float* xold; float* xnew; bf16_t* xb; float* SSo;
    __device__ __forceinline__ void operator()(const f32x4 (&acc)[2][2][4][2], const Unit& u, int wr, int wc, int fr, int fq) const {
        const int row0 = u.pm * BM + wr * 64 + fr, col0 = u.pn * BM + wc * 32 + 8 * fq;
#pragma unroll
        for (int ai = 0; ai < 2; ++ai)
#pragma unroll
            for (int m = 0; m < 4; ++m) { const int row = row0 + ai * HALF + m * 16; const size_t off = (size_t)row * 1024 + col0; float ssq = 0.f;
#pragma unroll
                for (int bj = 0; bj < 2; ++bj) {
                    const f32x4 a0 = *(const f32x4*)(xold + off + bj * HALF), a1 = *(const f32x4*)(xold + off + bj * HALF + 4);
                    const f32x4 v0 = a0 + acc[ai][bj][m][0], v1 = a1 + acc[ai][bj][m][1];
                    *(f32x4*)(xnew + off + bj * HALF) = v0; *(f32x4*)(xnew + off + bj * HALF + 4) = v1;
                    u32x4 w; w.x = cvt_pk_bf16(v0[0], v0[1]); w.y = cvt_pk_bf16(v0[2], v0[3]); w.z = cvt_pk_bf16(v1[0], v1[1]); w.w = cvt_pk_bf16(v1[2], v1[3]);
                    *(u32x4*)(xb + off + bj * HALF) = w;
                    ssq += (v0[0] * v0[0] + v0[1] * v0[1]) + (v0[2] * v0[2] + v0[3] * v0[3]) + (v1[0] * v1[0] + v1[1] * v1[1]) + (v1[2] * v1[2] + v1[3] * v1[3]); }
                ssq += __shfl_xor(ssq, 16); ssq += __shfl_xor(ssq, 32);
                if (fq == 0) SSo[(size_t)row * 16 + u.pn * 4 + wc] = ssq; }
    }
};
struct EpiInProj {
    static constexpr bool PERM = true, AFTER_DRAIN = false;
    const float* SS; bf16_t* NQKV; size_t nstride; bf16_t* GQ; bf16_t* GK; bf16_t* GV; const float* rope; const float* qn; const float* kn; float qs_na, qs_g;
    __device__ __forceinline__ void operator()(const f32x4 (&acc)[2][2][4][2], const Unit& u, int wr, int wc, int fr, int fq) const {
        const int row0 = u.pm * BM + wr * 64 + fr;
        if (u.pn < 6) {
            bf16_t* base = NQKV + (size_t)(u.pn >> 1) * nstride; const int col0 = (u.pn & 1) * 256 + wc * 32 + 8 * fq; const float sc = u.pn < 2 ? qs_na : 1.f;
#pragma unroll
            for (int ai = 0; ai < 2; ++ai)
#pragma unroll
                for (int m = 0; m < 4; ++m) { const int row = row0 + ai * HALF + m * 16; const float rs = row_rs(SS, row, fq) * sc;
                    bf16_t* rowp = base + (size_t)row * 512 + col0;
#pragma unroll
                    for (int bj = 0; bj < 2; ++bj) { const f32x4 v0 = acc[ai][bj][m][0] * rs, v1 = acc[ai][bj][m][1] * rs;
                        u32x4 w; w.x = cvt_pk_bf16(v0[0], v0[1]); w.y = cvt_pk_bf16(v0[2], v0[3]); w.z = cvt_pk_bf16(v1[0], v1[1]); w.w = cvt_pk_bf16(v1[2], v1[3]);
                        *(u32x4*)(rowp + bj * HALF) = w; } }
            return;
        }
        const bool isq = u.pn < 8, isv = (u.pn == 8) && (wc >= 2);
        bf16_t* dst; int ld; const float* gain; float post;
        if (isq) { dst = GQ + (4 * (u.pn - 6) + wc) * 64; ld = 512; gain = qn; post = qs_g; }
        else if (!isv) { dst = GK + wc * 64; ld = 128; gain = kn; post = 1.f; }
        else { dst = GV + (wc - 2) * 64; ld = 128; gain = kn; post = 1.f; }
        f32x4 g[2][2];
#pragma unroll
        for (int bj = 0; bj < 2; ++bj)
#pragma unroll
            for (int n = 0; n < 2; ++n) g[bj][n] = *(const f32x4*)(gain + 32 * bj + 16 * n + 4 * fq) * post;
#pragma unroll
        for (int ai = 0; ai < 2; ++ai)
#pragma unroll
            for (int m = 0; m < 4; ++m) { const int row = row0 + ai * HALF + m * 16; const float rs = row_rs(SS, row, fq);
                f32x4 v[2][2]; float ssq = 0.f;
#pragma unroll
                for (int bj = 0; bj < 2; ++bj)
#pragma unroll
                    for (int n = 0; n < 2; ++n) { v[bj][n] = acc[ai][bj][m][n] * rs; const f32x4 x = v[bj][n]; ssq += (x[0] * x[0] + x[1] * x[1]) + (x[2] * x[2] + x[3] * x[3]); }
                bf16_t* rowp = dst + (size_t)row * ld;
                if (!isv) {
                    ssq += __shfl_xor(ssq, 16); ssq += __shfl_xor(ssq, 32);
                    const float inv = __builtin_amdgcn_rsqf(ssq * (1.0f / 64.0f) + 1e-6f);
                    const int pos0 = (row & 4095) >> 6, pos1 = row & 63;
#pragma unroll
                    for (int bj = 0; bj < 2; ++bj) { const int pos = bj == 0 ? pos0 : pos1;
                        const f32x4 c = *(const f32x4*)(rope + pos * 32 + 4 * fq), s = *(const f32x4*)(rope + pos * 32 + 16 + 4 * fq);
                        const f32x4 x1 = v[bj][0] * inv * g[bj][0], x2 = v[bj][1] * inv * g[bj][1];
                        v[bj][0] = x1 * c - x2 * s; v[bj][1] = x1 * s + x2 * c; }
                }
#pragma unroll
                for (int bj = 0; bj < 2; ++bj)
#pragma unroll
                    for (int n = 0; n < 2; ++n) { u32x2 w; w.x = cvt_pk_bf16(v[bj][n][0], v[bj][n][1]); w.y = cvt_pk_bf16(v[bj][n][2], v[bj][n][3]);
                        *(u32x2*)(rowp + 32 * bj + 16 * n + 4 * fq) = w; } }
    }
};

template <class Epi, class Sched, bool ALIGN_EPI = false, bool SP2 = false>
__device__ __forceinline__ void gemm_phase(PG8_LAS unsigned char* lds, const Gemm g, const Sched& S, const Epi& E) {
    int tid_ = threadIdx.x; asm volatile("" : "+v"(tid_));
    const int tid = tid_, wid = __builtin_amdgcn_readfirstlane(tid >> 6), lane = tid & 63, wr = wid >> 2, wc = wid & 3, fr = lane & 15, fq = lane >> 4;
    const int K = g.K, nt = K / BK;
    unsigned voffA[2], voffB[2];
#pragma unroll
    for (int i = 0; i < 2; ++i) { int R, C; stage_rc(tid * 16 + i * 8192, R, C); const int Rb = Epi::PERM ? ((R & ~31) + perm32(R & 31)) : R;
        voffA[i] = (unsigned)(R * K + C) * 2u; voffB[i] = (unsigned)(Rb * K + C) * 2u; }
    const size_t kstep = (size_t)(BK * 2);
    const size_t hstep = (size_t)HALF * K * 2;
    const size_t tstep = 2 * hstep;
    const unsigned ldsw = (unsigned)wid * 1024u;
    const int aoff = lds_byte(wr * 64 + fr, fq * 8), boff = lds_byte(wc * 32 + fr, fq * 8);
#define PG8_SA(b, h) (((b) * 2 + (h)) * HTB)
#define PG8_SB(b, h) ((4 + (b) * 2 + (h)) * HTB)
#define PG8_STAGE(bufoff, gbase, voff) do { _Pragma("unroll") for (int _i = 0; _i < 2; ++_i) \
        __builtin_amdgcn_global_load_lds((const unsigned*)((const char*)(gbase) + (voff)[_i]), (PG8_LAS unsigned*)(lds + (bufoff) + ldsw + _i * 8192), 16, 0, 0); } while (0)
#define PG8_LDA(dst, b, h) do { _Pragma("unroll") for (int m = 0; m < 4; ++m) _Pragma("unroll") for (int k = 0; k < 2; ++k) dst[m][k] = *(const PG8_LAS bf16x8*)(lds + PG8_SA(b, h) + aoff + m * 2048 + k * 1024); } while (0)
#define PG8_LDB(dst, b, h) do { _Pragma("unroll") for (int n = 0; n < 2; ++n) _Pragma("unroll") for (int k = 0; k < 2; ++k) dst[n][k] = *(const PG8_LAS bf16x8*)(lds + PG8_SB(b, h) + boff + n * 2048 + k * 1024); } while (0)
#define PG8_MMA(ai, bj, At, Bt) do { __builtin_amdgcn_s_setprio(1); _Pragma("unroll") for (int m = 0; m < 4; ++m) _Pragma("unroll") for (int n = 0; n < 2; ++n) _Pragma("unroll") for (int k = 0; k < 2; ++k) \
        acc[ai][bj][m][n] = __builtin_amdgcn_mfma_f32_16x16x32_bf16(Bt[n][k], At[m][k], acc[ai][bj][m][n], 0, 0, 0); __builtin_amdgcn_s_setprio(0); } while (0)
#define PG8_WAIT_V(n) asm volatile("s_waitcnt vmcnt(" #n ")" ::: "memory")
#define PG8_WAIT_L(n) asm volatile("s_waitcnt lgkmcnt(" #n ")" ::: "memory")
#define PG8_BAR __builtin_amdgcn_s_barrier()
#define PG8_SCHED __builtin_amdgcn_sched_barrier(0)
    Unit cur, nxt; int ui = 0;
    if (!S.next(0, cur)) return;
    f32x4 acc[2][2][4][2];
#pragma unroll
    for (int a = 0; a < 2; ++a)
#pragma unroll
        for (int b = 0; b < 2; ++b)
#pragma unroll
            for (int m = 0; m < 4; ++m)
#pragma unroll
                for (int n = 0; n < 2; ++n) acc[a][b][m][n] = (f32x4){0.f, 0.f, 0.f, 0.f};
    bf16x8 At[4][2], B0[2][2], B1[2][2];
    const char* cA = (const char*)g.A + (size_t)cur.pm * tstep; const char* cB = (const char*)g.Bt + (size_t)cur.pn * tstep;
    S.a_ready(cur);
    if constexpr (SP2) {
        PG8_STAGE(PG8_SB(0, 0), cB, voffB); PG8_STAGE(PG8_SB(0, 1), cB + hstep, voffB); PG8_STAGE(PG8_SA(0, 0), cA, voffA); PG8_STAGE(PG8_SA(0, 1), cA + hstep, voffA);
        if (wr == 1) PG8_BAR;
        PG8_WAIT_V(2); PG8_BAR;
        PG8_STAGE(PG8_SB(1, 0), cB + kstep, voffB); PG8_STAGE(PG8_SA(1, 0), cA + kstep, voffA); PG8_STAGE(PG8_SB(1, 1), cB + hstep + kstep, voffB);
        PG8_WAIT_V(6); PG8_BAR;
    } else {
        PG8_STAGE(PG8_SB(0, 0), cB, voffB); PG8_STAGE(PG8_SA(0, 0), cA, voffA); PG8_STAGE(PG8_SB(0, 1), cB + hstep, voffB); PG8_STAGE(PG8_SA(0, 1), cA + hstep, voffA);
        if (wr == 1) PG8_BAR;
        PG8_WAIT_V(4); PG8_BAR;
        PG8_STAGE(PG8_SB(1, 0), cB + kstep, voffB); PG8_STAGE(PG8_SA(1, 0), cA + kstep, voffA); PG8_STAGE(PG8_SB(1, 1), cB + hstep + kstep, voffB);
        PG8_WAIT_V(6); PG8_BAR;
    }
    for (;;) {
        const bool has_next = S.next(ui + 1, nxt);
        const char* nA = has_next ? (const char*)g.A + (size_t)nxt.pm * tstep : cA; const char* nB = has_next ? (const char*)g.Bt + (size_t)nxt.pn * tstep : cB;
        for (int t = 0; t < nt; t += 2) {
            const bool last = (t == nt - 2);
            const char* a1 = cA + (size_t)(t + 1) * kstep;
            const char* a2 = last ? nA : cA + (size_t)(t + 2) * kstep; const char* b2 = last ? nB : cB + (size_t)(t + 2) * kstep;
            const char* a3 = a2 + kstep; const char* b3 = b2 + kstep;
            if (last && has_next) S.a_ready(nxt);
            if constexpr (SP2) {
            PG8_LDB(B0, 0, 0); PG8_LDB(B1, 0, 1); PG8_SCHED; PG8_LDA(At, 0, 0); PG8_STAGE(PG8_SA(1, 1), a1 + hstep, voffA);
            PG8_WAIT_V(8); PG8_WAIT_L(0); PG8_BAR; PG8_MMA(0, 0, At, B0); PG8_MMA(0, 1, At, B1); PG8_BAR; PG8_SCHED;
            PG8_LDA(At, 0, 1); PG8_STAGE(PG8_SB(0, 0), b2, voffB); PG8_STAGE(PG8_SB(0, 1), b2 + hstep, voffB); PG8_STAGE(PG8_SA(0, 0), a2, voffA);
            PG8_WAIT_V(8); PG8_WAIT_L(0); PG8_BAR; PG8_MMA(1, 0, At, B0); PG8_MMA(1, 1, At, B1); PG8_BAR; PG8_SCHED;
            PG8_LDB(B0, 1, 0); PG8_LDB(B1, 1, 1); PG8_SCHED; PG8_LDA(At, 1, 0); PG8_STAGE(PG8_SA(0, 1), a2 + hstep, voffA);
            PG8_WAIT_V(8); PG8_WAIT_L(0); PG8_BAR; PG8_MMA(0, 0, At, B0); PG8_MMA(0, 1, At, B1); PG8_BAR; PG8_SCHED;
            PG8_LDA(At, 1, 1); PG8_STAGE(PG8_SB(1, 0), b3, voffB); PG8_STAGE(PG8_SB(1, 1), b3 + hstep, voffB); PG8_STAGE(PG8_SA(1, 0), a3, voffA);
            PG8_WAIT_V(8); PG8_WAIT_L(0); PG8_BAR; PG8_MMA(1, 0, At, B0); PG8_MMA(1, 1, At, B1); PG8_BAR; PG8_SCHED;
            } else {
            PG8_LDB(B0, 0, 0); PG8_SCHED; PG8_LDA(At, 0, 0); PG8_STAGE(PG8_SA(1, 1), a1 + hstep, voffA);
            PG8_WAIT_L(8); PG8_BAR; PG8_WAIT_L(0); PG8_MMA(0, 0, At, B0); PG8_BAR; PG8_SCHED;
            PG8_LDB(B1, 0, 1); PG8_STAGE(PG8_SB(0, 0), b2, voffB);
            PG8_BAR; PG8_WAIT_L(0); PG8_MMA(0, 1, At, B1); PG8_BAR;
            PG8_LDA(At, 0, 1); PG8_STAGE(PG8_SA(0, 0), a2, voffA);
            PG8_BAR; PG8_WAIT_L(0); PG8_MMA(1, 0, At, B0); PG8_BAR; PG8_SCHED;
            PG8_STAGE(PG8_SB(0, 1), b2 + hstep, voffB);
            PG8_WAIT_V(6); PG8_BAR; PG8_MMA(1, 1, At, B1); PG8_BAR;
            PG8_LDB(B0, 1, 0); PG8_SCHED; PG8_LDA(At, 1, 0); PG8_STAGE(PG8_SA(0, 1), a2 + hstep, voffA);
            PG8_WAIT_L(8); PG8_BAR; PG8_WAIT_L(0); PG8_MMA(0, 0, At, B0); PG8_BAR; PG8_SCHED;
            PG8_LDB(B1, 1, 1); PG8_STAGE(PG8_SB(1, 0), b3, voffB);
            PG8_BAR; PG8_WAIT_L(0); PG8_MMA(0, 1, At, B1); PG8_BAR;
            PG8_LDA(At, 1, 1); PG8_STAGE(PG8_SA(1, 0), a3, voffA);
            PG8_BAR; PG8_WAIT_L(0); PG8_MMA(1, 0, At, B0); PG8_BAR; PG8_SCHED;
            PG8_STAGE(PG8_SB(1, 1), b3 + hstep, voffB);
            PG8_WAIT_V(6); PG8_BAR; PG8_MMA(1, 1, At, B1); PG8_BAR;
            }
        }
        if constexpr (ALIGN_EPI) { if (wr == 0) PG8_BAR; }
        if constexpr (!Epi::AFTER_DRAIN) { E(acc, cur, wr, wc, fr, fq); S.done(cur); }
        if (!has_next) break;
#pragma unroll
        for (int a = 0; a < 2; ++a)
#pragma unroll
            for (int b = 0; b < 2; ++b)
#pragma unroll
                for (int m = 0; m < 4; ++m)
#pragma unroll
                    for (int n = 0; n < 2; ++n) acc[a][b][m][n] = (f32x4){0.f, 0.f, 0.f, 0.f};
        cur = nxt; cA = nA; cB = nB; ++ui;
        if constexpr (ALIGN_EPI) { if (wr == 1) PG8_BAR; }
    }
    PG8_WAIT_V(0);
    if constexpr (!ALIGN_EPI) { if (wr == 0) PG8_BAR; }
    PG8_BAR;
    if constexpr (Epi::AFTER_DRAIN) { E.fused(acc, cur, wr, wc, fr, fq, lds, wid, lane); S.done(cur); }
#undef PG8_SA
#undef PG8_SB
#undef PG8_STAGE
#undef PG8_LDA
#undef PG8_LDB
#undef PG8_MMA
#undef PG8_WAIT_V
#undef PG8_WAIT_L
#undef PG8_BAR
#undef PG8_SCHED
}
}
#define GAS __attribute__((address_space(1)))
#define LAS __attribute__((address_space(3)))
typedef unsigned short bf16;
typedef unsigned v4u __attribute__((ext_vector_type(4)));
typedef float f32x4 __attribute__((ext_vector_type(4)));
typedef short bf16x8 __attribute__((ext_vector_type(8)));
typedef GAS unsigned gu32;
typedef GAS unsigned long long gu64;
#define RLX_AGENT __ATOMIC_RELAXED, __HIP_MEMORY_SCOPE_AGENT
#define LDS_WAIT() asm volatile("s_waitcnt lgkmcnt(0)" ::: "memory")
#define VM_WAIT() asm volatile("s_waitcnt vmcnt(0)" ::: "memory")
__device__ __forceinline__ unsigned long long rt() { return __builtin_amdgcn_s_memrealtime(); }
__device__ __forceinline__ unsigned f2bf(float f) { unsigned u = __builtin_bit_cast(unsigned, f); return (u + 0x7fffu + ((u >> 16) & 1u)) >> 16; }
__device__ __forceinline__ unsigned pk2(float lo, float hi) { return f2bf(lo) | (f2bf(hi) << 16); }

#define XB_TMO      128
#define XB_XCNT(j)  (256  + 64 * (j))
#define XB_XSUB(j)  (1280 + 64 * (j))
#define XB_XGEN(j)  (2304 + 64 * (j))
#define XB_TOP      3328
#define XB_TOPGEN   3392
#define XCD_BAR_WORDS 3456
#define XB_SPIN_CAP (1u << 18)

__device__ __forceinline__ unsigned xb_ld(unsigned* p)              { return __hip_atomic_load(p, __ATOMIC_RELAXED, __HIP_MEMORY_SCOPE_AGENT); }
__device__ __forceinline__ unsigned xb_add(unsigned* p, unsigned v) { return __hip_atomic_fetch_add(p, v, __ATOMIC_RELAXED, __HIP_MEMORY_SCOPE_AGENT); }
__device__ __forceinline__ unsigned xb_xcc_id() { return (unsigned)__builtin_amdgcn_s_getreg((3 << 11) | 20) & 0xFu; }
#define XB_SPIN(cond, bar) do { unsigned _sp = 0; while (cond) { __builtin_amdgcn_s_sleep(1); \
    if ((++_sp & 255u) == 0u) { if (xb_ld(&(bar)[XB_TMO])) break; if (_sp > XB_SPIN_CAP) { atomicAdd(&(bar)[XB_TMO], 1u); break; } } } } while (0)

struct XcdBarrier {
    unsigned* bar; unsigned x;
    volatile LAS unsigned* st;
};

__device__ __forceinline__ XcdBarrier xcd_barrier_post(unsigned* bar, volatile LAS unsigned* st) {
    XcdBarrier b; b.bar = bar; b.x = xb_xcc_id(); b.st = st;
    if (threadIdx.x == 0) (void)xb_add(&bar[XB_XCNT(b.x)], 1u);
    return b;
}
__device__ __forceinline__ void xcd_barrier_complete(unsigned* bar, unsigned x, unsigned& nloc, unsigned& nx) {
    const unsigned G = gridDim.x * gridDim.y * gridDim.z;
    unsigned sum, cnt, mine, sp = 0u;
    for (;;) {
        sum = 0u; cnt = 0u; mine = 0u;
#pragma unroll
        for (unsigned j = 0; j < 16; ++j) { const unsigned c = xb_ld(&bar[XB_XCNT(j)]); sum += c; cnt += (c > 0u) ? 1u : 0u; mine = (j == x) ? c : mine; }
        if (sum == G) break;
        __builtin_amdgcn_s_sleep(1);
        if ((++sp & 255u) == 0u) { if (xb_ld(&bar[XB_TMO])) break; if (sp > XB_SPIN_CAP) { atomicAdd(&bar[XB_TMO], 1u); break; } }
    }
    nloc = mine > 0u ? mine : 1u; nx = cnt > 0u ? cnt : 1u;
}

__device__ __forceinline__ void xcd_barrier(const XcdBarrier& b) {
    asm volatile("s_waitcnt vmcnt(0)" ::: "memory");
    __syncthreads();
    if (threadIdx.x == 0) {
        unsigned* bar = b.bar;
        __builtin_amdgcn_s_waitcnt(0);
        unsigned nloc = b.st[0], nx = b.st[1];
        if (nloc == 0u) { xcd_barrier_complete(bar, b.x, nloc, nx); b.st[0] = nloc; b.st[1] = nx; }
        const unsigned old = xb_add(&bar[XB_XSUB(b.x)], 1u);
        const unsigned gen = old / nloc;
        if (old + 1u == (gen + 1u) * nloc) {
            __builtin_amdgcn_fence(__ATOMIC_RELEASE, "agent");
            asm volatile("s_waitcnt vmcnt(0)" ::: "memory");
            const unsigned og = xb_add(&bar[XB_TOP], 1u);
            const unsigned tg = og / nx;
            if (og + 1u == (tg + 1u) * nx) xb_add(&bar[XB_TOPGEN], 1u);
            else XB_SPIN(xb_ld(&bar[XB_TOPGEN]) == tg, bar);
            __builtin_amdgcn_fence(__ATOMIC_ACQUIRE, "agent");
            xb_add(&bar[XB_XGEN(b.x)], 1u);
            asm volatile("s_waitcnt vmcnt(0)" ::: "memory");
        } else {
            XB_SPIN(xb_ld(&bar[XB_XGEN(b.x)]) == gen, bar);
            __builtin_amdgcn_fence(__ATOMIC_ACQUIRE, "agent");
            asm volatile("s_waitcnt vmcnt(0)" ::: "memory");
        }
    }
    __syncthreads();
}
#ifndef PG8_SP2
#define PG8_SP2 true
#endif
#ifndef PG8_ALIGN
#define PG8_ALIGN true
#endif

constexpr int NB = 4, SEQ = 4096, D = 1024, T = NB * SEQ;
constexpr int GW = 64;
constexpr int NINW = 2304, NAW = 512, GQW = 512, KVW = 128;
constexpr int MEML = 256, MEMT = NB * MEML, MEMW = 512;
constexpr int DFF = 2816, DFF2 = 5632;
constexpr float LOG2E = 1.4426950408889634f;
constexpr float QS_NA = 0.125f * LOG2E;
constexpr float QS_G = 0.125f * LOG2E;
constexpr float QS_M = 0.08838834764831845f * LOG2E;
constexpr int NTHREADS = 512, NWAVES = 8;

constexpr size_t MiB = 1u << 20;
constexpr size_t WS_CTL = 0, CTL_ZERO_BYTES = 1 * MiB;
constexpr size_t WS_ROPE = 1 * MiB, WS_SS = 2 * MiB, WS_MSS = 3 * MiB;
constexpr size_t WS_WIN = 4 * MiB, WS_WOUT = 13 * MiB, WS_WMQ = 17 * MiB, WS_WMKV = 19 * MiB, WS_WMO = 23 * MiB, WS_WUP = 25 * MiB, WS_WDN = 47 * MiB;
constexpr size_t WS_XB = 58 * MiB, WS_MXB = 90 * MiB, WS_MKV = 92 * MiB;
constexpr size_t WS_R = 96 * MiB;
constexpr size_t WS_NQ = WS_R, WS_NK = WS_R + 16 * MiB, WS_NV = WS_R + 32 * MiB, WS_GQ = WS_R + 48 * MiB, WS_GK = WS_R + 64 * MiB, WS_GV = WS_R + 68 * MiB, WS_OC = WS_R + 72 * MiB;
constexpr size_t WS_QM = WS_R, WS_OM = WS_R + 16 * MiB;
constexpr size_t WS_UP = WS_R, WS_ACT = WS_R + 64 * MiB, WS_END = 256 * MiB;
static_assert(WS_ACT + (size_t)T * DFF * 2 <= WS_END, "ws map");
constexpr int CW_BAR = 4096;

constexpr int RING_OFF = 0, RING_BYTES = 131072;
constexpr int LDSCTL_OFF = RING_BYTES, MISC_OFF = LDSCTL_OFF + 320;
constexpr int LDS_BYTES = 147456;

__device__ __forceinline__ float wave_sum(float v) {
#pragma unroll
    for (int o = 1; o < 64; o <<= 1) v += __shfl_xor(v, o);
    return v;
}
__device__ __forceinline__ float wave_max(float v) {
#pragma unroll
    for (int o = 1; o < 64; o <<= 1) v = fmaxf(v, __shfl_xor(v, o));
    return v;
}
__device__ __forceinline__ float bf_lo(unsigned w) { return __uint_as_float(w << 16); }
__device__ __forceinline__ float bf_hi(unsigned w) { return __uint_as_float(w & 0xffff0000u); }
__device__ __forceinline__ float bf2f(bf16 h) { return __uint_as_float((unsigned)h << 16); }
__device__ __forceinline__ float rdlane(float v, int l) { return __int_as_float(__builtin_amdgcn_readlane(__float_as_int(v), l)); }

__device__ __forceinline__ int rowmap(int kind, int n) {
    if (kind == 1) {
        if (n < 1536) return n;
        int pn, wc;
        if (n < 2048) { const int hh = (n - 1536) >> 6; pn = 6 + (hh >> 2); wc = hh & 3; }
        else if (n < 2176) { pn = 8; wc = (n - 2048) >> 6; }
        else { pn = 8; wc = 2 + ((n - 2176) >> 6); }
        const int d = n & 63, bj = d >> 5, nn = (d >> 4) & 1, fq = (d >> 2) & 3, e = d & 3;
        return 256 * pn + 128 * bj + 32 * wc + 8 * fq + 4 * nn + e;
    }
    if (kind == 2) { if (n < DFF) return 256 * (n >> 7) + (n & 127); const int ch = n - DFF; return 256 * (ch >> 7) + 128 + (ch & 127); }
    return n;
}
__device__ __forceinline__ void p0_transpose_item(const float* W, int K, int N, const float* gain, int kind, bf16* WT, LAS float* scr, int item, int lane) {
    const int nblk = N / 32, kb = item / nblk, nb = item % nblk, k0 = 64 * kb, n0 = 32 * nb;
#pragma unroll 8
    for (int i = 0; i < 32; ++i) { const int kk = 2 * i + (lane >> 5); const float gk = gain ? gain[k0 + kk] : 1.f; scr[kk * 33 + (lane & 31)] = W[(size_t)(k0 + kk) * N + n0 + (lane & 31)] * gk; }
    LDS_WAIT(); asm volatile("" ::: "memory");
    const int c = lane & 7;
#pragma unroll
    for (int j = 0; j < 4; ++j) { const int n = (lane >> 3) + 8 * j; const LAS float* s = scr + (8 * c) * 33 + n;
        v4u o; o.x = pk2(s[0 * 33], s[1 * 33]); o.y = pk2(s[2 * 33], s[3 * 33]); o.z = pk2(s[4 * 33], s[5 * 33]); o.w = pk2(s[6 * 33], s[7 * 33]);
        *(GAS v4u*)(WT + (size_t)rowmap(kind, n0 + n) * K + k0 + 8 * c) = o; }
    LDS_WAIT(); asm volatile("" ::: "memory");
}
__device__ __forceinline__ void row_to_bf16_ss(const float* xrow, bf16* orow, float* ssrow, int lane) {
    const GAS f32x4* xr = (const GAS f32x4*)xrow + lane;
    f32x4 v[4]; float s = 0.f;
#pragma unroll
    for (int j = 0; j < 4; ++j) { v[j] = xr[64 * j]; s += (v[j].x * v[j].x + v[j].y * v[j].y) + (v[j].z * v[j].z + v[j].w * v[j].w); }
    s = wave_sum(s);
    GAS unsigned long long* o8 = (GAS unsigned long long*)orow + lane;
#pragma unroll
    for (int j = 0; j < 4; ++j) o8[64 * j] = (unsigned long long)pk2(v[j].x, v[j].y) | ((unsigned long long)pk2(v[j].z, v[j].w) << 32);
    if (lane < 16) ssrow[lane] = lane == 0 ? s : 0.f;
}

struct Args { const float* in[19]; float* out; unsigned char* ws; };

__device__ __forceinline__ void na_naive(const bf16* NQ, const bf16* NK, const bf16* NV, bf16* OC, const float* rpb, int gw, int NGW, int lane) {
    for (int task = gw; task < T * 8; task += NGW) {
        const int h = task & 7, t = task >> 3;
        const int b = t >> 12, r = (t >> 6) & 63, c = t & 63;
        const int rs = min(max(r - 4, 0), 56), cs = min(max(c - 8, 0), 48);
        const float q = bf2f(NQ[(size_t)t * 512 + h * 64 + lane]);
        float s[2];
#pragma unroll
        for (int half = 0; half < 2; ++half) {
            const int kk = lane + 64 * half, i = kk >> 4, jj = kk & 15;
            const int tk = (b << 12) + ((rs + i) << 6) + cs + jj;
            const v4u* kp = (const v4u*)(NK + (size_t)tk * 512 + h * 64);
            v4u kv[8];
#pragma unroll
            for (int j = 0; j < 8; ++j) kv[j] = kp[j];
            float a = 0.f;
#pragma unroll
            for (int d = 0; d < 64; d += 2) { const unsigned w = kv[d >> 3][(d >> 1) & 3]; a += rdlane(q, d) * bf_lo(w) + rdlane(q, d + 1) * bf_hi(w); }
            s[half] = a + rpb[(h * 15 + (rs + i - r + 7)) * 31 + (cs + jj - c + 15)] * LOG2E;
        }
        const float m = wave_max(fmaxf(s[0], s[1]));
        const float p0 = exp2f(s[0] - m), p1 = exp2f(s[1] - m);
        const float l = wave_sum(p0 + p1);
        float o = 0.f;
        for (int kk = 0; kk < 64; ++kk) { const int i = kk >> 4, jj = kk & 15; const int tk = (b << 12) + ((rs + i) << 6) + cs + jj;
            o += rdlane(p0, kk) * bf2f(NV[(size_t)tk * 512 + h * 64 + lane]); }
        for (int kk = 0; kk < 64; ++kk) { const int i = 4 + (kk >> 4), jj = kk & 15; const int tk = (b << 12) + ((rs + i) << 6) + cs + jj;
            o += rdlane(p1, kk) * bf2f(NV[(size_t)tk * 512 + h * 64 + lane]); }
        OC[(size_t)t * 1024 + h * 64 + lane] = (bf16)f2bf(o / l);
    }
}
__device__ __forceinline__ void gqa_naive(const bf16* GQ, const bf16* GK, const bf16* GV, bf16* OC, int gw, int NGW, int lane) {
    for (int task = gw; task < T * 8; task += NGW) {
        const int h = task & 7, t = task >> 3, b = t >> 12, kvh = h >> 2;
        const float q = bf2f(GQ[(size_t)t * 512 + h * 64 + lane]);
        float m = -1e30f, l = 0.f, o = 0.f;
        for (int ch = 0; ch < 64; ++ch) {
            const int tk = (b << 12) + ch * 64 + lane;
            const v4u* kp = (const v4u*)(GK + (size_t)tk * 128 + kvh * 64);
            v4u kv[8];
#pragma unroll
            for (int j = 0; j < 8; ++j) kv[j] = kp[j];
            float a = 0.f;
#pragma unroll
            for (int d = 0; d < 64; d += 2) { const unsigned w = kv[d >> 3][(d >> 1) & 3]; a += rdlane(q, d) * bf_lo(w) + rdlane(q, d + 1) * bf_hi(w); }
            const float cm = wave_max(a), mn = fmaxf(m, cm), alpha = exp2f(m - mn), p = exp2f(a - mn);
            l = l * alpha + wave_sum(p); o *= alpha; m = mn;
            const bf16* vp = GV + (size_t)((b << 12) + ch * 64) * 128 + kvh * 64 + lane;
            for (int kk = 0; kk < 64; ++kk) o += rdlane(p, kk) * bf2f(vp[(size_t)kk * 128]);
        }
        OC[(size_t)t * 1024 + 512 + h * 64 + lane] = (bf16)f2bf(o / l);
    }
}
__device__ __forceinline__ void mem_naive(const bf16* QM, const bf16* MK, const bf16* MV, bf16* OM, int gw, int NGW, int lane) {
    for (int task = gw; task < T * 4; task += NGW) {
        const int h = task & 3, t = task >> 2, b = t >> 12;
        const float q0 = bf2f(QM[(size_t)t * 512 + h * 128 + lane]), q1 = bf2f(QM[(size_t)t * 512 + h * 128 + 64 + lane]);
        float s[4];
#pragma unroll
        for (int j = 0; j < 4; ++j) {
            const int row = b * 256 + 64 * j + lane;
            const v4u* kp = (const v4u*)(MK + (size_t)row * 512 + h * 128);
            v4u kv[16];
#pragma unroll
            for (int i = 0; i < 16; ++i) kv[i] = kp[i];
            float a = 0.f;
#pragma unroll
            for (int d = 0; d < 64; d += 2) { const unsigned w = kv[d >> 3][(d >> 1) & 3]; a += rdlane(q0, d) * bf_lo(w) + rdlane(q0, d + 1) * bf_hi(w); }
#pragma unroll
            for (int d = 0; d < 64; d += 2) { const unsigned w = kv[8 + (d >> 3)][(d >> 1) & 3]; a += rdlane(q1, d) * bf_lo(w) + rdlane(q1, d + 1) * bf_hi(w); }
            s[j] = a * QS_M;
        }
        const float m = wave_max(fmaxf(fmaxf(s[0], s[1]), fmaxf(s[2], s[3])));
        float p[4], ps = 0.f;
#pragma unroll
        for (int j = 0; j < 4; ++j) { p[j] = exp2f(s[j] - m); ps += p[j]; }
        const float l = wave_sum(ps);
        float o0 = 0.f, o1 = 0.f;
#pragma unroll
        for (int j = 0; j < 4; ++j) {
            const bf16* vp = MV + (size_t)(b * 256 + 64 * j) * 512 + h * 128 + lane;
            for (int kk = 0; kk < 64; ++kk) { const float pk = rdlane(p[j], kk); o0 += pk * bf2f(vp[(size_t)kk * 512]); o1 += pk * bf2f(vp[(size_t)kk * 512 + 64]); }
        }
        OM[(size_t)t * 512 + h * 128 + lane] = (bf16)f2bf(o0 / l); OM[(size_t)t * 512 + h * 128 + 64 + lane] = (bf16)f2bf(o1 / l);
    }
}
__device__ __forceinline__ void conv_act_pass(const bf16* U, int ntp, int tp0, const float* cw, const float* cb, bf16* ACT, int gtid, int NGT) {
    const int ldu = ntp * 256, nitem = T * ntp * 16;
    for (int it = gtid; it < nitem; it += NGT) {
        const int g8 = it & 15, j = (it >> 4) % ntp, t = (it >> 4) / ntp;
        const int ch = 128 * (tp0 + j) + 8 * g8;
        const bf16* ug = U + (size_t)t * ldu + 256 * j + 8 * g8; const bf16* uv = ug + 128;
        const bool hp = (t & 4095) != 0, hn = (t & 4095) != 4095;
        const v4u z = {0u, 0u, 0u, 0u};
        const v4u g0 = hp ? *(const v4u*)(ug - ldu) : z, g1 = *(const v4u*)ug, g2 = hn ? *(const v4u*)(ug + ldu) : z;
        const v4u v0 = hp ? *(const v4u*)(uv - ldu) : z, v1 = *(const v4u*)uv, v2 = hn ? *(const v4u*)(uv + ldu) : z;
        float r[8];
#pragma unroll
        for (int e = 0; e < 8; ++e) {
            const int c = ch + e; const unsigned sh = e >> 1;
            const float a0 = (e & 1) ? bf_hi(g0[sh]) : bf_lo(g0[sh]), a1 = (e & 1) ? bf_hi(g1[sh]) : bf_lo(g1[sh]), a2 = (e & 1) ? bf_hi(g2[sh]) : bf_lo(g2[sh]);
            const float b0 = (e & 1) ? bf_hi(v0[sh]) : bf_lo(v0[sh]), b1 = (e & 1) ? bf_hi(v1[sh]) : bf_lo(v1[sh]), b2 = (e & 1) ? bf_hi(v2[sh]) : bf_lo(v2[sh]);
            const float gg = a0 * cw[c] + a1 * cw[DFF2 + c] + a2 * cw[2 * DFF2 + c] + cb[c];
            const float vv = b0 * cw[DFF + c] + b1 * cw[DFF2 + DFF + c] + b2 * cw[2 * DFF2 + DFF + c] + cb[DFF + c];
            r[e] = gg / (1.f + __expf(-gg)) * vv;
        }
        v4u o; o.x = pk2(r[0], r[1]); o.y = pk2(r[2], r[3]); o.z = pk2(r[4], r[5]); o.w = pk2(r[6], r[7]);
        *(v4u*)(ACT + (size_t)t * DFF + ch) = o;
    }
}

__device__ __forceinline__ const void* karg(int i) {
    unsigned off = (unsigned)i * 8u; asm volatile("" : "+s"(off));
    return *(const void* const __attribute__((address_space(4)))*)((const char __attribute__((address_space(4)))*)__builtin_amdgcn_kernarg_segment_ptr() + off);
}
#define WSP() ((unsigned char*)karg(20))
#define OUTP() ((float*)karg(19))
#define INP(i) ((const float*)karg(i))
#define WSB(off) ((bf16*)(WSP() + (off)))
#define WSF(off) ((float*)(WSP() + (off)))
struct Ids { int tid, lane, wave, vcu, gw, NGW, gtid, NGT, G, bx; };
__device__ __forceinline__ Ids ids() {
    Ids I; int t = threadIdx.x; asm volatile("" : "+v"(t)); I.tid = t; I.lane = t & 63; I.wave = __builtin_amdgcn_readfirstlane(t >> 6);
    I.G = gridDim.x; I.bx = blockIdx.x; I.vcu = (I.G % 8 == 0) ? (I.bx % 8) * (I.G / 8) + I.bx / 8 : I.bx;
    I.gw = I.vcu * NWAVES + I.wave; I.NGW = I.G * NWAVES; I.gtid = I.vcu * NTHREADS + I.tid; I.NGT = I.G * NTHREADS; return I;
}
__device__ __forceinline__ void grid_bar(LAS unsigned char* L) {
    XcdBarrier b; b.bar = (unsigned*)(WSP() + WS_CTL) + CW_BAR; b.x = xb_xcc_id(); b.st = (volatile LAS unsigned*)(L + MISC_OFF) + 8;
    xcd_barrier(b);
}
__global__ void __launch_bounds__(NTHREADS, 2) mk_fwd(Args args) {
    extern __shared__ __attribute__((aligned(16))) unsigned char lds[];
    LAS unsigned char* L = (LAS unsigned char*)lds;
    {
        const int tid = threadIdx.x;
        for (int u = tid; u < (LDS_BYTES - LDSCTL_OFF) / 4; u += NTHREADS) ((LAS unsigned*)(L + LDSCTL_OFF))[u] = 0u;
        __syncthreads();
        (void)xcd_barrier_post((unsigned*)(WSP() + WS_CTL) + CW_BAR, (volatile LAS unsigned*)(L + MISC_OFF) + 8);
    }
#define GRID_BAR() grid_bar(L)

    {
        const Ids I = ids(); const int lane = I.lane;
        LAS float* scr = (LAS float*)(L + RING_OFF + I.wave * 16384);
        constexpr int I_IN = 16 * (NINW / 32), I_OUT = 16 * 32, I_MQ = 16 * 16, I_MKV = 16 * 32, I_MO = 8 * 32, I_UP = 16 * (DFF2 / 32), I_DN = 44 * 32;
        constexpr int I_L = I_IN + I_OUT + I_MQ + I_MKV + I_MO + I_UP + I_DN;
        for (int it = I.gw; it < 2 * I_L; it += I.NGW) {
            const int l = it / I_L; int r = it % I_L;
            if (r < I_IN) { p0_transpose_item(INP(3) + (size_t)l * D * NINW, D, NINW, INP(2) + l * D, 1, WSB(WS_WIN) + (size_t)l * NINW * D, scr, r, lane); continue; } r -= I_IN;
            if (r < I_OUT) { p0_transpose_item(INP(7) + (size_t)l * D * D, D, D, nullptr, 0, WSB(WS_WOUT) + (size_t)l * D * D, scr, r, lane); continue; } r -= I_OUT;
            if (r < I_MQ) { p0_transpose_item(INP(10) + (size_t)l * D * MEMW, D, MEMW, INP(8) + l * D, 0, WSB(WS_WMQ) + (size_t)l * MEMW * D, scr, r, lane); continue; } r -= I_MQ;
            if (r < I_MKV) { p0_transpose_item(INP(11) + (size_t)l * D * 1024, D, 1024, INP(9) + l * D, 0, WSB(WS_WMKV) + (size_t)l * 1024 * D, scr, r, lane); continue; } r -= I_MKV;
            if (r < I_MO) { p0_transpose_item(INP(12) + (size_t)l * MEMW * D, MEMW, D, nullptr, 0, WSB(WS_WMO) + (size_t)l * D * MEMW, scr, r, lane); continue; } r -= I_MO;
            if (r < I_UP) { p0_transpose_item(INP(14) + (size_t)l * D * DFF2, D, DFF2, INP(13) + l * D, 2, WSB(WS_WUP) + (size_t)l * DFF2 * D, scr, r, lane); continue; } r -= I_UP;
            p0_transpose_item(INP(17) + (size_t)l * DFF * D, DFF, D, nullptr, 0, WSB(WS_WDN) + (size_t)l * D * DFF, scr, r, lane);
        }
        { const float* x_in = INP(0); bf16* XB = WSB(WS_XB); float* SS = WSF(WS_SS);
          for (int m = I.gw; m < T; m += I.NGW) row_to_bf16_ss(x_in + (size_t)m * D, XB + (size_t)m * D, SS + (size_t)m * 16, lane); }
        { const float* mem_in = INP(1); bf16* MXB = WSB(WS_MXB); float* MSS = WSF(WS_MSS);
          for (int m = I.gw; m < MEMT; m += I.NGW) row_to_bf16_ss(mem_in + (size_t)m * D, MXB + (size_t)m * D, MSS + (size_t)m * 16, lane); }
        if (I.bx == 0) { float* ROPE = WSF(WS_ROPE); for (int i = I.tid; i < 1024; i += NTHREADS) { const int pos = i >> 4, f = i & 15;
            const float inv_freq = powf(10000.0f, -(float)f / 16.0f); const float ang = (float)pos * inv_freq;
            ROPE[pos * 32 + f] = cosf(ang); ROPE[pos * 32 + 16 + f] = sinf(ang); } }
    }
    GRID_BAR();

    {
        pg8::Gemm g{WSB(WS_MXB), WSB(WS_WMKV), MEMT, 2048, D}; pg8::StaticOrder S; S.init(MEMT, 2048, gridDim.x, blockIdx.x);
        pg8::EpiSB E{WSB(WS_MKV), MEMW, WSF(WS_MSS), 512, (size_t)MEMT * MEMW, 1.f};
        pg8::gemm_phase<pg8::EpiSB, pg8::StaticOrder, PG8_ALIGN, PG8_SP2>(L + RING_OFF, g, S, E);
    }

    for (int l = 0; l < 2; ++l) {
        {
            pg8::Gemm g{WSB(WS_XB), WSB(WS_WIN) + (size_t)l * NINW * D, T, NINW, D}; pg8::StaticOrder S; S.init(T, NINW, gridDim.x, blockIdx.x);
            pg8::EpiInProj E{WSF(WS_SS), WSB(WS_NQ), (size_t)T * 512, WSB(WS_GQ), WSB(WS_GK), WSB(WS_GV), WSF(WS_ROPE), INP(5) + l * 64, INP(6) + l * 64, QS_NA, QS_G};
            pg8::gemm_phase<pg8::EpiInProj, pg8::StaticOrder, PG8_ALIGN, PG8_SP2>(L + RING_OFF, g, S, E);
        }
        GRID_BAR();
        { const Ids I = ids(); na_naive(WSB(WS_NQ), WSB(WS_NK), WSB(WS_NV), WSB(WS_OC), INP(4) + (size_t)l * 8 * 15 * 31, I.gw, I.NGW, I.lane); }
        { const Ids I = ids(); gqa_naive(WSB(WS_GQ), WSB(WS_GK), WSB(WS_GV), WSB(WS_OC), I.gw, I.NGW, I.lane); }
        GRID_BAR();
        {
            pg8::Gemm g{WSB(WS_OC), WSB(WS_WOUT) + (size_t)l * D * D, T, D, D}; pg8::StaticOrder S; S.init(T, D, gridDim.x, blockIdx.x);
            pg8::EpiRes E{l == 0 ? INP(0) : (const float*)OUTP(), OUTP(), WSB(WS_XB), WSF(WS_SS)};
            pg8::gemm_phase<pg8::EpiRes, pg8::StaticOrder, PG8_ALIGN, PG8_SP2>(L + RING_OFF, g, S, E);
        }
        GRID_BAR();
        {
            pg8::Gemm g{WSB(WS_XB), WSB(WS_WMQ) + (size_t)l * MEMW * D, T, MEMW, D}; pg8::StaticOrder S; S.init(T, MEMW, gridDim.x, blockIdx.x);
            pg8::EpiSB E{WSB(WS_QM), MEMW, WSF(WS_SS), 0, 0, 1.f};
            pg8::gemm_phase<pg8::EpiSB, pg8::StaticOrder, PG8_ALIGN, PG8_SP2>(L + RING_OFF, g, S, E);
        }
        GRID_BAR();
        { const Ids I = ids(); const bf16* MK = WSB(WS_MKV) + (size_t)l * 2 * MEMT * MEMW;
          mem_naive(WSB(WS_QM), MK, MK + (size_t)MEMT * MEMW, WSB(WS_OM), I.gw, I.NGW, I.lane); }
        GRID_BAR();
        {
            pg8::Gemm g{WSB(WS_OM), WSB(WS_WMO) + (size_t)l * D * MEMW, T, D, MEMW}; pg8::StaticOrder S; S.init(T, D, gridDim.x, blockIdx.x);
            pg8::EpiRes E{OUTP(), OUTP(), WSB(WS_XB), WSF(WS_SS)};
            pg8::gemm_phase<pg8::EpiRes, pg8::StaticOrder, PG8_ALIGN, PG8_SP2>(L + RING_OFF, g, S, E);
        }
        GRID_BAR();
        for (int p = 0; p < 3; ++p) {
            const int tp0 = 8 * p, ntp = p < 2 ? 8 : 6;
            {
                pg8::Gemm g{WSB(WS_XB), WSB(WS_WUP) + (size_t)l * DFF2 * D + (size_t)tp0 * 256 * D, T, ntp * 256, D}; pg8::StaticOrder S; S.init(T, ntp * 256, gridDim.x, blockIdx.x);
                pg8::EpiSB E{WSB(WS_UP), ntp * 256, WSF(WS_SS), 0, 0, 1.f};
                pg8::gemm_phase<pg8::EpiSB, pg8::StaticOrder, PG8_ALIGN, PG8_SP2>(L + RING_OFF, g, S, E);
            }
            GRID_BAR();
            { const Ids I = ids(); conv_act_pass(WSB(WS_UP), ntp, tp0, INP(15) + (size_t)l * 3 * DFF2, INP(16) + (size_t)l * DFF2, WSB(WS_ACT), I.gtid, I.NGT); }
            GRID_BAR();
        }
        {
            pg8::Gemm g{WSB(WS_ACT), WSB(WS_WDN) + (size_t)l * D * DFF, T, D, DFF}; pg8::StaticOrder S; S.init(T, D, gridDim.x, blockIdx.x);
            pg8::EpiRes E{OUTP(), OUTP(), WSB(WS_XB), WSF(WS_SS)};
            pg8::gemm_phase<pg8::EpiRes, pg8::StaticOrder, PG8_ALIGN, PG8_SP2>(L + RING_OFF, g, S, E);
        }
        GRID_BAR();
    }
    {
        const Ids I = ids(); const int lane = I.lane;
        const float* gf = INP(18); float* X = OUTP();
        for (int m = I.gw; m < T; m += I.NGW) {
            GAS f32x4* xr = (GAS f32x4*)(X + (size_t)m * D) + lane;
            f32x4 v[4]; float s = 0.f;
#pragma unroll
            for (int j = 0; j < 4; ++j) { v[j] = xr[64 * j]; s += (v[j].x * v[j].x + v[j].y * v[j].y) + (v[j].z * v[j].z + v[j].w * v[j].w); }
            const float rs = 1.0f / sqrtf(wave_sum(s) * (1.0f / D) + 1e-6f);
#pragma unroll
            for (int j = 0; j < 4; ++j) { const f32x4 gg = *((const f32x4*)gf + lane + 64 * j); xr[64 * j] = v[j] * rs * gg; }
        }
    }
}

extern "C" void kernel_launch(void* const* d_in, const int* in_sizes, int n_in, void* d_out, int out_size, void* d_ws, size_t ws_size, hipStream_t stream) {
    static int grid = 0;
    if (grid == 0) {
        if (n_in != 19 || in_sizes[0] != T * D || out_size != T * D || ws_size < WS_END) { fprintf(stderr, "kernel_launch: shape mismatch n_in %d in0 %d out %d ws %zu\n", n_in, n_in > 0 ? in_sizes[0] : -1, out_size, ws_size); grid = -1; return; }
        int dev = 0, cus = 0;
        if (hipGetDevice(&dev) != hipSuccess || hipDeviceGetAttribute(&cus, hipDeviceAttributeMultiprocessorCount, dev) != hipSuccess) { grid = -1; return; }
        if (hipFuncSetAttribute((const void*)mk_fwd, hipFuncAttributeMaxDynamicSharedMemorySize, LDS_BYTES) != hipSuccess) { fprintf(stderr, "kernel_launch: hipFuncSetAttribute failed\n"); grid = -1; return; }
        int per_cu = 0;
        if (hipOccupancyMaxActiveBlocksPerMultiprocessor(&per_cu, (const void*)mk_fwd, NTHREADS, LDS_BYTES) != hipSuccess || per_cu < 1) fprintf(stderr, "kernel_launch: occupancy query says %d\n", per_cu);
        (void)hipGetLastError();
        grid = cus;
    }
    if (grid < 0) return;
    if (hipMemsetAsync((char*)d_ws + WS_CTL, 0, CTL_ZERO_BYTES, stream) != hipSuccess) { fprintf(stderr, "kernel_launch: memset failed\n"); return; }
    Args a{};
    for (int i = 0; i < 19; ++i) a.in[i] = (const float*)d_in[i];
    a.out = (float*)d_out; a.ws = (unsigned char*)d_ws;
    hipLaunchKernelGGL(mk_fwd, dim3(grid), dim3(NTHREADS), LDS_BYTES, stream, a);
    const hipError_t le = hipPeekAtLastError();
    if (le != hipSuccess) fprintf(stderr, "kernel_launch: launch failed: %s\n", hipGetErrorName(le));
}
```

```cpp
#include <hip/hip_runtime.h>
#include <hip/hip_bf16.h>
#include <cstdio>
#include <cstdint>
#include <cmath>
namespace pg8 {
#define PG8_LAS __attribute__((address_space(3)))
typedef unsigned short bf16_t;
typedef short bf16x8 __attribute__((ext_vector_type(8)));
typedef float f32x4 __attribute__((ext_vector_type(4)));
typedef unsigned u32x4 __attribute__((ext_vector_type(4)));
constexpr int BM = 256, BK = 64, HALF = 128, HTB = HALF * BK * 2  , STAGE_BYTES = 8 * HTB, NXCD = 8, WGM = 8;

__host__ __device__ __forceinline__ int lds_byte(int r, int c) { const int st = (r >> 4) * 2 + (c >> 5), rr = r & 15, cc = c & 31, ob = rr * 64 + cc * 2; return st * 1024 + (ob ^ (((ob >> 9) & 1) << 5)); }
__host__ __device__ __forceinline__ void stage_rc(int b, int& R, int& C) { const int st = b / 1024, sb = b % 1024, swz = sb ^ (((sb >> 9) & 1) << 5); R = (st >> 1) * 16 + swz / 64; C = (st & 1) * 32 + (swz % 64) / 2; }
__host__ __device__ __forceinline__ int perm32(int rho) { const int n = rho >> 4, i = rho & 15; return 8 * (i >> 2) + 4 * n + (i & 3); }

struct Unit { int pm, pn; };
struct Gemm { const bf16_t* A; const bf16_t* Bt; int M, N, K; };

struct StaticOrder {
    int nM, nN, nwg, G, c;
    __host__ __device__ void init(int M, int N, int G_, int c_) { nM = M / BM; nN = N / BM; nwg = nM * nN; G = G_; c = c_; }
    __host__ __device__ bool next(int i, Unit& u) const {
        const long L = (long)i * G + c; if (L >= nwg) return false;
        int wgid = (int)L; { const int q = nwg / NXCD, r = nwg % NXCD, xcd = wgid % NXCD, off = wgid / NXCD; wgid = (xcd < r ? xcd * (q + 1) : r * (q + 1) + (xcd - r) * q) + off; }
        const int nig = WGM * nN, gid = wgid / nig, fm = gid * WGM, gsz = (nM - fm) < WGM ? (nM - fm) : WGM;
        u.pm = fm + ((wgid % nig) % gsz); u.pn = (wgid % nig) / gsz; return true;
    }
    __device__ __forceinline__ void a_ready(const Unit&) const {}
    __device__ __forceinline__ void done(const Unit&) const {}
};

__device__ __forceinline__ unsigned cvt_pk_bf16(float lo, float hi) { unsigned r; asm volatile("v_cvt_pk_bf16_f32 %0, %1, %2" : "=v"(r) : "v"(lo), "v"(hi)); return r; }
typedef float f32x2 __attribute__((ext_vector_type(2)));
typedef unsigned u32x2 __attribute__((ext_vector_type(2)));
__device__ __forceinline__ float row_rs(const float* SS, int row, int fq) {
    const f32x4 v = *(const f32x4*)(SS + (size_t)row * 16 + fq * 4);
    float s = (v[0] + v[1]) + (v[2] + v[3]);
    s += __shfl_xor(s, 16); s += __shfl_xor(s, 32);
    return __builtin_amdgcn_rsqf(s * (1.0f / 1024.0f) + 1e-6f);
}
struct EpiSB {
    static constexpr bool PERM = true, AFTER_DRAIN = false;
    bf16_t* O; int ldc; const float* SS; int split_cols; size_t split_stride; float scale0;
    __device__ __forceinline__ void operator()(const f32x4 (&acc)[2][2][4][2], const Unit& u, int wr, int wc, int fr, int fq) const {
        const int row0 = u.pm * BM + wr * 64 + fr; int colt = u.pn * BM; bf16_t* base = O;
        float sc = 1.f; if (split_cols) { const int t = colt / split_cols; base += (size_t)t * split_stride; colt -= t * split_cols; if (t == 0) sc = scale0; }
        const int col0 = colt + wc * 32 + 8 * fq;
#pragma unroll
        for (int ai = 0; ai < 2; ++ai)
#pragma unroll
            for (int m = 0; m < 4; ++m) { const int row = row0 + ai * HALF + m * 16; const float rs = SS ? row_rs(SS, row, fq) * sc : sc;
                bf16_t* rowp = base + (size_t)row * ldc + col0;
#pragma unroll
                for (int bj = 0; bj < 2; ++bj) { const f32x4 v0 = acc[ai][bj][m][0] * rs, v1 = acc[ai][bj][m][1] * rs;
                    u32x4 w; w.x = cvt_pk_bf16(v0[0], v0[1]); w.y = cvt_pk_bf16(v0[2], v0[3]); w.z = cvt_pk_bf16(v1[0], v1[1]); w.w = cvt_pk_bf16(v1[2], v1[3]);
                    *(u32x4*)(rowp + bj * HALF) = w; } }
    }
};
struct EpiRes {
    static constexpr bool PERM = true, AFTER_DRAIN = false;
    const float* xold; float* xnew; bf16_t* xb; float* SSo;
    __device__ __forceinline__ void operator()(const f32x4 (&acc)[2][2][4][2], const Unit& u, int wr, int wc, int fr, int fq) const {
        const int row0 = u.pm * BM + wr * 64 + fr, col0 = u.pn * BM + wc * 32 + 8 * fq;
#pragma unroll
        for (int ai = 0; ai < 2; ++ai)
#pragma unroll
            for (int m = 0; m < 4; ++m) { const int row = row0 + ai * HALF + m * 16; const size_t off = (size_t)row * 1024 + col0; float ssq = 0.f;
#pragma unroll
                for (int bj = 0; bj < 2; ++bj) {
                    const f32x4 a0 = *(const f32x4*)(xold + off + bj * HALF), a1 = *(const f32x4*)(xold + off + bj * HALF + 4);
                    const f32x4 v0 = a0 + acc[ai][bj][m][0], v1 = a1 + acc[ai][bj][m][1];
                    *(f32x4*)(xnew + off + bj * HALF) = v0; *(f32x4*)(xnew + off + bj * HALF + 4) = v1;
                    u32x4 w; w.x = cvt_pk_bf16(v0[0], v0[1]); w.y = cvt_pk_bf16(v0[2], v0[3]); w.z = cvt_pk_bf16(v1[0], v1[1]); w.w = cvt_pk_bf16(v1[2], v1[3]);
                    *(u32x4*)(xb + off + bj * HALF) = w;
                    ssq += (v0[0] * v0[0] + v0[1] * v0[1]) + (v0[2] * v0[2] + v0[3] * v0[3]) + (v1[0] * v1[0] + v1[1] * v1[1]) + (v1[2] * v1[2] + v1[3] * v1[3]); }
                ssq += __shfl_xor(ssq, 16); ssq += __shfl_xor(ssq, 32);
                if (fq == 0) SSo[(size_t)row * 16 + u.pn * 4 + wc] = ssq; }
    }
};
struct EpiInProj {
    static constexpr bool PERM = true, AFTER_DRAIN = false;
    const float* SS; bf16_t* NQKV; size_t nstride; bf16_t* GQ; bf16_t* GK; bf16_t* GV; const float* rope; const float* qn; const float* kn; float qs_na, qs_g;
    __device__ __forceinline__ void operator()(const f32x4 (&acc)[2][2][4][2], const Unit& u, int wr, int wc, int fr, int fq) const {
        const int row0 = u.pm * BM + wr * 64 + fr;
        if (u.pn < 6) {
            bf16_t* base = NQKV + (size_t)(u.pn >> 1) * nstride; const int col0 = (u.pn & 1) * 256 + wc * 32 + 8 * fq; const float sc = u.pn < 2 ? qs_na : 1.f;
#pragma unroll
            for (int ai = 0; ai < 2; ++ai)
#pragma unroll
                for (int m = 0; m < 4; ++m) { const int row = row0 + ai * HALF + m * 16; const float rs = row_rs(SS, row, fq) * sc;
                    bf16_t* rowp = base + (size_t)row * 512 + col0;
#pragma unroll
                    for (int bj = 0; bj < 2; ++bj) { const f32x4 v0 = acc[ai][bj][m][0] * rs, v1 = acc[ai][bj][m][1] * rs;
                        u32x4 w; w.x = cvt_pk_bf16(v0[0], v0[1]); w.y = cvt_pk_bf16(v0[2], v0[3]); w.z = cvt_pk_bf16(v1[0], v1[1]); w.w = cvt_pk_bf16(v1[2], v1[3]);
                        *(u32x4*)(rowp + bj * HALF) = w; } }
            return;
        }
        const bool isq = u.pn < 8, isv = (u.pn == 8) && (wc >= 2);
        bf16_t* dst; int ld; const float* gain; float post;
        if (isq) { dst = GQ + (4 * (u.pn - 6) + wc) * 64; ld = 512; gain = qn; post = qs_g; }
        else if (!isv) { dst = GK + wc * 64; ld = 128; gain = kn; post = 1.f; }
        else { dst = GV + (wc - 2) * 64; ld = 128; gain = kn; post = 1.f; }
        f32x4 g[2][2];
#pragma unroll
        for (int bj = 0; bj < 2; ++bj)
#pragma unroll
            for (int n = 0; n < 2; ++n) g[bj][n] = *(const f32x4*)(gain + 32 * bj + 16 * n + 4 * fq) * post;
#pragma unroll
        for (int ai = 0; ai < 2; ++ai)
#pragma unroll
            for (int m = 0; m < 4; ++m) { const int row = row0 + ai * HALF + m * 16; const float rs = row_rs(SS, row, fq);
                f32x4 v[2][2]; float ssq = 0.f;
#pragma unroll
                for (int bj = 0; bj < 2; ++bj)
#pragma unroll
                    for (int n = 0; n < 2; ++n) { v[bj][n] = acc[ai][bj][m][n] * rs; const f32x4 x = v[bj][n]; ssq += (x[0] * x[0] + x[1] * x[1]) + (x[2] * x[2] + x[3] * x[3]); }
                bf16_t* rowp = dst + (size_t)row * ld;
                if (!isv) {
                    ssq += __shfl_xor(ssq, 16); ssq += __shfl_xor(ssq, 32);
                    const float inv = __builtin_amdgcn_rsqf(ssq * (1.0f / 64.0f) + 1e-6f);
                    const int pos0 = (row & 4095) >> 6, pos1 = row & 63;
#pragma unroll
                    for (int bj = 0; bj < 2; ++bj) { const int pos = bj == 0 ? pos0 : pos1;
                        const f32x4 c = *(const f32x4*)(rope + pos * 32 + 4 * fq), s = *(const f32x4*)(rope + pos * 32 + 16 + 4 * fq);
                        const f32x4 x1 = v[bj][0] * inv * g[bj][0], x2 = v[bj][1] * inv * g[bj][1];
                        v[bj][0] = x1 * c - x2 * s; v[bj][1] = x1 * s + x2 * c; }
                }
#pragma unroll
                for (int bj = 0; bj < 2; ++bj)
#pragma unroll
                    for (int n = 0; n < 2; ++n) { u32x2 w; w.x = cvt_pk_bf16(v[bj][n][0], v[bj][n][1]); w.y = cvt_pk_bf16(v[bj][n][2], v[bj][n][3]);
                        *(u32x2*)(rowp + 32 * bj + 16 * n + 4 * fq) = w; } }
    }
};

template <class Epi, class Sched, bool ALIGN_EPI = false, bool SP2 = false>
__device__ __forceinline__ void gemm_phase(PG8_LAS unsigned char* lds, const Gemm g, const Sched& S, const Epi& E) {
    int tid_ = threadIdx.x; asm volatile("" : "+v"(tid_));
    const int tid = tid_, wid = __builtin_amdgcn_readfirstlane(tid >> 6), lane = tid & 63, wr = wid >> 2, wc = wid & 3, fr = lane & 15, fq = lane >> 4;
    const int K = g.K, nt = K / BK;
    unsigned voffA[2], voffB[2];
#pragma unroll
    for (int i = 0; i < 2; ++i) { int R, C; stage_rc(tid * 16 + i * 8192, R, C); const int Rb = Epi::PERM ? ((R & ~31) + perm32(R & 31)) : R;
        voffA[i] = (unsigned)(R * K + C) * 2u; voffB[i] = (unsigned)(Rb * K + C) * 2u; }
    const size_t kstep = (size_t)(BK * 2);
    const size_t hstep = (size_t)HALF * K * 2;
    const size_t tstep = 2 * hstep;
    const unsigned ldsw = (unsigned)wid * 1024u;
    const int aoff = lds_byte(wr * 64 + fr, fq * 8), boff = lds_byte(wc * 32 + fr, fq * 8);
#define PG8_SA(b, h) (((b) * 2 + (h)) * HTB)
#define PG8_SB(b, h) ((4 + (b) * 2 + (h)) * HTB)
#define PG8_STAGE(bufoff, gbase, voff) do { _Pragma("unroll") for (int _i = 0; _i < 2; ++_i) \
        __builtin_amdgcn_global_load_lds((const unsigned*)((const char*)(gbase) + (voff)[_i]), (PG8_LAS unsigned*)(lds + (bufoff) + ldsw + _i * 8192), 16, 0, 0); } while (0)
#define PG8_LDA(dst, b, h) do { _Pragma("unroll") for (int m = 0; m < 4; ++m) _Pragma("unroll") for (int k = 0; k < 2; ++k) dst[m][k] = *(const PG8_LAS bf16x8*)(lds + PG8_SA(b, h) + aoff + m * 2048 + k * 1024); } while (0)
#define PG8_LDB(dst, b, h) do { _Pragma("unroll") for (int n = 0; n < 2; ++n) _Pragma("unroll") for (int k = 0; k < 2; ++k) dst[n][k] = *(const PG8_LAS bf16x8*)(lds + PG8_SB(b, h) + boff + n * 2048 + k * 1024); } while (0)
#define PG8_MMA(ai, bj, At, Bt) do { __builtin_amdgcn_s_setprio(1); _Pragma("unroll") for (int m = 0; m < 4; ++m) _Pragma("unroll") for (int n = 0; n < 2; ++n) _Pragma("unroll") for (int k = 0; k < 2; ++k) \
        acc[ai][bj][m][n] = __builtin_amdgcn_mfma_f32_16x16x32_bf16(Bt[n][k], At[m][k], acc[ai][bj][m][n], 0, 0, 0); __builtin_amdgcn_s_setprio(0); } while (0)
#define PG8_WAIT_V(n) asm volatile("s_waitcnt vmcnt(" #n ")" ::: "memory")
#define PG8_WAIT_L(n) asm volatile("s_waitcnt lgkmcnt(" #n ")" ::: "memory")
#define PG8_BAR __builtin_amdgcn_s_barrier()
#define PG8_SCHED __builtin_amdgcn_sched_barrier(0)
    Unit cur, nxt; int ui = 0;
    if (!S.next(0, cur)) return;
    f32x4 acc[2][2][4][2];
#pragma unroll
    for (int a = 0; a < 2; ++a)
#pragma unroll
        for (int b = 0; b < 2; ++b)
#pragma unroll
            for (int m = 0; m < 4; ++m)
#pragma unroll
                for (int n = 0; n < 2; ++n) acc[a][b][m][n] = (f32x4){0.f, 0.f, 0.f, 0.f};
    bf16x8 At[4][2], B0[2][2], B1[2][2];
    const char* cA = (const char*)g.A + (size_t)cur.pm * tstep; const char* cB = (const char*)g.Bt + (size_t)cur.pn * tstep;
    S.a_ready(cur);
    if constexpr (SP2) {
        PG8_STAGE(PG8_SB(0, 0), cB, voffB); PG8_STAGE(PG8_SB(0, 1), cB + hstep, voffB); PG8_STAGE(PG8_SA(0, 0), cA, voffA); PG8_STAGE(PG8_SA(0, 1), cA + hstep, voffA);
        if (wr == 1) PG8_BAR;
        PG8_WAIT_V(2); PG8_BAR;
        PG8_STAGE(PG8_SB(1, 0), cB + kstep, voffB); PG8_STAGE(PG8_SA(1, 0), cA + kstep, voffA); PG8_STAGE(PG8_SB(1, 1), cB + hstep + kstep, voffB);
        PG8_WAIT_V(6); PG8_BAR;
    } else {
        PG8_STAGE(PG8_SB(0, 0), cB, voffB); PG8_STAGE(PG8_SA(0, 0), cA, voffA); PG8_STAGE(PG8_SB(0, 1), cB + hstep, voffB); PG8_STAGE(PG8_SA(0, 1), cA + hstep, voffA);
        if (wr == 1) PG8_BAR;
        PG8_WAIT_V(4); PG8_BAR;
        PG8_STAGE(PG8_SB(1, 0), cB + kstep, voffB); PG8_STAGE(PG8_SA(1, 0), cA + kstep, voffA); PG8_STAGE(PG8_SB(1, 1), cB + hstep + kstep, voffB);
        PG8_WAIT_V(6); PG8_BAR;
    }
    for (;;) {
        const bool has_next = S.next(ui + 1, nxt);
        const char* nA = has_next ? (const char*)g.A + (size_t)nxt.pm * tstep : cA; const char* nB = has_next ? (const char*)g.Bt + (size_t)nxt.pn * tstep : cB;
        for (int t = 0; t < nt; t += 2) {
            const bool last = (t == nt - 2);
            const char* a1 = cA + (size_t)(t + 1) * kstep;
            const char* a2 = last ? nA : cA + (size_t)(t + 2) * kstep; const char* b2 = last ? nB : cB + (size_t)(t + 2) * kstep;
            const char* a3 = a2 + kstep; const char* b3 = b2 + kstep;
            if (last && has_next) S.a_ready(nxt);
            if constexpr (SP2) {
            PG8_LDB(B0, 0, 0); PG8_LDB(B1, 0, 1); PG8_SCHED; PG8_LDA(At, 0, 0); PG8_STAGE(PG8_SA(1, 1), a1 + hstep, voffA);
            PG8_WAIT_V(8); PG8_WAIT_L(0); PG8_BAR; PG8_MMA(0, 0, At, B0); PG8_MMA(0, 1, At, B1); PG8_BAR; PG8_SCHED;
            PG8_LDA(At, 0, 1); PG8_STAGE(PG8_SB(0, 0), b2, voffB); PG8_STAGE(PG8_SB(0, 1), b2 + hstep, voffB); PG8_STAGE(PG8_SA(0, 0), a2, voffA);
            PG8_WAIT_V(8); PG8_WAIT_L(0); PG8_BAR; PG8_MMA(1, 0, At, B0); PG8_MMA(1, 1, At, B1); PG8_BAR; PG8_SCHED;
            PG8_LDB(B0, 1, 0); PG8_LDB(B1, 1, 1); PG8_SCHED; PG8_LDA(At, 1, 0); PG8_STAGE(PG8_SA(0, 1), a2 + hstep, voffA);
            PG8_WAIT_V(8); PG8_WAIT_L(0); PG8_BAR; PG8_MMA(0, 0, At, B0); PG8_MMA(0, 1, At, B1); PG8_BAR; PG8_SCHED;
            PG8_LDA(At, 1, 1); PG8_STAGE(PG8_SB(1, 0), b3, voffB); PG8_STAGE(PG8_SB(1, 1), b3 + hstep, voffB); PG8_STAGE(PG8_SA(1, 0), a3, voffA);
            PG8_WAIT_V(8); PG8_WAIT_L(0); PG8_BAR; PG8_MMA(1, 0, At, B0); PG8_MMA(1, 1, At, B1); PG8_BAR; PG8_SCHED;
            } else {
            PG8_LDB(B0, 0, 0); PG8_SCHED; PG8_LDA(At, 0, 0); PG8_STAGE(PG8_SA(1, 1), a1 + hstep, voffA);
            PG8_WAIT_L(8); PG8_BAR; PG8_WAIT_L(0); PG8_MMA(0, 0, At, B0); PG8_BAR; PG8_SCHED;
            PG8_LDB(B1, 0, 1); PG8_STAGE(PG8_SB(0, 0), b2, voffB);
            PG8_BAR; PG8_WAIT_L(0); PG8_MMA(0, 1, At, B1); PG8_BAR;
            PG8_LDA(At, 0, 1); PG8_STAGE(PG8_SA(0, 0), a2, voffA);
            PG8_BAR; PG8_WAIT_L(0); PG8_MMA(1, 0, At, B0); PG8_BAR; PG8_SCHED;
            PG8_STAGE(PG8_SB(0, 1), b2 + hstep, voffB);
            PG8_WAIT_V(6); PG8_BAR; PG8_MMA(1, 1, At, B1); PG8_BAR;
            PG8_LDB(B0, 1, 0); PG8_SCHED; PG8_LDA(At, 1, 0); PG8_STAGE(PG8_SA(0, 1), a2 + hstep, voffA);
            PG8_WAIT_L(8); PG8_BAR; PG8_WAIT_L(0); PG8_MMA(0, 0, At, B0); PG8_BAR; PG8_SCHED;
            PG8_LDB(B1, 1, 1); PG8_STAGE(PG8_SB(1, 0), b3, voffB);
            PG8_BAR; PG8_WAIT_L(0); PG8_MMA(0, 1, At, B1); PG8_BAR;
            PG8_LDA(At, 1, 1); PG8_STAGE(PG8_SA(1, 0), a3, voffA);
            PG8_BAR; PG8_WAIT_L(0); PG8_MMA(1, 0, At, B0); PG8_BAR; PG8_SCHED;
            PG8_STAGE(PG8_SB(1, 1), b3 + hstep, voffB);
            PG8_WAIT_V(6); PG8_BAR; PG8_MMA(1, 1, At, B1); PG8_BAR;
            }
        }
        if constexpr (ALIGN_EPI) { if (wr == 0) PG8_BAR; }
        if constexpr (!Epi::AFTER_DRAIN) { E(acc, cur, wr, wc, fr, fq); S.done(cur); }
        if (!has_next) break;
#pragma unroll
        for (int a = 0; a < 2; ++a)
#pragma unroll
            for (int b = 0; b < 2; ++b)
#pragma unroll
                for (int m = 0; m < 4; ++m)
#pragma unroll
                    for (int n = 0; n < 2; ++n) acc[a][b][m][n] = (f32x4){0.f, 0.f, 0.f, 0.f};
        cur = nxt; cA = nA; cB = nB; ++ui;
        if constexpr (ALIGN_EPI) { if (wr == 1) PG8_BAR; }
    }
    PG8_WAIT_V(0);
    if constexpr (!ALIGN_EPI) { if (wr == 0) PG8_BAR; }
    PG8_BAR;
    if constexpr (Epi::AFTER_DRAIN) { E.fused(acc, cur, wr, wc, fr, fq, lds, wid, lane); S.done(cur); }
#undef PG8_SA
#undef PG8_SB
#undef PG8_STAGE
#undef PG8_LDA
#undef PG8_LDB
#undef PG8_MMA
#undef PG8_WAIT_V
#undef PG8_WAIT_L
#undef PG8_BAR
#undef PG8_SCHED
}
}
namespace attn_body {
using bf16=__hip_bfloat16;
using bf16x8=__attribute__((ext_vector_type(8)))short;
using s16x4=__attribute__((ext_vector_type(4)))short;
using f32x16=__attribute__((ext_vector_type(16)))float;
using u32x4=__attribute__((ext_vector_type(4)))unsigned;
constexpr int BATCH=4,NHEAD=8,SEQ=4096,D=64;
constexpr int PQ=512,PK=128,PO=1024,OCOL=512;
constexpr int NW=8,QBLK=32,QB=QBLK*NW,KVBLK=64,NQB=SEQ/QB;
constexpr int ATTN_UNIT_ROWS=QB;
__device__ __forceinline__ int crow(int r,int hi){return (r&3)+8*(r>>2)+4*hi;}
#define SBAR() __builtin_amdgcn_sched_barrier(0)
__device__ __forceinline__ void cmask(f32x16&p0,f32x16&p1,int jb,int qrel,int hi){
  const float NEG=-INFINITY; int kb=64*jb+4*hi;
  #pragma unroll
  for(int r=0;r<16;++r){int kv=kb+(r&3)+8*(r>>2); if(kv>qrel)p0[r]=NEG; if(kv+32>qrel)p1[r]=NEG;}
}

constexpr int NSLOT=3, SLOTB=8192;
constexpr int LDS_K=0, LDS_V=NSLOT*SLOTB, LDS_WS=2*NSLOT*SLOTB, LDS_OST=LDS_WS+NW*64*4, LDS_BYTES=LDS_OST+NW*4096;
constexpr float C2=0.125f*1.4426950408889634f;
__device__ __forceinline__ void glds16(const void*gsrc,unsigned lds_dst){unsigned keep;
  asm volatile("s_mov_b32 %0, m0\n\ts_mov_b32 m0, %2\n\ts_nop 0\n\tglobal_load_lds_dwordx4 %1, off\n\ts_mov_b32 m0, %0":"=&s"(keep):"v"(gsrc),"s"(lds_dst):"memory");}
__device__ __forceinline__ float max3f(float a,float b,float c){float r;asm("v_max3_f32 %0, %1, %2, %3":"=v"(r):"v"(a),"v"(b),"v"(c));return r;}
__device__ __forceinline__ float max2f(float a,float b){float r;asm("v_max_f32_e32 %0, %1, %2":"=v"(r):"v"(a),"v"(b));return r;}
__device__ __forceinline__ float fadd_s(float a,float b){float r;asm("v_add_f32_e32 %0, %1, %2":"=v"(r):"v"(a),"v"(b));return r;}
__device__ __forceinline__ float fsub_s(float a,float b){float r;asm("v_sub_f32_e32 %0, %1, %2":"=v"(r):"v"(a),"v"(b));return r;}
typedef float f32x2_t __attribute__((ext_vector_type(2))); typedef __bf16 bf16x2_t __attribute__((ext_vector_type(2)));
__device__ __forceinline__ unsigned cvtpk_s(float lo,float hi){f32x2_t v={lo,hi};bf16x2_t b=__builtin_convertvector(v,bf16x2_t);return __builtin_bit_cast(unsigned,b);}
#define WAIT_BAR(N) asm volatile("s_waitcnt vmcnt(" #N ") lgkmcnt(0)\n\ts_barrier":::"memory")

__device__ __forceinline__ void qkt(f32x16&p0,f32x16&p1,const char*Kslot,const bf16x8*qr,const f32x16&negm,int r32,int hi){
  const char*kb=Kslot+hi*1024+r32*16;
  #pragma unroll
  for(int d0=0;d0<4;++d0){
    const bf16x8 b0=*reinterpret_cast<const bf16x8*>(kb+d0*2048);
    const bf16x8 b1=*reinterpret_cast<const bf16x8*>(kb+d0*2048+512);
    if(d0==0){p0=__builtin_amdgcn_mfma_f32_32x32x16_bf16(b0,qr[0],negm,0,0,0);p1=__builtin_amdgcn_mfma_f32_32x32x16_bf16(b1,qr[0],negm,0,0,0);}
    else{p0=__builtin_amdgcn_mfma_f32_32x32x16_bf16(b0,qr[d0],p0,0,0,0);p1=__builtin_amdgcn_mfma_f32_32x32x16_bf16(b1,qr[d0],p1,0,0,0);}}
}
typedef __attribute__((address_space(3))) const char* lds_cptr;
typedef short v4i16_t __attribute__((ext_vector_type(4)));
__device__ __forceinline__ void kload8(bf16x8*kf,lds_cptr kp){
  kf[0]=*(const __attribute__((address_space(3))) bf16x8*)(kp);      kf[1]=*(const __attribute__((address_space(3))) bf16x8*)(kp+512);
  kf[2]=*(const __attribute__((address_space(3))) bf16x8*)(kp+2048); kf[3]=*(const __attribute__((address_space(3))) bf16x8*)(kp+2560);
  kf[4]=*(const __attribute__((address_space(3))) bf16x8*)(kp+4096); kf[5]=*(const __attribute__((address_space(3))) bf16x8*)(kp+4608);
  kf[6]=*(const __attribute__((address_space(3))) bf16x8*)(kp+6144); kf[7]=*(const __attribute__((address_space(3))) bf16x8*)(kp+6656);
}
__device__ __forceinline__ void kload2(bf16x8*kf,lds_cptr kp,int j){ kf[2*j]=*(const __attribute__((address_space(3))) bf16x8*)(kp+j*2048); kf[2*j+1]=*(const __attribute__((address_space(3))) bf16x8*)(kp+j*2048+512); }
__device__ __forceinline__ s16x4 vtr(lds_cptr p){ return __builtin_bit_cast(s16x4,__builtin_amdgcn_ds_read_tr16_b64_v4i16((__attribute__((address_space(3))) v4i16_t*)p)); }
__device__ __forceinline__ float rowmax(const f32x16&p0,const f32x16&p1){
  float a=max3f(p0[0],p0[1],p1[0]),b=max3f(p0[2],p0[3],p1[1]);a=max3f(a,p1[2],p1[3]);
  #pragma unroll
  for(int r=4;r<16;r+=4){a=max3f(a,p0[r],p0[r+1]);b=max3f(b,p0[r+2],p0[r+3]);a=max3f(a,p1[r],p1[r+1]);b=max3f(b,p1[r+2],p1[r+3]);}
  const float m=max2f(a,b);
  auto rr=__builtin_amdgcn_permlane32_swap(__float_as_uint(m),__float_as_uint(m),false,false);
  return max2f(__uint_as_float(rr[0]),__uint_as_float(rr[1]));
}
__device__ __forceinline__ void pv(f32x16*o,int vb,bf16x8 pa0,bf16x8 pa1,bf16x8 pa2,bf16x8 pa3){
  #pragma unroll
  for(int d0=0;d0<2;++d0){s16x4 lo[4],hi[4];
    #pragma unroll
    for(int ks=0;ks<4;++ks){
      asm volatile("ds_read_b64_tr_b16 %0,%1 offset:%c2":"=&v"(lo[ks]):"v"(vb),"i"(d0*4096+ks*1024):"memory");
      asm volatile("ds_read_b64_tr_b16 %0,%1 offset:%c2":"=&v"(hi[ks]):"v"(vb),"i"(d0*4096+ks*1024+512):"memory");}
    asm volatile("s_waitcnt lgkmcnt(0)":::"memory");SBAR();
    #define PK(k) (bf16x8){lo[k][0],lo[k][1],lo[k][2],lo[k][3],hi[k][0],hi[k][1],hi[k][2],hi[k][3]}
    o[d0]=__builtin_amdgcn_mfma_f32_32x32x16_bf16(pa0,PK(0),o[d0],0,0,0);
    o[d0]=__builtin_amdgcn_mfma_f32_32x32x16_bf16(pa1,PK(1),o[d0],0,0,0);
    o[d0]=__builtin_amdgcn_mfma_f32_32x32x16_bf16(pa2,PK(2),o[d0],0,0,0);
    o[d0]=__builtin_amdgcn_mfma_f32_32x32x16_bf16(pa3,PK(3),o[d0],0,0,0);
    #undef PK
  }
}

#ifndef ATTN_STORE16
#define ATTN_STORE16(p,v) (*(u32x4*)(p)=(v))
#endif
template<int THRL> __device__ __forceinline__ void attn_unit(int b,int h,int qb,const bf16*Q,const bf16*__restrict__ K,const bf16*__restrict__ V,bf16*O,char*shm){
  int tid_=threadIdx.x; asm volatile("":"+v"(tid_));
  const int tid=tid_,lane=tid&63,r32=lane&31,hi=lane>>5; const int wid=__builtin_amdgcn_readfirstlane(tid>>6);
  const long rowbase=(long)b*SEQ; const int q0=qb*QB;
  const bf16*Qw=Q+(rowbase+q0+wid*QBLK)*PQ+h*D;
  const bf16*Kh=K+rowbase*PK+(h>>2)*D,*Vh=V+rowbase*PK+(h>>2)*D;
  const unsigned lds0=(unsigned)(uintptr_t)shm;
  float*wsf=(float*)(shm+LDS_WS)+wid*64;
  const bf16*ksrc=Kh+(long)lane*PK+wid*8;
  const bf16*vsrc=Vh+(long)(16*(wid&3)+(lane>>2))*PK+(wid>>2)*32+(lane&3)*8;
  const unsigned kdst=lds0+LDS_K+wid*1024, vdst=lds0+LDS_V+wid*1024;
  #define DMA_K(t,slot) glds16(ksrc+(long)(t)*KVBLK*PK,(unsigned)__builtin_amdgcn_readfirstlane(kdst+(slot)))
  #define DMA_V(t,slot) glds16(vsrc+(long)(t)*KVBLK*PK,(unsigned)__builtin_amdgcn_readfirstlane(vdst+(slot)))
  const int vb0=(int)(lds0+LDS_V)+((lane>>4)&1)*32+(lane&3)*8+(4*hi+((lane&15)>>2))*64;
  const char*Kbase=shm+LDS_K; bf16x8 kf[8];
  const lds_cptr shm3=(lds_cptr)shm; const lds_cptr kp0=shm3+LDS_K+hi*1024+r32*16; const lds_cptr vp0=shm3+LDS_V+((lane>>4)&1)*32+(lane&3)*8+(4*hi+((lane&15)>>2))*64;
  constexpr int NT=SEQ/KVBLK;
  DMA_K(0,0);DMA_V(0,0);DMA_K(1,SLOTB);
  bf16x8 qr[4];
  #pragma unroll
  for(int d0=0;d0<4;++d0)qr[d0]=*reinterpret_cast<const bf16x8*>(&Qw[(long)r32*PQ+d0*16+hi*8]);
  float mhat=0.f,l_reg=0.f;f32x16 o[2];o[0]=f32x16{};o[1]=f32x16{};f32x16 negm=f32x16{};asm volatile("":"+v"(negm));
  #define CMASK(P0,P1,t) do{}while(0)
  bool resc=false;
  #define START(P0,P1) do{ const float rm=rowmax(P0,P1); resc=false; \
    { const float dl=rm; mhat=fadd_s(mhat,dl); \
      _Pragma("unroll") for(int r=0;r<16;++r){P0[r]=fsub_s(P0[r],dl);P1[r]=fsub_s(P1[r],dl);} \
      _Pragma("unroll") for(int r=0;r<16;++r)negm[r]=-mhat; asm volatile("":"+v"(negm)); } \
    _Pragma("unroll") for(int r=0;r<16;++r)P0[r]=__builtin_amdgcn_exp2f(P0[r]); }while(0)
  #define RESC() do{ if(resc){ asm volatile("s_waitcnt lgkmcnt(0)":::"memory"); \
      _Pragma("unroll") for(int d_=0;d_<2;++d_) _Pragma("unroll") for(int r=0;r<16;++r)o[d_][r]*=wsf[crow(r,hi)]; } }while(0)
  f32x16 pA0,pA1,pB0,pB1;
  int sl_prev=0,sl_cur=0,sl_next=SLOTB;
  #define ROT() do{sl_prev=sl_cur;sl_cur=sl_next;sl_next=(sl_next==(NSLOT-1)*SLOTB)?0:sl_next+SLOTB;}while(0)
  DMA_K(2,2*SLOTB);
  WAIT_BAR(3);
  qkt(pA0,pA1,Kbase,qr,negm,r32,hi);asm volatile("s_nop 15\n\ts_nop 7":"+v"(pA0),"+v"(pA1));CMASK(pA0,pA1,0);
  START(pA0,pA1);
  _Pragma("unroll") for(int r=0;r<16;++r)pA1[r]=__builtin_amdgcn_exp2f(pA1[r]);
  WAIT_BAR(0);
  DMA_K(3,0);DMA_V(1,SLOTB);
  ROT();
  kload8(kf,kp0+sl_cur);
  WAIT_BAR(2);
  s16x4 vlo[8],vhi[8]; u32x4 pw0,pw1,pw2,pw3;
  #define PKW(P,B) cvtpk_s(P[B],P[B+1])
  #define PAF(k) __builtin_bit_cast(bf16x8,pw##k)
  #define VFR(i) (bf16x8){vlo[i][0],vlo[i][1],vlo[i][2],vlo[i][3],vhi[i][0],vhi[i][1],vhi[i][2],vhi[i][3]}
  #define PIN(x) asm volatile("":"+v"(x))
  #define MX3(a,b,c) __builtin_fmaxf(__builtin_fmaxf((a),(b)),(c))
  #define GAPA(MF,A0,A1,A2,A3,W0,W1,PW) do{ MF; sacc+=A0; sacc+=A1; sacc+=A2; sacc+=A3; PIN(sacc); W0; W1; PIN(PW); SBAR(); }while(0)
  #define EX(v) __builtin_amdgcn_exp2f(v)
  #define GAPB(MF,X,B) do{ MF; X[B]=EX(X[B]); X[B+1]=EX(X[B+1]); X[B+2]=EX(X[B+2]); X[B+3]=EX(X[B+3]); PIN(X); SBAR(); }while(0)
  #define VRD(i) do{ vlo[i]=vtr(vp_+(((i)>>2)*4096+((i)&3)*1024)); vhi[i]=vtr(vp_+(((i)>>2)*4096+((i)&3)*1024+512)); }while(0)
  #define KRD(G,j) do{ if(G){ kload2(kf,kp0+sl_next,j); SBAR(); } }while(0)
  #define STEP(C0,C1,P0,P1,t,GK,GV,GL) do{ SBAR(); \
    const lds_cptr vp_=vp0+sl_prev; \
    VRD(0); SBAR(); float sacc=(P0[0]+P0[1]); \
    GAPA(C0=__builtin_amdgcn_mfma_f32_32x32x16_bf16(kf[0],qr[0],negm,0,0,0), P0[2],P0[3],P0[4],P0[5],     pw0[0]=PKW(P0,0), pw0[1]=PKW(P0,2), pw0); \
    VRD(4); SBAR(); GAPA(C1=__builtin_amdgcn_mfma_f32_32x32x16_bf16(kf[1],qr[0],negm,0,0,0), P0[6],P0[7],P0[8],P0[9],     pw0[2]=PKW(P0,4), pw0[3]=PKW(P0,6), pw0); \
    VRD(1); SBAR(); GAPA(C0=__builtin_amdgcn_mfma_f32_32x32x16_bf16(kf[2],qr[1],C0,0,0,0),   P0[10],P0[11],P0[12],P0[13], pw1[0]=PKW(P0,8), pw1[1]=PKW(P0,10), pw1); \
    VRD(5); SBAR(); GAPA(C1=__builtin_amdgcn_mfma_f32_32x32x16_bf16(kf[3],qr[1],C1,0,0,0),   P0[14],P0[15],P1[0],P1[1],   pw1[2]=PKW(P0,12),pw1[3]=PKW(P0,14), pw1); \
    VRD(2); SBAR(); GAPA(C0=__builtin_amdgcn_mfma_f32_32x32x16_bf16(kf[4],qr[2],C0,0,0,0),   P1[2],P1[3],P1[4],P1[5],     pw2[0]=PKW(P1,0), pw2[1]=PKW(P1,2), pw2); \
    VRD(6); SBAR(); GAPA(C1=__builtin_amdgcn_mfma_f32_32x32x16_bf16(kf[5],qr[2],C1,0,0,0),   P1[6],P1[7],P1[8],P1[9],     pw2[2]=PKW(P1,4), pw2[3]=PKW(P1,6), pw2); \
    VRD(3); SBAR(); GAPA(C0=__builtin_amdgcn_mfma_f32_32x32x16_bf16(kf[6],qr[3],C0,0,0,0),   P1[10],P1[11],P1[12],P1[13], pw3[0]=PKW(P1,8), pw3[1]=PKW(P1,10), pw3); \
    VRD(7); SBAR(); GAPA(C1=__builtin_amdgcn_mfma_f32_32x32x16_bf16(kf[7],qr[3],C1,0,0,0),   P1[14],P1[15],0.f,0.f,       pw3[2]=PKW(P1,12),pw3[3]=PKW(P1,14), pw3); \
    l_reg+=sacc; \
    if(GK){DMA_K((t)+3,sl_cur);} if(GV){DMA_V((t)+1,sl_next);} \
    CMASK(C0,C1,t); \
    { float a=MX3(C0[0],C0[1],C1[0]),b=MX3(C0[2],C0[3],C1[1]); a=MX3(a,C1[2],C1[3]); \
      _Pragma("unroll") for(int r=4;r<16;r+=4){a=MX3(a,C0[r],C0[r+1]);b=MX3(b,C0[r+2],C0[r+3]);a=MX3(a,C1[r],C1[r+1]);b=MX3(b,C1[r+2],C1[r+3]);} \
      float rm=__builtin_fmaxf(a,b); { auto rr=__builtin_amdgcn_permlane32_swap(__float_as_uint(rm),__float_as_uint(rm),false,false); rm=__builtin_fmaxf(__uint_as_float(rr[0]),__uint_as_float(rr[1])); } \
      resc=false; \
      if(__builtin_expect(__any(rm>(float)THRL),0)){ const float dl=__builtin_fmaxf(rm,0.f); mhat+=dl; \
        _Pragma("unroll") for(int r=0;r<16;++r){C0[r]-=dl;C1[r]-=dl;} \
        _Pragma("unroll") for(int r=0;r<16;++r)negm[r]=-mhat; asm volatile("":"+v"(negm)); \
        const float f=__builtin_amdgcn_exp2f(-dl); l_reg*=f; if(hi==0)wsf[r32]=f; resc=true; } } \
    SBAR(); \
    GAPB(o[0]=__builtin_amdgcn_mfma_f32_32x32x16_bf16(PAF(0),VFR(0),o[0],0,0,0), C0,0); \
    GAPB(o[1]=__builtin_amdgcn_mfma_f32_32x32x16_bf16(PAF(0),VFR(4),o[1],0,0,0), C0,4); \
    KRD(GL,0); GAPB(o[0]=__builtin_amdgcn_mfma_f32_32x32x16_bf16(PAF(1),VFR(1),o[0],0,0,0), C0,8); \
    KRD(GL,1); GAPB(o[1]=__builtin_amdgcn_mfma_f32_32x32x16_bf16(PAF(1),VFR(5),o[1],0,0,0), C0,12); \
    KRD(GL,2); GAPB(o[0]=__builtin_amdgcn_mfma_f32_32x32x16_bf16(PAF(2),VFR(2),o[0],0,0,0), C1,0); \
    KRD(GL,3); GAPB(o[1]=__builtin_amdgcn_mfma_f32_32x32x16_bf16(PAF(2),VFR(6),o[1],0,0,0), C1,4); \
    GAPB(o[0]=__builtin_amdgcn_mfma_f32_32x32x16_bf16(PAF(3),VFR(3),o[0],0,0,0), C1,8); \
    GAPB(o[1]=__builtin_amdgcn_mfma_f32_32x32x16_bf16(PAF(3),VFR(7),o[1],0,0,0), C1,12); \
    }while(0)
  int t=1;
  #undef CMASK
  #define CMASK(P0,P1,t) do{}while(0)
  for(;t+5<NT;t+=2){
    STEP(pB0,pB1,pA0,pA1,t,true,true,true);     WAIT_BAR(2); RESC(); ROT();
    STEP(pA0,pA1,pB0,pB1,t+1,true,true,true);   WAIT_BAR(2); RESC(); ROT();
  }
  #undef CMASK
  #define CMASK(P0,P1,t) do{}while(0)
  #define ENDW(tt) do{ if((tt)+3<NT){WAIT_BAR(2);} else if((tt)+2<NT){WAIT_BAR(1);} else {WAIT_BAR(0);} }while(0)
  for(;t+1<NT;t+=2){
    STEP(pB0,pB1,pA0,pA1,t,(t+3<NT),(t+1<NT),(t+1<NT));       ENDW(t);   RESC(); ROT();
    STEP(pA0,pA1,pB0,pB1,t+1,(t+4<NT),(t+2<NT),(t+2<NT));     ENDW(t+1); RESC(); ROT();
  }
  STEP(pB0,pB1,pA0,pA1,NT-1,false,false,false); RESC();
  { float sacc=pB0[0]+pB0[1]; _Pragma("unroll") for(int r=2;r<16;++r)sacc+=pB0[r]; _Pragma("unroll") for(int r=0;r<16;++r)sacc+=pB1[r]; l_reg+=sacc;
    pw0=(u32x4){PKW(pB0,0),PKW(pB0,2),PKW(pB0,4),PKW(pB0,6)};pw1=(u32x4){PKW(pB0,8),PKW(pB0,10),PKW(pB0,12),PKW(pB0,14)};pw2=(u32x4){PKW(pB1,0),PKW(pB1,2),PKW(pB1,4),PKW(pB1,6)};pw3=(u32x4){PKW(pB1,8),PKW(pB1,10),PKW(pB1,12),PKW(pB1,14)};
    SBAR(); pv(o,vb0+sl_cur,PAF(0),PAF(1),PAF(2),PAF(3)); }
  #undef PKW
  #undef PAF
  #undef VFR
  #undef PIN
  #undef MX3
  #undef GAPA
  #undef GAPB
  #undef EX
  #undef VRD
  #undef KRD
  #undef STEP
  #undef ENDW
  {auto rr=__builtin_amdgcn_permlane32_swap(__float_as_uint(l_reg),__float_as_uint(l_reg),false,false);l_reg=__uint_as_float(rr[0])+__uint_as_float(rr[1]);}
  if(hi==0)wsf[32+r32]=l_reg;asm volatile("s_waitcnt lgkmcnt(0)":::"memory");
  float rli[16];
  #pragma unroll
  for(int r=0;r<16;++r)rli[r]=__builtin_amdgcn_rcpf(wsf[32+crow(r,hi)]);
  bf16*Ow=O+(rowbase+q0+wid*QBLK)*PO+OCOL+h*D;
  { bf16*stg=(bf16*)(shm+LDS_OST)+wid*2048;
    #pragma unroll
    for(int r=0;r<16;++r){const int orow=crow(r,hi);
      #pragma unroll
      for(int d0=0;d0<2;++d0)stg[orow*64+d0*32+r32]=__float2bfloat16(o[d0][r]*rli[r]);}
    asm volatile("s_waitcnt lgkmcnt(0)":::"memory");
    #pragma unroll
    for(int i=0;i<4;++i){const int row=i*8+(lane>>3),ch=lane&7; const u32x4 v=*(const u32x4*)(stg+row*64+ch*8); ATTN_STORE16(Ow+(long)row*PO+ch*8,v);} }
  asm volatile("s_waitcnt lgkmcnt(0)\n\ts_barrier":::"memory");
  #undef DMA_K
  #undef DMA_V
  #undef CMASK
  #undef START
  #undef RESC
  #undef ROT
}
constexpr int ATTN_LDS_BYTES=LDS_BYTES;
struct AttnTensors { const bf16* Q; const bf16* K; const bf16* V; bf16* O; };
struct AttnUnit { int bh; int qb; };
struct StaticOrder {
  int x, j;
  __device__ __forceinline__ explicit StaticOrder(int grid,int block):x(block%8),j(block/8){}
  __device__ __forceinline__ bool next(int i,AttnUnit&u)const{ if(i>=2||j>=32)return false; const int uu=2*j+i; u.bh=(x>>1)*NHEAD+(x&1)*4+(uu>>4); u.qb=uu&15; return true; }
  __device__ __forceinline__ void a_ready(const AttnUnit&)const{}
  __device__ __forceinline__ void done(const AttnUnit&)const{}
};
template<class Sched,int THRL=8> __device__ __forceinline__ void attn_phase(char*lds,const AttnTensors&T,const Sched&S){
  AttnUnit u;
  for(int i=0;S.next(i,u);++i){ S.a_ready(u); attn_unit<THRL>(u.bh/NHEAD,u.bh%NHEAD,u.qb,T.Q,T.K,T.V,T.O,lds); S.done(u); }
}
#undef SBAR
#undef WAIT_BAR
}
#define GAS __attribute__((address_space(1)))
#define LAS __attribute__((address_space(3)))
typedef unsigned short bf16;
typedef unsigned v4u __attribute__((ext_vector_type(4)));
typedef float f32x4 __attribute__((ext_vector_type(4)));
typedef short bf16x8 __attribute__((ext_vector_type(8)));
typedef GAS unsigned gu32;
typedef GAS unsigned long long gu64;
#define RLX_AGENT __ATOMIC_RELAXED, __HIP_MEMORY_SCOPE_AGENT
#define LDS_WAIT() asm volatile("s_waitcnt lgkmcnt(0)" ::: "memory")
#define VM_WAIT() asm volatile("s_waitcnt vmcnt(0)" ::: "memory")
__device__ __forceinline__ unsigned long long rt() { return __builtin_amdgcn_s_memrealtime(); }
__device__ __forceinline__ unsigned f2bf(float f) { unsigned u = __builtin_bit_cast(unsigned, f); return (u + 0x7fffu + ((u >> 16) & 1u)) >> 16; }
__device__ __forceinline__ unsigned pk2(float lo, float hi) { return f2bf(lo) | (f2bf(hi) << 16); }

#define XB_TMO      128
#define XB_XCNT(j)  (256  + 64 * (j))
#define XB_XSUB(j)  (1280 + 64 * (j))
#define XB_XGEN(j)  (2304 + 64 * (j))
#define XB_TOP      3328
#define XB_TOPGEN   3392
#define XCD_BAR_WORDS 3456
#define XB_SPIN_CAP (1u << 18)

__device__ __forceinline__ unsigned xb_ld(unsigned* p)              { return __hip_atomic_load(p, __ATOMIC_RELAXED, __HIP_MEMORY_SCOPE_AGENT); }
__device__ __forceinline__ unsigned xb_add(unsigned* p, unsigned v) { return __hip_atomic_fetch_add(p, v, __ATOMIC_RELAXED, __HIP_MEMORY_SCOPE_AGENT); }
__device__ __forceinline__ unsigned xb_xcc_id() { return (unsigned)__builtin_amdgcn_s_getreg((3 << 11) | 20) & 0xFu; }
#define XB_SPIN(cond, bar) do { unsigned _sp = 0; while (cond) { __builtin_amdgcn_s_sleep(1); \
    if ((++_sp & 255u) == 0u) { if (xb_ld(&(bar)[XB_TMO])) break; if (_sp > XB_SPIN_CAP) { atomicAdd(&(bar)[XB_TMO], 1u); break; } } } } while (0)

struct XcdBarrier {
    unsigned* bar; unsigned x;
    volatile LAS unsigned* st;
};

__device__ __forceinline__ XcdBarrier xcd_barrier_post(unsigned* bar, volatile LAS unsigned* st) {
    XcdBarrier b; b.bar = bar; b.x = xb_xcc_id(); b.st = st;
    if (threadIdx.x == 0) (void)xb_add(&bar[XB_XCNT(b.x)], 1u);
    return b;
}
__device__ __forceinline__ void xcd_barrier_complete(unsigned* bar, unsigned x, unsigned& nloc, unsigned& nx) {
    const unsigned G = gridDim.x * gridDim.y * gridDim.z;
    unsigned sum, cnt, mine, sp = 0u;
    for (;;) {
        sum = 0u; cnt = 0u; mine = 0u;
#pragma unroll
        for (unsigned j = 0; j < 16; ++j) { const unsigned c = xb_ld(&bar[XB_XCNT(j)]); sum += c; cnt += (c > 0u) ? 1u : 0u; mine = (j == x) ? c : mine; }
        if (sum == G) break;
        __builtin_amdgcn_s_sleep(1);
        if ((++sp & 255u) == 0u) { if (xb_ld(&bar[XB_TMO])) break; if (sp > XB_SPIN_CAP) { atomicAdd(&bar[XB_TMO], 1u); break; } }
    }
    nloc = mine > 0u ? mine : 1u; nx = cnt > 0u ? cnt : 1u;
}

__device__ __forceinline__ void xcd_barrier(const XcdBarrier& b) {
    asm volatile("s_waitcnt vmcnt(0)" ::: "memory");
    __syncthreads();
    if (threadIdx.x == 0) {
        unsigned* bar = b.bar;
        __builtin_amdgcn_s_waitcnt(0);
        unsigned nloc = b.st[0], nx = b.st[1];
        if (nloc == 0u) { xcd_barrier_complete(bar, b.x, nloc, nx); b.st[0] = nloc; b.st[1] = nx; }
        const unsigned old = xb_add(&bar[XB_XSUB(b.x)], 1u);
        const unsigned gen = old / nloc;
        if (old + 1u == (gen + 1u) * nloc) {
            __builtin_amdgcn_fence(__ATOMIC_RELEASE, "agent");
            asm volatile("s_waitcnt vmcnt(0)" ::: "memory");
            const unsigned og = xb_add(&bar[XB_TOP], 1u);
            const unsigned tg = og / nx;
            if (og + 1u == (tg + 1u) * nx) xb_add(&bar[XB_TOPGEN], 1u);
            else XB_SPIN(xb_ld(&bar[XB_TOPGEN]) == tg, bar);
            __builtin_amdgcn_fence(__ATOMIC_ACQUIRE, "agent");
            xb_add(&bar[XB_XGEN(b.x)], 1u);
            asm volatile("s_waitcnt vmcnt(0)" ::: "memory");
        } else {
            XB_SPIN(xb_ld(&bar[XB_XGEN(b.x)]) == gen, bar);
            __builtin_amdgcn_fence(__ATOMIC_ACQUIRE, "agent");
            asm volatile("s_waitcnt vmcnt(0)" ::: "memory");
        }
    }
    __syncthreads();
}
#ifndef NAIVE_GQA
#define NAIVE_GQA 0
#endif
#ifndef NAIVE_NA
#define NAIVE_NA 1
#endif
#ifndef NAIVE_MEM
#define NAIVE_MEM 1
#endif
#ifndef PG8_SP2
#define PG8_SP2 true
#endif
#ifndef PG8_ALIGN
#define PG8_ALIGN true
#endif

constexpr int NB = 4, SEQ = 4096, D = 1024, T = NB * SEQ;
constexpr int GW = 64;
constexpr int NINW = 2304, NAW = 512, GQW = 512, KVW = 128;
constexpr int MEML = 256, MEMT = NB * MEML, MEMW = 512;
constexpr int DFF = 2816, DFF2 = 5632;
constexpr float LOG2E = 1.4426950408889634f;
constexpr float QS_NA = 0.125f * LOG2E;
constexpr float QS_G = 0.125f * LOG2E;
constexpr float QS_M = 0.08838834764831845f * LOG2E;
constexpr int NTHREADS = 512, NWAVES = 8;

constexpr size_t MiB = 1u << 20;
constexpr size_t WS_CTL = 0, CTL_ZERO_BYTES = 1 * MiB;
constexpr size_t WS_ROPE = 1 * MiB, WS_SS = 2 * MiB, WS_MSS = 3 * MiB;
constexpr size_t WS_WIN = 4 * MiB, WS_WOUT = 13 * MiB, WS_WMQ = 17 * MiB, WS_WMKV = 19 * MiB, WS_WMO = 23 * MiB, WS_WUP = 25 * MiB, WS_WDN = 47 * MiB;
constexpr size_t WS_XB = 58 * MiB, WS_MXB = 90 * MiB, WS_MKV = 92 * MiB;
constexpr size_t WS_R = 96 * MiB;
constexpr size_t WS_NQ = WS_R, WS_NK = WS_R + 16 * MiB, WS_NV = WS_R + 32 * MiB, WS_GQ = WS_R + 48 * MiB, WS_GK = WS_R + 64 * MiB, WS_GV = WS_R + 68 * MiB, WS_OC = WS_R + 72 * MiB;
constexpr size_t WS_QM = WS_R, WS_OM = WS_R + 16 * MiB;
constexpr size_t WS_UP = WS_R, WS_ACT = WS_R + 64 * MiB, WS_END = 256 * MiB;
static_assert(WS_ACT + (size_t)T * DFF * 2 <= WS_END, "ws map");
constexpr int CW_BAR = 4096;

constexpr int RING_OFF = 0, RING_BYTES = 131072;
constexpr int LDSCTL_OFF = RING_BYTES, MISC_OFF = LDSCTL_OFF + 320;
constexpr int LDS_BYTES = 147456;

__device__ __forceinline__ float wave_sum(float v) {
#pragma unroll
    for (int o = 1; o < 64; o <<= 1) v += __shfl_xor(v, o);
    return v;
}
__device__ __forceinline__ float wave_max(float v) {
#pragma unroll
    for (int o = 1; o < 64; o <<= 1) v = fmaxf(v, __shfl_xor(v, o));
    return v;
}
__device__ __forceinline__ float bf_lo(unsigned w) { return __uint_as_float(w << 16); }
__device__ __forceinline__ float bf_hi(unsigned w) { return __uint_as_float(w & 0xffff0000u); }
__device__ __forceinline__ float bf2f(bf16 h) { return __uint_as_float((unsigned)h << 16); }
__device__ __forceinline__ float rdlane(float v, int l) { return __int_as_float(__builtin_amdgcn_readlane(__float_as_int(v), l)); }

__device__ __forceinline__ int rowmap(int kind, int n) {
    if (kind == 1) {
        if (n < 1536) return n;
        int pn, wc;
        if (n < 2048) { const int hh = (n - 1536) >> 6; pn = 6 + (hh >> 2); wc = hh & 3; }
        else if (n < 2176) { pn = 8; wc = (n - 2048) >> 6; }
        else { pn = 8; wc = 2 + ((n - 2176) >> 6); }
        const int d = n & 63, bj = d >> 5, nn = (d >> 4) & 1, fq = (d >> 2) & 3, e = d & 3;
        return 256 * pn + 128 * bj + 32 * wc + 8 * fq + 4 * nn + e;
    }
    if (kind == 2) { if (n < DFF) return 256 * (n >> 7) + (n & 127); const int ch = n - DFF; return 256 * (ch >> 7) + 128 + (ch & 127); }
    return n;
}
__device__ __forceinline__ void p0_transpose_item(const float* W, int K, int N, const float* gain, int kind, bf16* WT, LAS float* scr, int item, int lane) {
    const int nblk = N / 32, kb = item / nblk, nb = item % nblk, k0 = 64 * kb, n0 = 32 * nb;
#pragma unroll 8
    for (int i = 0; i < 32; ++i) { const int kk = 2 * i + (lane >> 5); const float gk = gain ? gain[k0 + kk] : 1.f; scr[kk * 33 + (lane & 31)] = W[(size_t)(k0 + kk) * N + n0 + (lane & 31)] * gk; }
    LDS_WAIT(); asm volatile("" ::: "memory");
    const int c = lane & 7;
#pragma unroll
    for (int j = 0; j < 4; ++j) { const int n = (lane >> 3) + 8 * j; const LAS float* s = scr + (8 * c) * 33 + n;
        v4u o; o.x = pk2(s[0 * 33], s[1 * 33]); o.y = pk2(s[2 * 33], s[3 * 33]); o.z = pk2(s[4 * 33], s[5 * 33]); o.w = pk2(s[6 * 33], s[7 * 33]);
        *(GAS v4u*)(WT + (size_t)rowmap(kind, n0 + n) * K + k0 + 8 * c) = o; }
    LDS_WAIT(); asm volatile("" ::: "memory");
}
__device__ __forceinline__ void row_to_bf16_ss(const float* xrow, bf16* orow, float* ssrow, int lane) {
    const GAS f32x4* xr = (const GAS f32x4*)xrow + lane;
    f32x4 v[4]; float s = 0.f;
#pragma unroll
    for (int j = 0; j < 4; ++j) { v[j] = xr[64 * j]; s += (v[j].x * v[j].x + v[j].y * v[j].y) + (v[j].z * v[j].z + v[j].w * v[j].w); }
    s = wave_sum(s);
    GAS unsigned long long* o8 = (GAS unsigned long long*)orow + lane;
#pragma unroll
    for (int j = 0; j < 4; ++j) o8[64 * j] = (unsigned long long)pk2(v[j].x, v[j].y) | ((unsigned long long)pk2(v[j].z, v[j].w) << 32);
    if (lane < 16) ssrow[lane] = lane == 0 ? s : 0.f;
}

struct Args { const float* in[19]; float* out; unsigned char* ws; };

__device__ __forceinline__ void na_naive(const bf16* NQ, const bf16* NK, const bf16* NV, bf16* OC, const float* rpb, int gw, int NGW, int lane) {
    for (int task = gw; task < T * 8; task += NGW) {
        const int h = task & 7, t = task >> 3;
        const int b = t >> 12, r = (t >> 6) & 63, c = t & 63;
        const int rs = min(max(r - 4, 0), 56), cs = min(max(c - 8, 0), 48);
        const float q = bf2f(NQ[(size_t)t * 512 + h * 64 + lane]);
        float s[2];
#pragma unroll
        for (int half = 0; half < 2; ++half) {
            const int kk = lane + 64 * half, i = kk >> 4, jj = kk & 15;
            const int tk = (b << 12) + ((rs + i) << 6) + cs + jj;
            const v4u* kp = (const v4u*)(NK + (size_t)tk * 512 + h * 64);
            v4u kv[8];
#pragma unroll
            for (int j = 0; j < 8; ++j) kv[j] = kp[j];
            float a = 0.f;
#pragma unroll
            for (int d = 0; d < 64; d += 2) { const unsigned w = kv[d >> 3][(d >> 1) & 3]; a += rdlane(q, d) * bf_lo(w) + rdlane(q, d + 1) * bf_hi(w); }
            s[half] = a + rpb[(h * 15 + (rs + i - r + 7)) * 31 + (cs + jj - c + 15)] * LOG2E;
        }
        const float m = wave_max(fmaxf(s[0], s[1]));
        const float p0 = exp2f(s[0] - m), p1 = exp2f(s[1] - m);
        const float l = wave_sum(p0 + p1);
        float o = 0.f;
        for (int kk = 0; kk < 64; ++kk) { const int i = kk >> 4, jj = kk & 15; const int tk = (b << 12) + ((rs + i) << 6) + cs + jj;
            o += rdlane(p0, kk) * bf2f(NV[(size_t)tk * 512 + h * 64 + lane]); }
        for (int kk = 0; kk < 64; ++kk) { const int i = 4 + (kk >> 4), jj = kk & 15; const int tk = (b << 12) + ((rs + i) << 6) + cs + jj;
            o += rdlane(p1, kk) * bf2f(NV[(size_t)tk * 512 + h * 64 + lane]); }
        OC[(size_t)t * 1024 + h * 64 + lane] = (bf16)f2bf(o / l);
    }
}
__device__ __forceinline__ void gqa_naive(const bf16* GQ, const bf16* GK, const bf16* GV, bf16* OC, int gw, int NGW, int lane) {
    for (int task = gw; task < T * 8; task += NGW) {
        const int h = task & 7, t = task >> 3, b = t >> 12, kvh = h >> 2;
        const float q = bf2f(GQ[(size_t)t * 512 + h * 64 + lane]);
        float m = -1e30f, l = 0.f, o = 0.f;
        for (int ch = 0; ch < 64; ++ch) {
            const int tk = (b << 12) + ch * 64 + lane;
            const v4u* kp = (const v4u*)(GK + (size_t)tk * 128 + kvh * 64);
            v4u kv[8];
#pragma unroll
            for (int j = 0; j < 8; ++j) kv[j] = kp[j];
            float a = 0.f;
#pragma unroll
            for (int d = 0; d < 64; d += 2) { const unsigned w = kv[d >> 3][(d >> 1) & 3]; a += rdlane(q, d) * bf_lo(w) + rdlane(q, d + 1) * bf_hi(w); }
            const float cm = wave_max(a), mn = fmaxf(m, cm), alpha = exp2f(m - mn), p = exp2f(a - mn);
            l = l * alpha + wave_sum(p); o *= alpha; m = mn;
            const bf16* vp = GV + (size_t)((b << 12) + ch * 64) * 128 + kvh * 64 + lane;
            for (int kk = 0; kk < 64; ++kk) o += rdlane(p, kk) * bf2f(vp[(size_t)kk * 128]);
        }
        OC[(size_t)t * 1024 + 512 + h * 64 + lane] = (bf16)f2bf(o / l);
    }
}
__device__ __forceinline__ void mem_naive(const bf16* QM, const bf16* MK, const bf16* MV, bf16* OM, int gw, int NGW, int lane) {
    for (int task = gw; task < T * 4; task += NGW) {
        const int h = task & 3, t = task >> 2, b = t >> 12;
        const float q0 = bf2f(QM[(size_t)t * 512 + h * 128 + lane]), q1 = bf2f(QM[(size_t)t * 512 + h * 128 + 64 + lane]);
        float s[4];
#pragma unroll
        for (int j = 0; j < 4; ++j) {
            const int row = b * 256 + 64 * j + lane;
            const v4u* kp = (const v4u*)(MK + (size_t)row * 512 + h * 128);
            v4u kv[16];
#pragma unroll
            for (int i = 0; i < 16; ++i) kv[i] = kp[i];
            float a = 0.f;
#pragma unroll
            for (int d = 0; d < 64; d += 2) { const unsigned w = kv[d >> 3][(d >> 1) & 3]; a += rdlane(q0, d) * bf_lo(w) + rdlane(q0, d + 1) * bf_hi(w); }
#pragma unroll
            for (int d = 0; d < 64; d += 2) { const unsigned w = kv[8 + (d >> 3)][(d >> 1) & 3]; a += rdlane(q1, d) * bf_lo(w) + rdlane(q1, d + 1) * bf_hi(w); }
            s[j] = a * QS_M;
        }
        const float m = wave_max(fmaxf(fmaxf(s[0], s[1]), fmaxf(s[2], s[3])));
        float p[4], ps = 0.f;
#pragma unroll
        for (int j = 0; j < 4; ++j) { p[j] = exp2f(s[j] - m); ps += p[j]; }
        const float l = wave_sum(ps);
        float o0 = 0.f, o1 = 0.f;
#pragma unroll
        for (int j = 0; j < 4; ++j) {
            const bf16* vp = MV + (size_t)(b * 256 + 64 * j) * 512 + h * 128 + lane;
            for (int kk = 0; kk < 64; ++kk) { const float pk = rdlane(p[j], kk); o0 += pk * bf2f(vp[(size_t)kk * 512]); o1 += pk * bf2f(vp[(size_t)kk * 512 + 64]); }
        }
        OM[(size_t)t * 512 + h * 128 + lane] = (bf16)f2bf(o0 / l); OM[(size_t)t * 512 + h * 128 + 64 + lane] = (bf16)f2bf(o1 / l);
    }
}
__device__ __forceinline__ void conv_act_pass(const bf16* U, int ntp, int tp0, const float* cw, const float* cb, bf16* ACT, int gtid, int NGT) {
    const int ldu = ntp * 256, nitem = T * ntp * 16;
    for (int it = gtid; it < nitem; it += NGT) {
        const int g8 = it & 15, j = (it >> 4) % ntp, t = (it >> 4) / ntp;
        const int ch = 128 * (tp0 + j) + 8 * g8;
        const bf16* ug = U + (size_t)t * ldu + 256 * j + 8 * g8; const bf16* uv = ug + 128;
        const bool hp = (t & 4095) != 0, hn = (t & 4095) != 4095;
        const v4u z = {0u, 0u, 0u, 0u};
        const v4u g0 = hp ? *(const v4u*)(ug - ldu) : z, g1 = *(const v4u*)ug, g2 = hn ? *(const v4u*)(ug + ldu) : z;
        const v4u v0 = hp ? *(const v4u*)(uv - ldu) : z, v1 = *(const v4u*)uv, v2 = hn ? *(const v4u*)(uv + ldu) : z;
        float r[8];
#pragma unroll
        for (int e = 0; e < 8; ++e) {
            const int c = ch + e; const unsigned sh = e >> 1;
            const float a0 = (e & 1) ? bf_hi(g0[sh]) : bf_lo(g0[sh]), a1 = (e & 1) ? bf_hi(g1[sh]) : bf_lo(g1[sh]), a2 = (e & 1) ? bf_hi(g2[sh]) : bf_lo(g2[sh]);
            const float b0 = (e & 1) ? bf_hi(v0[sh]) : bf_lo(v0[sh]), b1 = (e & 1) ? bf_hi(v1[sh]) : bf_lo(v1[sh]), b2 = (e & 1) ? bf_hi(v2[sh]) : bf_lo(v2[sh]);
            const float gg = a0 * cw[c] + a1 * cw[DFF2 + c] + a2 * cw[2 * DFF2 + c] + cb[c];
            const float vv = b0 * cw[DFF + c] + b1 * cw[DFF2 + DFF + c] + b2 * cw[2 * DFF2 + DFF + c] + cb[DFF + c];
            r[e] = gg / (1.f + __expf(-gg)) * vv;
        }
        v4u o; o.x = pk2(r[0], r[1]); o.y = pk2(r[2], r[3]); o.z = pk2(r[4], r[5]); o.w = pk2(r[6], r[7]);
        *(v4u*)(ACT + (size_t)t * DFF + ch) = o;
    }
}

__device__ __forceinline__ const void* karg(int i) {
    unsigned off = (unsigned)i * 8u; asm volatile("" : "+s"(off));
    return *(const void* const __attribute__((address_space(4)))*)((const char __attribute__((address_space(4)))*)__builtin_amdgcn_kernarg_segment_ptr() + off);
}
#define WSP() ((unsigned char*)karg(20))
#define OUTP() ((float*)karg(19))
#define INP(i) ((const float*)karg(i))
#define WSB(off) ((bf16*)(WSP() + (off)))
#define WSF(off) ((float*)(WSP() + (off)))
struct Ids { int tid, lane, wave, vcu, gw, NGW, gtid, NGT, G, bx; };
__device__ __forceinline__ Ids ids() {
    Ids I; int t = threadIdx.x; asm volatile("" : "+v"(t)); I.tid = t; I.lane = t & 63; I.wave = __builtin_amdgcn_readfirstlane(t >> 6);
    I.G = gridDim.x; I.bx = blockIdx.x; I.vcu = (I.G % 8 == 0) ? (I.bx % 8) * (I.G / 8) + I.bx / 8 : I.bx;
    I.gw = I.vcu * NWAVES + I.wave; I.NGW = I.G * NWAVES; I.gtid = I.vcu * NTHREADS + I.tid; I.NGT = I.G * NTHREADS; return I;
}
__device__ __forceinline__ void grid_bar(LAS unsigned char* L) {
    XcdBarrier b; b.bar = (unsigned*)(WSP() + WS_CTL) + CW_BAR; b.x = xb_xcc_id(); b.st = (volatile LAS unsigned*)(L + MISC_OFF) + 8;
    xcd_barrier(b);
}
__global__ void __launch_bounds__(NTHREADS, 2) mk_fwd(Args args) {
    extern __shared__ __attribute__((aligned(16))) unsigned char lds[];
    LAS unsigned char* L = (LAS unsigned char*)lds;
    {
        const int tid = threadIdx.x;
        for (int u = tid; u < (LDS_BYTES - LDSCTL_OFF) / 4; u += NTHREADS) ((LAS unsigned*)(L + LDSCTL_OFF))[u] = 0u;
        __syncthreads();
        (void)xcd_barrier_post((unsigned*)(WSP() + WS_CTL) + CW_BAR, (volatile LAS unsigned*)(L + MISC_OFF) + 8);
    }
#define GRID_BAR() grid_bar(L)

    {
        const Ids I = ids(); const int lane = I.lane;
        LAS float* scr = (LAS float*)(L + RING_OFF + I.wave * 16384);
        constexpr int I_IN = 16 * (NINW / 32), I_OUT = 16 * 32, I_MQ = 16 * 16, I_MKV = 16 * 32, I_MO = 8 * 32, I_UP = 16 * (DFF2 / 32), I_DN = 44 * 32;
        constexpr int I_L = I_IN + I_OUT + I_MQ + I_MKV + I_MO + I_UP + I_DN;
        for (int it = I.gw; it < 2 * I_L; it += I.NGW) {
            const int l = it / I_L; int r = it % I_L;
            if (r < I_IN) { p0_transpose_item(INP(3) + (size_t)l * D * NINW, D, NINW, INP(2) + l * D, 1, WSB(WS_WIN) + (size_t)l * NINW * D, scr, r, lane); continue; } r -= I_IN;
            if (r < I_OUT) { p0_transpose_item(INP(7) + (size_t)l * D * D, D, D, nullptr, 0, WSB(WS_WOUT) + (size_t)l * D * D, scr, r, lane); continue; } r -= I_OUT;
            if (r < I_MQ) { p0_transpose_item(INP(10) + (size_t)l * D * MEMW, D, MEMW, INP(8) + l * D, 0, WSB(WS_WMQ) + (size_t)l * MEMW * D, scr, r, lane); continue; } r -= I_MQ;
            if (r < I_MKV) { p0_transpose_item(INP(11) + (size_t)l * D * 1024, D, 1024, INP(9) + l * D, 0, WSB(WS_WMKV) + (size_t)l * 1024 * D, scr, r, lane); continue; } r -= I_MKV;
            if (r < I_MO) { p0_transpose_item(INP(12) + (size_t)l * MEMW * D, MEMW, D, nullptr, 0, WSB(WS_WMO) + (size_t)l * D * MEMW, scr, r, lane); continue; } r -= I_MO;
            if (r < I_UP) { p0_transpose_item(INP(14) + (size_t)l * D * DFF2, D, DFF2, INP(13) + l * D, 2, WSB(WS_WUP) + (size_t)l * DFF2 * D, scr, r, lane); continue; } r -= I_UP;
            p0_transpose_item(INP(17) + (size_t)l * DFF * D, DFF, D, nullptr, 0, WSB(WS_WDN) + (size_t)l * D * DFF, scr, r, lane);
        }
        { const float* x_in = INP(0); bf16* XB = WSB(WS_XB); float* SS = WSF(WS_SS);
          for (int m = I.gw; m < T; m += I.NGW) row_to_bf16_ss(x_in + (size_t)m * D, XB + (size_t)m * D, SS + (size_t)m * 16, lane); }
        { const float* mem_in = INP(1); bf16* MXB = WSB(WS_MXB); float* MSS = WSF(WS_MSS);
          for (int m = I.gw; m < MEMT; m += I.NGW) row_to_bf16_ss(mem_in + (size_t)m * D, MXB + (size_t)m * D, MSS + (size_t)m * 16, lane); }
        if (I.bx == 0) { float* ROPE = WSF(WS_ROPE); for (int i = I.tid; i < 1024; i += NTHREADS) { const int pos = i >> 4, f = i & 15;
            const float inv_freq = powf(10000.0f, -(float)f / 16.0f); const float ang = (float)pos * inv_freq;
            ROPE[pos * 32 + f] = cosf(ang); ROPE[pos * 32 + 16 + f] = sinf(ang); } }
    }
    GRID_BAR();

    {
        pg8::Gemm g{WSB(WS_MXB), WSB(WS_WMKV), MEMT, 2048, D}; pg8::StaticOrder S; S.init(MEMT, 2048, gridDim.x, blockIdx.x);
        pg8::EpiSB E{WSB(WS_MKV), MEMW, WSF(WS_MSS), 512, (size_t)MEMT * MEMW, 1.f};
        pg8::gemm_phase<pg8::EpiSB, pg8::StaticOrder, PG8_ALIGN, PG8_SP2>(L + RING_OFF, g, S, E);
    }

    for (int l = 0; l < 2; ++l) {
        {
            pg8::Gemm g{WSB(WS_XB), WSB(WS_WIN) + (size_t)l * NINW * D, T, NINW, D}; pg8::StaticOrder S; S.init(T, NINW, gridDim.x, blockIdx.x);
            pg8::EpiInProj E{WSF(WS_SS), WSB(WS_NQ), (size_t)T * 512, WSB(WS_GQ), WSB(WS_GK), WSB(WS_GV), WSF(WS_ROPE), INP(5) + l * 64, INP(6) + l * 64, QS_NA, QS_G};
            pg8::gemm_phase<pg8::EpiInProj, pg8::StaticOrder, PG8_ALIGN, PG8_SP2>(L + RING_OFF, g, S, E);
        }
        GRID_BAR();
        { const Ids I = ids(); na_naive(WSB(WS_NQ), WSB(WS_NK), WSB(WS_NV), WSB(WS_OC), INP(4) + (size_t)l * 8 * 15 * 31, I.gw, I.NGW, I.lane); }
#if NAIVE_GQA
        { const Ids I = ids(); gqa_naive(WSB(WS_GQ), WSB(WS_GK), WSB(WS_GV), WSB(WS_OC), I.gw, I.NGW, I.lane); }
#else
        { const attn_body::AttnTensors AT{(const attn_body::bf16*)WSB(WS_GQ), (const attn_body::bf16*)WSB(WS_GK), (const attn_body::bf16*)WSB(WS_GV), (attn_body::bf16*)WSB(WS_OC)};
          const attn_body::StaticOrder S((int)gridDim.x, (int)blockIdx.x);
          attn_body::attn_phase<attn_body::StaticOrder>((char*)lds + RING_OFF, AT, S); }
#endif
        GRID_BAR();
        {
            pg8::Gemm g{WSB(WS_OC), WSB(WS_WOUT) + (size_t)l * D * D, T, D, D}; pg8::StaticOrder S; S.init(T, D, gridDim.x, blockIdx.x);
            pg8::EpiRes E{l == 0 ? INP(0) : (const float*)OUTP(), OUTP(), WSB(WS_XB), WSF(WS_SS)};
            pg8::gemm_phase<pg8::EpiRes, pg8::StaticOrder, PG8_ALIGN, PG8_SP2>(L + RING_OFF, g, S, E);
        }
        GRID_BAR();
        {
            pg8::Gemm g{WSB(WS_XB), WSB(WS_WMQ) + (size_t)l * MEMW * D, T, MEMW, D}; pg8::StaticOrder S; S.init(T, MEMW, gridDim.x, blockIdx.x);
            pg8::EpiSB E{WSB(WS_QM), MEMW, WSF(WS_SS), 0, 0, 1.f};
            pg8::gemm_phase<pg8::EpiSB, pg8::StaticOrder, PG8_ALIGN, PG8_SP2>(L + RING_OFF, g, S, E);
        }
        GRID_BAR();
        { const Ids I = ids(); const bf16* MK = WSB(WS_MKV) + (size_t)l * 2 * MEMT * MEMW;
          mem_naive(WSB(WS_QM), MK, MK + (size_t)MEMT * MEMW, WSB(WS_OM), I.gw, I.NGW, I.lane); }
        GRID_BAR();
        {
            pg8::Gemm g{WSB(WS_OM), WSB(WS_WMO) + (size_t)l * D * MEMW, T, D, MEMW}; pg8::StaticOrder S; S.init(T, D, gridDim.x, blockIdx.x);
            pg8::EpiRes E{OUTP(), OUTP(), WSB(WS_XB), WSF(WS_SS)};
            pg8::gemm_phase<pg8::EpiRes, pg8::StaticOrder, PG8_ALIGN, PG8_SP2>(L + RING_OFF, g, S, E);
        }
        GRID_BAR();
        for (int p = 0; p < 3; ++p) {
            const int tp0 = 8 * p, ntp = p < 2 ? 8 : 6;
            {
                pg8::Gemm g{WSB(WS_XB), WSB(WS_WUP) + (size_t)l * DFF2 * D + (size_t)tp0 * 256 * D, T, ntp * 256, D}; pg8::StaticOrder S; S.init(T, ntp * 256, gridDim.x, blockIdx.x);
                pg8::EpiSB E{WSB(WS_UP), ntp * 256, WSF(WS_SS), 0, 0, 1.f};
                pg8::gemm_phase<pg8::EpiSB, pg8::StaticOrder, PG8_ALIGN, PG8_SP2>(L + RING_OFF, g, S, E);
            }
            GRID_BAR();
            { const Ids I = ids(); conv_act_pass(WSB(WS_UP), ntp, tp0, INP(15) + (size_t)l * 3 * DFF2, INP(16) + (size_t)l * DFF2, WSB(WS_ACT), I.gtid, I.NGT); }
            GRID_BAR();
        }
        {
            pg8::Gemm g{WSB(WS_ACT), WSB(WS_WDN) + (size_t)l * D * DFF, T, D, DFF}; pg8::StaticOrder S; S.init(T, D, gridDim.x, blockIdx.x);
            pg8::EpiRes E{OUTP(), OUTP(), WSB(WS_XB), WSF(WS_SS)};
            pg8::gemm_phase<pg8::EpiRes, pg8::StaticOrder, PG8_ALIGN, PG8_SP2>(L + RING_OFF, g, S, E);
        }
        GRID_BAR();
    }
    {
        const Ids I = ids(); const int lane = I.lane;
        const float* gf = INP(18); float* X = OUTP();
        for (int m = I.gw; m < T; m += I.NGW) {
            GAS f32x4* xr = (GAS f32x4*)(X + (size_t)m * D) + lane;
            f32x4 v[4]; float s = 0.f;
#pragma unroll
            for (int j = 0; j < 4; ++j) { v[j] = xr[64 * j]; s += (v[j].x * v[j].x + v[j].y * v[j].y) + (v[j].z * v[j].z + v[j].w * v[j].w); }
            const float rs = 1.0f / sqrtf(wave_sum(s) * (1.0f / D) + 1e-6f);
#pragma unroll
            for (int j = 0; j < 4; ++j) { const f32x4 gg = *((const f32x4*)gf + lane + 64 * j); xr[64 * j] = v[j] * rs * gg; }
        }
    }
}

extern "C" void kernel_launch(void* const* d_in, const int* in_sizes, int n_in, void* d_out, int out_size, void* d_ws, size_t ws_size, hipStream_t stream) {
    static int grid = 0;
    if (grid == 0) {
        if (n_in != 19 || in_sizes[0] != T * D || out_size != T * D || ws_size < WS_END) { fprintf(stderr, "kernel_launch: shape mismatch n_in %d in0 %d out %d ws %zu\n", n_in, n_in > 0 ? in_sizes[0] : -1, out_size, ws_size); grid = -1; return; }
        int dev = 0, cus = 0;
        if (hipGetDevice(&dev) != hipSuccess || hipDeviceGetAttribute(&cus, hipDeviceAttributeMultiprocessorCount, dev) != hipSuccess) { grid = -1; return; }
        if (hipFuncSetAttribute((const void*)mk_fwd, hipFuncAttributeMaxDynamicSharedMemorySize, LDS_BYTES) != hipSuccess) { fprintf(stderr, "kernel_launch: hipFuncSetAttribute failed\n"); grid = -1; return; }
        int per_cu = 0;
        if (hipOccupancyMaxActiveBlocksPerMultiprocessor(&per_cu, (const void*)mk_fwd, NTHREADS, LDS_BYTES) != hipSuccess || per_cu < 1) fprintf(stderr, "kernel_launch: occupancy query says %d\n", per_cu);
        (void)hipGetLastError();
        grid = cus;
    }
    if (grid < 0) return;
    if (hipMemsetAsync((char*)d_ws + WS_CTL, 0, CTL_ZERO_BYTES, stream) != hipSuccess) { fprintf(stderr, "kernel_launch: memset failed\n"); return; }
    Args a{};
    for (int i = 0; i < 19; ++i) a.in[i] = (const float*)d_in[i];
    a.out = (float*)d_out; a.ws = (unsigned char*)d_ws;
    hipLaunchKernelGGL(mk_fwd, dim3(grid), dim3(NTHREADS), LDS_BYTES, stream, a);
    const hipError_t le = hipPeekAtLastError();
    if (le != hipSuccess) fprintf(stderr, "kernel_launch: launch failed: %s\n", hipGetErrorName(le));
}
```

```cpp
#include <hip/hip_runtime.h>
#include <hip/hip_bf16.h>
#include <cstdio>
#include <cstdint>
#include <cmath>
namespace pg8 {
#define PG8_LAS __attribute__((address_space(3)))
typedef unsigned short bf16_t;
typedef short bf16x8 __attribute__((ext_vector_type(8)));
typedef float f32x4 __attribute__((ext_vector_type(4)));
typedef unsigned u32x4 __attribute__((ext_vector_type(4)));
constexpr int BM = 256, BK = 64, HALF = 128, HTB = HALF * BK * 2  , STAGE_BYTES = 8 * HTB, NXCD = 8, WGM = 8;

__host__ __device__ __forceinline__ int lds_byte(int r, int c) { const int st = (r >> 4) * 2 + (c >> 5), rr = r & 15, cc = c & 31, ob = rr * 64 + cc * 2; return st * 1024 + (ob ^ (((ob >> 9) & 1) << 5)); }
__host__ __device__ __forceinline__ void stage_rc(int b, int& R, int& C) { const int st = b / 1024, sb = b % 1024, swz = sb ^ (((sb >> 9) & 1) << 5); R = (st >> 1) * 16 + swz / 64; C = (st & 1) * 32 + (swz % 64) / 2; }
__host__ __device__ __forceinline__ int perm32(int rho) { const int n = rho >> 4, i = rho & 15; return 8 * (i >> 2) + 4 * n + (i & 3); }

struct Unit { int pm, pn; };
struct Gemm { const bf16_t* A; const bf16_t* Bt; int M, N, K; };

struct StaticOrder {
    int nM, nN, nwg, G, c;
    __host__ __device__ void init(int M, int N, int G_, int c_) { nM = M / BM; nN = N / BM; nwg = nM * nN; G = G_; c = c_; }
    __host__ __device__ bool next(int i, Unit& u) const {
        const long L = (long)i * G + c; if (L >= nwg) return false;
        int wgid = (int)L; { const int q = nwg / NXCD, r = nwg % NXCD, xcd = wgid % NXCD, off = wgid / NXCD; wgid = (xcd < r ? xcd * (q + 1) : r * (q + 1) + (xcd - r) * q) + off; }
        const int nig = WGM * nN, gid = wgid / nig, fm = gid * WGM, gsz = (nM - fm) < WGM ? (nM - fm) : WGM;
        u.pm = fm + ((wgid % nig) % gsz); u.pn = (wgid % nig) / gsz; return true;
    }
    __device__ __forceinline__ void a_ready(const Unit&) const {}
    __device__ __forceinline__ void done(const Unit&) const {}
};

__device__ __forceinline__ unsigned cvt_pk_bf16(float lo, float hi) { unsigned r; asm volatile("v_cvt_pk_bf16_f32 %0, %1, %2" : "=v"(r) : "v"(lo), "v"(hi)); return r; }
typedef float f32x2 __attribute__((ext_vector_type(2)));
typedef unsigned u32x2 __attribute__((ext_vector_type(2)));
__device__ __forceinline__ float row_rs(const float* SS, int row, int fq) {
    const f32x4 v = *(const f32x4*)(SS + (size_t)row * 16 + fq * 4);
    float s = (v[0] + v[1]) + (v[2] + v[3]);
    s += __shfl_xor(s, 16); s += __shfl_xor(s, 32);
    return __builtin_amdgcn_rsqf(s * (1.0f / 1024.0f) + 1e-6f);
}
struct EpiSB {
    static constexpr bool PERM = true, AFTER_DRAIN = false;
    bf16_t* O; int ldc; const float* SS; int split_cols; size_t split_stride; float scale0;
    __device__ __forceinline__ void operator()(const f32x4 (&acc)[2][2][4][2], const Unit& u, int wr, int wc, int fr, int fq) const {
        const int row0 = u.pm * BM + wr * 64 + fr; int colt = u.pn * BM; bf16_t* base = O;
        float sc = 1.f; if (split_cols) { const int t = colt / split_cols; base += (size_t)t * split_stride; colt -= t * split_cols; if (t == 0) sc = scale0; }
        const int col0 = colt + wc * 32 + 8 * fq;
#pragma unroll
        for (int ai = 0; ai < 2; ++ai)
#pragma unroll
            for (int m = 0; m < 4; ++m) { const int row = row0 + ai * HALF + m * 16; const float rs = SS ? row_rs(SS, row, fq) * sc : sc;
                bf16_t* rowp = base + (size_t)row * ldc + col0;
#pragma unroll
                for (int bj = 0; bj < 2; ++bj) { const f32x4 v0 = acc[ai][bj][m][0] * rs, v1 = acc[ai][bj][m][1] * rs;
                    u32x4 w; w.x = cvt_pk_bf16(v0[0], v0[1]); w.y = cvt_pk_bf16(v0[2], v0[3]); w.z = cvt_pk_bf16(v1[0], v1[1]); w.w = cvt_pk_bf16(v1[2], v1[3]);
                    *(u32x4*)(rowp + bj * HALF) = w; } }
    }
};
struct EpiRes {
    static constexpr bool PERM = true, AFTER_DRAIN = false;
    const float* xold; float* xnew; bf16_t* xb; float* SSo;
    __device__ __forceinline__ void operator()(const f32x4 (&acc)[2][2][4][2], const Unit& u, int wr, int wc, int fr, int fq) const {
        const int row0 = u.pm * BM + wr * 64 + fr, col0 = u.pn * BM + wc * 32 + 8 * fq;
#pragma unroll
        for (int ai = 0; ai < 2; ++ai)
#pragma unroll
            for (int m = 0; m < 4; ++m) { const int row = row0 + ai * HALF + m * 16; const size_t off = (size_t)row * 1024 + col0; float ssq = 0.f;
#pragma unroll
                for (int bj = 0; bj < 2; ++bj) {
                    const f32x4 a0 = *(const f32x4*)(xold + off + bj * HALF), a1 = *(const f32x4*)(xold + off + bj * HALF + 4);
                    const f32x4 v0 = a0 + acc[ai][bj][m][0], v1 = a1 + acc[ai][bj][m][1];
                    *(f32x4*)(xnew + off + bj * HALF) = v0; *(f32x4*)(xnew + off + bj * HALF + 4) = v1;
                    u32x4 w; w.x = cvt_pk_bf16(v0[0], v0[1]); w.y = cvt_pk_bf16(v0[2], v0[3]); w.z = cvt_pk_bf16(v1[0], v1[1]); w.w = cvt_pk_bf16(v1[2], v1[3]);
                    *(u32x4*)(xb + off + bj * HALF) = w;
                    ssq += (v0[0] * v0[0] + v0[1] * v0[1]) + (v0[2] * v0[2] + v0[3] * v0[3]) + (v1[0] * v1[0] + v1[1] * v1[1]) + (v1[2] * v1[2] + v1[3] * v1[3]); }
                ssq += __shfl_xor(ssq, 16); ssq += __shfl_xor(ssq, 32);
                if (fq == 0) SSo[(size_t)row * 16 + u.pn * 4 + wc] = ssq; }
    }
};
struct EpiInProj {
    static constexpr bool PERM = true, AFTER_DRAIN = false;
    const float* SS; bf16_t* NQKV; size_t nstride; bf16_t* GQ; bf16_t* GK; bf16_t* GV; const float* rope; const float* qn; const float* kn; float qs_na, qs_g;
    __device__ __forceinline__ void operator()(const f32x4 (&acc)[2][2][4][2], const Unit& u, int wr, int wc, int fr, int fq) const {
        const int row0 = u.pm * BM + wr * 64 + fr;
        if (u.pn < 6) {
            bf16_t* base = NQKV + (size_t)(u.pn >> 1) * nstride; const int col0 = (u.pn & 1) * 256 + wc * 32 + 8 * fq; const float sc = u.pn < 2 ? qs_na : 1.f;
#pragma unroll
            for (int ai = 0; ai < 2; ++ai)
#pragma unroll
                for (int m = 0; m < 4; ++m) { const int row = row0 + ai * HALF + m * 16; const float rs = row_rs(SS, row, fq) * sc;
                    bf16_t* rowp = base + (size_t)row * 512 + col0;
#pragma unroll
                    for (int bj = 0; bj < 2; ++bj) { const f32x4 v0 = acc[ai][bj][m][0] * rs, v1 = acc[ai][bj][m][1] * rs;
                        u32x4 w; w.x = cvt_pk_bf16(v0[0], v0[1]); w.y = cvt_pk_bf16(v0[2], v0[3]); w.z = cvt_pk_bf16(v1[0], v1[1]); w.w = cvt_pk_bf16(v1[2], v1[3]);
                        *(u32x4*)(rowp + bj * HALF) = w; } }
            return;
        }
        const bool isq = u.pn < 8, isv = (u.pn == 8) && (wc >= 2);
        bf16_t* dst; int ld; const float* gain; float post;
        if (isq) { dst = GQ + (4 * (u.pn - 6) + wc) * 64; ld = 512; gain = qn; post = qs_g; }
        else if (!isv) { dst = GK + wc * 64; ld = 128; gain = kn; post = 1.f; }
        else { dst = GV + (wc - 2) * 64; ld = 128; gain = kn; post = 1.f; }
        f32x4 g[2][2];
#pragma unroll
        for (int bj = 0; bj < 2; ++bj)
#pragma unroll
            for (int n = 0; n < 2; ++n) g[bj][n] = *(const f32x4*)(gain + 32 * bj + 16 * n + 4 * fq) * post;
#pragma unroll
        for (int ai = 0; ai < 2; ++ai)
#pragma unroll
            for (int m = 0; m < 4; ++m) { const int row = row0 + ai * HALF + m * 16; const float rs = row_rs(SS, row, fq);
                f32x4 v[2][2]; float ssq = 0.f;
#pragma unroll
                for (int bj = 0; bj < 2; ++bj)
#pragma unroll
                    for (int n = 0; n < 2; ++n) { v[bj][n] = acc[ai][bj][m][n] * rs; const f32x4 x = v[bj][n]; ssq += (x[0] * x[0] + x[1] * x[1]) + (x[2] * x[2] + x[3] * x[3]); }
                bf16_t* rowp = dst + (size_t)row * ld;
                if (!isv) {
                    ssq += __shfl_xor(ssq, 16); ssq += __shfl_xor(ssq, 32);
                    const float inv = __builtin_amdgcn_rsqf(ssq * (1.0f / 64.0f) + 1e-6f);
                    const int pos0 = (row & 4095) >> 6, pos1 = row & 63;
#pragma unroll
                    for (int bj = 0; bj < 2; ++bj) { const int pos = bj == 0 ? pos0 : pos1;
                        const f32x4 c = *(const f32x4*)(rope + pos * 32 + 4 * fq), s = *(const f32x4*)(rope + pos * 32 + 16 + 4 * fq);
                        const f32x4 x1 = v[bj][0] * inv * g[bj][0], x2 = v[bj][1] * inv * g[bj][1];
                        v[bj][0] = x1 * c - x2 * s; v[bj][1] = x1 * s + x2 * c; }
                }
#pragma unroll
                for (int bj = 0; bj < 2; ++bj)
#pragma unroll
                    for (int n = 0; n < 2; ++n) { u32x2 w; w.x = cvt_pk_bf16(v[bj][n][0], v[bj][n][1]); w.y = cvt_pk_bf16(v[bj][n][2], v[bj][n][3]);
                        *(u32x2*)(rowp + 32 * bj + 16 * n + 4 * fq) = w; } }
    }
};

template <class Epi, class Sched, bool ALIGN_EPI = false, bool SP2 = false>
__device__ __forceinline__ void gemm_phase(PG8_LAS unsigned char* lds, const Gemm g, const Sched& S, const Epi& E) {
    int tid_ = threadIdx.x; asm volatile("" : "+v"(tid_));
    const int tid = tid_, wid = __builtin_amdgcn_readfirstlane(tid >> 6), lane = tid & 63, wr = wid >> 2, wc = wid & 3, fr = lane & 15, fq = lane >> 4;
    const int K = g.K, nt = K / BK;
    unsigned voffA[2], voffB[2];
#pragma unroll
    for (int i = 0; i < 2; ++i) { int R, C; stage_rc(tid * 16 + i * 8192, R, C); const int Rb = Epi::PERM ? ((R & ~31) + perm32(R & 31)) : R;
        voffA[i] = (unsigned)(R * K + C) * 2u; voffB[i] = (unsigned)(Rb * K + C) * 2u; }
    const size_t kstep = (size_t)(BK * 2);
    const size_t hstep = (size_t)HALF * K * 2;
    const size_t tstep = 2 * hstep;
    const unsigned ldsw = (unsigned)wid * 1024u;
    const int aoff = lds_byte(wr * 64 + fr, fq * 8), boff = lds_byte(wc * 32 + fr, fq * 8);
#define PG8_SA(b, h) (((b) * 2 + (h)) * HTB)
#define PG8_SB(b, h) ((4 + (b) * 2 + (h)) * HTB)
#define PG8_STAGE(bufoff, gbase, voff) do { _Pragma("unroll") for (int _i = 0; _i < 2; ++_i) \
        __builtin_amdgcn_global_load_lds((const unsigned*)((const char*)(gbase) + (voff)[_i]), (PG8_LAS unsigned*)(lds + (bufoff) + ldsw + _i * 8192), 16, 0, 0); } while (0)
#define PG8_LDA(dst, b, h) do { _Pragma("unroll") for (int m = 0; m < 4; ++m) _Pragma("unroll") for (int k = 0; k < 2; ++k) dst[m][k] = *(const PG8_LAS bf16x8*)(lds + PG8_SA(b, h) + aoff + m * 2048 + k * 1024); } while (0)
#define PG8_LDB(dst, b, h) do { _Pragma("unroll") for (int n = 0; n < 2; ++n) _Pragma("unroll") for (int k = 0; k < 2; ++k) dst[n][k] = *(const PG8_LAS bf16x8*)(lds + PG8_SB(b, h) + boff + n * 2048 + k * 1024); } while (0)
#define PG8_MMA(ai, bj, At, Bt) do { __builtin_amdgcn_s_setprio(1); _Pragma("unroll") for (int m = 0; m < 4; ++m) _Pragma("unroll") for (int n = 0; n < 2; ++n) _Pragma("unroll") for (int k = 0; k < 2; ++k) \
        acc[ai][bj][m][n] = __builtin_amdgcn_mfma_f32_16x16x32_bf16(Bt[n][k], At[m][k], acc[ai][bj][m][n], 0, 0, 0); __builtin_amdgcn_s_setprio(0); } while (0)
#define PG8_WAIT_V(n) asm volatile("s_waitcnt vmcnt(" #n ")" ::: "memory")
#define PG8_WAIT_L(n) asm volatile("s_waitcnt lgkmcnt(" #n ")" ::: "memory")
#define PG8_BAR __builtin_amdgcn_s_barrier()
#define PG8_SCHED __builtin_amdgcn_sched_barrier(0)
    Unit cur, nxt; int ui = 0;
    if (!S.next(0, cur)) return;
    f32x4 acc[2][2][4][2];
#pragma unroll
    for (int a = 0; a < 2; ++a)
#pragma unroll
        for (int b = 0; b < 2; ++b)
#pragma unroll
            for (int m = 0; m < 4; ++m)
#pragma unroll
                for (int n = 0; n < 2; ++n) acc[a][b][m][n] = (f32x4){0.f, 0.f, 0.f, 0.f};
    bf16x8 At[4][2], B0[2][2], B1[2][2];
    const char* cA = (const char*)g.A + (size_t)cur.pm * tstep; const char* cB = (const char*)g.Bt + (size_t)cur.pn * tstep;
    S.a_ready(cur);
    if constexpr (SP2) {
        PG8_STAGE(PG8_SB(0, 0), cB, voffB); PG8_STAGE(PG8_SB(0, 1), cB + hstep, voffB); PG8_STAGE(PG8_SA(0, 0), cA, voffA); PG8_STAGE(PG8_SA(0, 1), cA + hstep, voffA);
        if (wr == 1) PG8_BAR;
        PG8_WAIT_V(2); PG8_BAR;
        PG8_STAGE(PG8_SB(1, 0), cB + kstep, voffB); PG8_STAGE(PG8_SA(1, 0), cA + kstep, voffA); PG8_STAGE(PG8_SB(1, 1), cB + hstep + kstep, voffB);
        PG8_WAIT_V(6); PG8_BAR;
    } else {
        PG8_STAGE(PG8_SB(0, 0), cB, voffB); PG8_STAGE(PG8_SA(0, 0), cA, voffA); PG8_STAGE(PG8_SB(0, 1), cB + hstep, voffB); PG8_STAGE(PG8_SA(0, 1), cA + hstep, voffA);
        if (wr == 1) PG8_BAR;
        PG8_WAIT_V(4); PG8_BAR;
        PG8_STAGE(PG8_SB(1, 0), cB + kstep, voffB); PG8_STAGE(PG8_SA(1, 0), cA + kstep, voffA); PG8_STAGE(PG8_SB(1, 1), cB + hstep + kstep, voffB);
        PG8_WAIT_V(6); PG8_BAR;
    }
    for (;;) {
        const bool has_next = S.next(ui + 1, nxt);
        const char* nA = has_next ? (const char*)g.A + (size_t)nxt.pm * tstep : cA; const char* nB = has_next ? (const char*)g.Bt + (size_t)nxt.pn * tstep : cB;
        for (int t = 0; t < nt; t += 2) {
            const bool last = (t == nt - 2);
            const char* a1 = cA + (size_t)(t + 1) * kstep;
            const char* a2 = last ? nA : cA + (size_t)(t + 2) * kstep; const char* b2 = last ? nB : cB + (size_t)(t + 2) * kstep;
            const char* a3 = a2 + kstep; const char* b3 = b2 + kstep;
            if (last && has_next) S.a_ready(nxt);
            if constexpr (SP2) {
            PG8_LDB(B0, 0, 0); PG8_LDB(B1, 0, 1); PG8_SCHED; PG8_LDA(At, 0, 0); PG8_STAGE(PG8_SA(1, 1), a1 + hstep, voffA);
            PG8_WAIT_V(8); PG8_WAIT_L(0); PG8_BAR; PG8_MMA(0, 0, At, B0); PG8_MMA(0, 1, At, B1); PG8_BAR; PG8_SCHED;
            PG8_LDA(At, 0, 1); PG8_STAGE(PG8_SB(0, 0), b2, voffB); PG8_STAGE(PG8_SB(0, 1), b2 + hstep, voffB); PG8_STAGE(PG8_SA(0, 0), a2, voffA);
            PG8_WAIT_V(8); PG8_WAIT_L(0); PG8_BAR; PG8_MMA(1, 0, At, B0); PG8_MMA(1, 1, At, B1); PG8_BAR; PG8_SCHED;
            PG8_LDB(B0, 1, 0); PG8_LDB(B1, 1, 1); PG8_SCHED; PG8_LDA(At, 1, 0); PG8_STAGE(PG8_SA(0, 1), a2 + hstep, voffA);
            PG8_WAIT_V(8); PG8_WAIT_L(0); PG8_BAR; PG8_MMA(0, 0, At, B0); PG8_MMA(0, 1, At, B1); PG8_BAR; PG8_SCHED;
            PG8_LDA(At, 1, 1); PG8_STAGE(PG8_SB(1, 0), b3, voffB); PG8_STAGE(PG8_SB(1, 1), b3 + hstep, voffB); PG8_STAGE(PG8_SA(1, 0), a3, voffA);
            PG8_WAIT_V(8); PG8_WAIT_L(0); PG8_BAR; PG8_MMA(1, 0, At, B0); PG8_MMA(1, 1, At, B1); PG8_BAR; PG8_SCHED;
            } else {
            PG8_LDB(B0, 0, 0); PG8_SCHED; PG8_LDA(At, 0, 0); PG8_STAGE(PG8_SA(1, 1), a1 + hstep, voffA);
            PG8_WAIT_L(8); PG8_BAR; PG8_WAIT_L(0); PG8_MMA(0, 0, At, B0); PG8_BAR; PG8_SCHED;
            PG8_LDB(B1, 0, 1); PG8_STAGE(PG8_SB(0, 0), b2, voffB);
            PG8_BAR; PG8_WAIT_L(0); PG8_MMA(0, 1, At, B1); PG8_BAR;
            PG8_LDA(At, 0, 1); PG8_STAGE(PG8_SA(0, 0), a2, voffA);
            PG8_BAR; PG8_WAIT_L(0); PG8_MMA(1, 0, At, B0); PG8_BAR; PG8_SCHED;
            PG8_STAGE(PG8_SB(0, 1), b2 + hstep, voffB);
            PG8_WAIT_V(6); PG8_BAR; PG8_MMA(1, 1, At, B1); PG8_BAR;
            PG8_LDB(B0, 1, 0); PG8_SCHED; PG8_LDA(At, 1, 0); PG8_STAGE(PG8_SA(0, 1), a2 + hstep, voffA);
            PG8_WAIT_L(8); PG8_BAR; PG8_WAIT_L(0); PG8_MMA(0, 0, At, B0); PG8_BAR; PG8_SCHED;
            PG8_LDB(B1, 1, 1); PG8_STAGE(PG8_SB(1, 0), b3, voffB);
            PG8_BAR; PG8_WAIT_L(0); PG8_MMA(0, 1, At, B1); PG8_BAR;
            PG8_LDA(At, 1, 1); PG8_STAGE(PG8_SA(1, 0), a3, voffA);
            PG8_BAR; PG8_WAIT_L(0); PG8_MMA(1, 0, At, B0); PG8_BAR; PG8_SCHED;
            PG8_STAGE(PG8_SB(1, 1), b3 + hstep, voffB);
            PG8_WAIT_V(6); PG8_BAR; PG8_MMA(1, 1, At, B1); PG8_BAR;
            }
        }
        if constexpr (ALIGN_EPI) { if (wr == 0) PG8_BAR; }
        if constexpr (!Epi::AFTER_DRAIN) { E(acc, cur, wr, wc, fr, fq); S.done(cur); }
        if (!has_next) break;
#pragma unroll
        for (int a = 0; a < 2; ++a)
#pragma unroll
            for (int b = 0; b < 2; ++b)
#pragma unroll
                for (int m = 0; m < 4; ++m)
#pragma unroll
                    for (int n = 0; n < 2; ++n) acc[a][b][m][n] = (f32x4){0.f, 0.f, 0.f, 0.f};
        cur = nxt; cA = nA; cB = nB; ++ui;
        if constexpr (ALIGN_EPI) { if (wr == 1) PG8_BAR; }
    }
    PG8_WAIT_V(0);
    if constexpr (!ALIGN_EPI) { if (wr == 0) PG8_BAR; }
    PG8_BAR;
    if constexpr (Epi::AFTER_DRAIN) { E.fused(acc, cur, wr, wc, fr, fq, lds, wid, lane); S.done(cur); }
#undef PG8_SA
#undef PG8_SB
#undef PG8_STAGE
#undef PG8_LDA
#undef PG8_LDB
#undef PG8_MMA
#undef PG8_WAIT_V
#undef PG8_WAIT_L
#undef PG8_BAR
#undef PG8_SCHED
}
}
namespace attn_body {
using bf16=__hip_bfloat16;
using bf16x8=__attribute__((ext_vector_type(8)))short;
using s16x4=__attribute__((ext_vector_type(4)))short;
using f32x16=__attribute__((ext_vector_type(16)))float;
using u32x4=__attribute__((ext_vector_type(4)))unsigned;
constexpr int BATCH=4,NHEAD=8,SEQ=4096,D=64;
constexpr int PQ=512,PK=128,PO=1024,OCOL=512;
constexpr int NW=8,QBLK=32,QB=QBLK*NW,KVBLK=64,NQB=SEQ/QB;
constexpr int ATTN_UNIT_ROWS=QB;
__device__ __forceinline__ int crow(int r,int hi){return (r&3)+8*(r>>2)+4*hi;}
#define SBAR() __builtin_amdgcn_sched_barrier(0)
__device__ __forceinline__ void cmask(f32x16&p0,f32x16&p1,int jb,int qrel,int hi){
  const float NEG=-INFINITY; int kb=64*jb+4*hi;
  #pragma unroll
  for(int r=0;r<16;++r){int kv=kb+(r&3)+8*(r>>2); if(kv>qrel)p0[r]=NEG; if(kv+32>qrel)p1[r]=NEG;}
}

constexpr int NSLOT=3, SLOTB=8192;
constexpr int LDS_K=0, LDS_V=NSLOT*SLOTB, LDS_WS=2*NSLOT*SLOTB, LDS_OST=LDS_WS+NW*64*4, LDS_BYTES=LDS_OST+NW*4096;
constexpr float C2=0.125f*1.4426950408889634f;
__device__ __forceinline__ void glds16(const void*gsrc,unsigned lds_dst){unsigned keep;
  asm volatile("s_mov_b32 %0, m0\n\ts_mov_b32 m0, %2\n\ts_nop 0\n\tglobal_load_lds_dwordx4 %1, off\n\ts_mov_b32 m0, %0":"=&s"(keep):"v"(gsrc),"s"(lds_dst):"memory");}
__device__ __forceinline__ float max3f(float a,float b,float c){float r;asm("v_max3_f32 %0, %1, %2, %3":"=v"(r):"v"(a),"v"(b),"v"(c));return r;}
__device__ __forceinline__ float max2f(float a,float b){float r;asm("v_max_f32_e32 %0, %1, %2":"=v"(r):"v"(a),"v"(b));return r;}
__device__ __forceinline__ float fadd_s(float a,float b){float r;asm("v_add_f32_e32 %0, %1, %2":"=v"(r):"v"(a),"v"(b));return r;}
__device__ __forceinline__ float fsub_s(float a,float b){float r;asm("v_sub_f32_e32 %0, %1, %2":"=v"(r):"v"(a),"v"(b));return r;}
typedef float f32x2_t __attribute__((ext_vector_type(2))); typedef __bf16 bf16x2_t __attribute__((ext_vector_type(2)));
__device__ __forceinline__ unsigned cvtpk_s(float lo,float hi){f32x2_t v={lo,hi};bf16x2_t b=__builtin_convertvector(v,bf16x2_t);return __builtin_bit_cast(unsigned,b);}
#define WAIT_BAR(N) asm volatile("s_waitcnt vmcnt(" #N ") lgkmcnt(0)\n\ts_barrier":::"memory")

__device__ __forceinline__ void qkt(f32x16&p0,f32x16&p1,const char*Kslot,const bf16x8*qr,const f32x16&negm,int r32,int hi){
  const char*kb=Kslot+hi*1024+r32*16;
  #pragma unroll
  for(int d0=0;d0<4;++d0){
    const bf16x8 b0=*reinterpret_cast<const bf16x8*>(kb+d0*2048);
    const bf16x8 b1=*reinterpret_cast<const bf16x8*>(kb+d0*2048+512);
    if(d0==0){p0=__builtin_amdgcn_mfma_f32_32x32x16_bf16(b0,qr[0],negm,0,0,0);p1=__builtin_amdgcn_mfma_f32_32x32x16_bf16(b1,qr[0],negm,0,0,0);}
    else{p0=__builtin_amdgcn_mfma_f32_32x32x16_bf16(b0,qr[d0],p0,0,0,0);p1=__builtin_amdgcn_mfma_f32_32x32x16_bf16(b1,qr[d0],p1,0,0,0);}}
}
typedef __attribute__((address_space(3))) const char* lds_cptr;
typedef short v4i16_t __attribute__((ext_vector_type(4)));
__device__ __forceinline__ void kload8(bf16x8*kf,lds_cptr kp){
  kf[0]=*(const __attribute__((address_space(3))) bf16x8*)(kp);      kf[1]=*(const __attribute__((address_space(3))) bf16x8*)(kp+512);
  kf[2]=*(const __attribute__((address_space(3))) bf16x8*)(kp+2048); kf[3]=*(const __attribute__((address_space(3))) bf16x8*)(kp+2560);
  kf[4]=*(const __attribute__((address_space(3))) bf16x8*)(kp+4096); kf[5]=*(const __attribute__((address_space(3))) bf16x8*)(kp+4608);
  kf[6]=*(const __attribute__((address_space(3))) bf16x8*)(kp+6144); kf[7]=*(const __attribute__((address_space(3))) bf16x8*)(kp+6656);
}
__device__ __forceinline__ void kload2(bf16x8*kf,lds_cptr kp,int j){ kf[2*j]=*(const __attribute__((address_space(3))) bf16x8*)(kp+j*2048); kf[2*j+1]=*(const __attribute__((address_space(3))) bf16x8*)(kp+j*2048+512); }
__device__ __forceinline__ s16x4 vtr(lds_cptr p){ return __builtin_bit_cast(s16x4,__builtin_amdgcn_ds_read_tr16_b64_v4i16((__attribute__((address_space(3))) v4i16_t*)p)); }
__device__ __forceinline__ float rowmax(const f32x16&p0,const f32x16&p1){
  float a=max3f(p0[0],p0[1],p1[0]),b=max3f(p0[2],p0[3],p1[1]);a=max3f(a,p1[2],p1[3]);
  #pragma unroll
  for(int r=4;r<16;r+=4){a=max3f(a,p0[r],p0[r+1]);b=max3f(b,p0[r+2],p0[r+3]);a=max3f(a,p1[r],p1[r+1]);b=max3f(b,p1[r+2],p1[r+3]);}
  const float m=max2f(a,b);
  auto rr=__builtin_amdgcn_permlane32_swap(__float_as_uint(m),__float_as_uint(m),false,false);
  return max2f(__uint_as_float(rr[0]),__uint_as_float(rr[1]));
}
__device__ __forceinline__ void pv(f32x16*o,int vb,bf16x8 pa0,bf16x8 pa1,bf16x8 pa2,bf16x8 pa3){
  #pragma unroll
  for(int d0=0;d0<2;++d0){s16x4 lo[4],hi[4];
    #pragma unroll
    for(int ks=0;ks<4;++ks){
      asm volatile("ds_read_b64_tr_b16 %0,%1 offset:%c2":"=&v"(lo[ks]):"v"(vb),"i"(d0*4096+ks*1024):"memory");
      asm volatile("ds_read_b64_tr_b16 %0,%1 offset:%c2":"=&v"(hi[ks]):"v"(vb),"i"(d0*4096+ks*1024+512):"memory");}
    asm volatile("s_waitcnt lgkmcnt(0)":::"memory");SBAR();
    #define PK(k) (bf16x8){lo[k][0],lo[k][1],lo[k][2],lo[k][3],hi[k][0],hi[k][1],hi[k][2],hi[k][3]}
    o[d0]=__builtin_amdgcn_mfma_f32_32x32x16_bf16(pa0,PK(0),o[d0],0,0,0);
    o[d0]=__builtin_amdgcn_mfma_f32_32x32x16_bf16(pa1,PK(1),o[d0],0,0,0);
    o[d0]=__builtin_amdgcn_mfma_f32_32x32x16_bf16(pa2,PK(2),o[d0],0,0,0);
    o[d0]=__builtin_amdgcn_mfma_f32_32x32x16_bf16(pa3,PK(3),o[d0],0,0,0);
    #undef PK
  }
}

#ifndef ATTN_STORE16
#define ATTN_STORE16(p,v) (*(u32x4*)(p)=(v))
#endif
template<int THRL> __device__ __forceinline__ void attn_unit(int b,int h,int qb,const bf16*Q,const bf16*__restrict__ K,const bf16*__restrict__ V,bf16*O,char*shm){
  int tid_=threadIdx.x; asm volatile("":"+v"(tid_));
  const int tid=tid_,lane=tid&63,r32=lane&31,hi=lane>>5; const int wid=__builtin_amdgcn_readfirstlane(tid>>6);
  const long rowbase=(long)b*SEQ; const int q0=qb*QB;
  const bf16*Qw=Q+(rowbase+q0+wid*QBLK)*PQ+h*D;
  const bf16*Kh=K+rowbase*PK+(h>>2)*D,*Vh=V+rowbase*PK+(h>>2)*D;
  const unsigned lds0=(unsigned)(uintptr_t)shm;
  float*wsf=(float*)(shm+LDS_WS)+wid*64;
  const bf16*ksrc=Kh+(long)lane*PK+wid*8;
  const bf16*vsrc=Vh+(long)(16*(wid&3)+(lane>>2))*PK+(wid>>2)*32+(lane&3)*8;
  const unsigned kdst=lds0+LDS_K+wid*1024, vdst=lds0+LDS_V+wid*1024;
  #define DMA_K(t,slot) glds16(ksrc+(long)(t)*KVBLK*PK,(unsigned)__builtin_amdgcn_readfirstlane(kdst+(slot)))
  #define DMA_V(t,slot) glds16(vsrc+(long)(t)*KVBLK*PK,(unsigned)__builtin_amdgcn_readfirstlane(vdst+(slot)))
  const int vb0=(int)(lds0+LDS_V)+((lane>>4)&1)*32+(lane&3)*8+(4*hi+((lane&15)>>2))*64;
  const char*Kbase=shm+LDS_K; bf16x8 kf[8];
  const lds_cptr shm3=(lds_cptr)shm; const lds_cptr kp0=shm3+LDS_K+hi*1024+r32*16; const lds_cptr vp0=shm3+LDS_V+((lane>>4)&1)*32+(lane&3)*8+(4*hi+((lane&15)>>2))*64;
  constexpr int NT=SEQ/KVBLK;
  DMA_K(0,0);DMA_V(0,0);DMA_K(1,SLOTB);
  bf16x8 qr[4];
  #pragma unroll
  for(int d0=0;d0<4;++d0)qr[d0]=*reinterpret_cast<const bf16x8*>(&Qw[(long)r32*PQ+d0*16+hi*8]);
  float mhat=0.f,l_reg=0.f;f32x16 o[2];o[0]=f32x16{};o[1]=f32x16{};f32x16 negm=f32x16{};asm volatile("":"+v"(negm));
  #define CMASK(P0,P1,t) do{}while(0)
  bool resc=false;
  #define START(P0,P1) do{ const float rm=rowmax(P0,P1); resc=false; \
    { const float dl=rm; mhat=fadd_s(mhat,dl); \
      _Pragma("unroll") for(int r=0;r<16;++r){P0[r]=fsub_s(P0[r],dl);P1[r]=fsub_s(P1[r],dl);} \
      _Pragma("unroll") for(int r=0;r<16;++r)negm[r]=-mhat; asm volatile("":"+v"(negm)); } \
    _Pragma("unroll") for(int r=0;r<16;++r)P0[r]=__builtin_amdgcn_exp2f(P0[r]); }while(0)
  #define RESC() do{ if(resc){ asm volatile("s_waitcnt lgkmcnt(0)":::"memory"); \
      _Pragma("unroll") for(int d_=0;d_<2;++d_) _Pragma("unroll") for(int r=0;r<16;++r)o[d_][r]*=wsf[crow(r,hi)]; } }while(0)
  f32x16 pA0,pA1,pB0,pB1;
  int sl_prev=0,sl_cur=0,sl_next=SLOTB;
  #define ROT() do{sl_prev=sl_cur;sl_cur=sl_next;sl_next=(sl_next==(NSLOT-1)*SLOTB)?0:sl_next+SLOTB;}while(0)
  DMA_K(2,2*SLOTB);
  WAIT_BAR(3);
  qkt(pA0,pA1,Kbase,qr,negm,r32,hi);asm volatile("s_nop 15\n\ts_nop 7":"+v"(pA0),"+v"(pA1));CMASK(pA0,pA1,0);
  START(pA0,pA1);
  _Pragma("unroll") for(int r=0;r<16;++r)pA1[r]=__builtin_amdgcn_exp2f(pA1[r]);
  WAIT_BAR(0);
  DMA_K(3,0);DMA_V(1,SLOTB);
  ROT();
  kload8(kf,kp0+sl_cur);
  WAIT_BAR(2);
  s16x4 vlo[8],vhi[8]; u32x4 pw0,pw1,pw2,pw3;
  #define PKW(P,B) cvtpk_s(P[B],P[B+1])
  #define PAF(k) __builtin_bit_cast(bf16x8,pw##k)
  #define VFR(i) (bf16x8){vlo[i][0],vlo[i][1],vlo[i][2],vlo[i][3],vhi[i][0],vhi[i][1],vhi[i][2],vhi[i][3]}
  #define PIN(x) asm volatile("":"+v"(x))
  #define MX3(a,b,c) __builtin_fmaxf(__builtin_fmaxf((a),(b)),(c))
  #define GAPA(MF,A0,A1,A2,A3,W0,W1,PW) do{ MF; sacc+=A0; sacc+=A1; sacc+=A2; sacc+=A3; PIN(sacc); W0; W1; PIN(PW); SBAR(); }while(0)
  #define EX(v) __builtin_amdgcn_exp2f(v)
  #define GAPB(MF,X,B) do{ MF; X[B]=EX(X[B]); X[B+1]=EX(X[B+1]); X[B+2]=EX(X[B+2]); X[B+3]=EX(X[B+3]); PIN(X); SBAR(); }while(0)
  #define VRD(i) do{ vlo[i]=vtr(vp_+(((i)>>2)*4096+((i)&3)*1024)); vhi[i]=vtr(vp_+(((i)>>2)*4096+((i)&3)*1024+512)); }while(0)
  #define KRD(G,j) do{ if(G){ kload2(kf,kp0+sl_next,j); SBAR(); } }while(0)
  #define STEP(C0,C1,P0,P1,t,GK,GV,GL) do{ SBAR(); \
    const lds_cptr vp_=vp0+sl_prev; \
    VRD(0); SBAR(); float sacc=(P0[0]+P0[1]); \
    GAPA(C0=__builtin_amdgcn_mfma_f32_32x32x16_bf16(kf[0],qr[0],negm,0,0,0), P0[2],P0[3],P0[4],P0[5],     pw0[0]=PKW(P0,0), pw0[1]=PKW(P0,2), pw0); \
    VRD(4); SBAR(); GAPA(C1=__builtin_amdgcn_mfma_f32_32x32x16_bf16(kf[1],qr[0],negm,0,0,0), P0[6],P0[7],P0[8],P0[9],     pw0[2]=PKW(P0,4), pw0[3]=PKW(P0,6), pw0); \
    VRD(1); SBAR(); GAPA(C0=__builtin_amdgcn_mfma_f32_32x32x16_bf16(kf[2],qr[1],C0,0,0,0),   P0[10],P0[11],P0[12],P0[13], pw1[0]=PKW(P0,8), pw1[1]=PKW(P0,10), pw1); \
    VRD(5); SBAR(); GAPA(C1=__builtin_amdgcn_mfma_f32_32x32x16_bf16(kf[3],qr[1],C1,0,0,0),   P0[14],P0[15],P1[0],P1[1],   pw1[2]=PKW(P0,12),pw1[3]=PKW(P0,14), pw1); \
    VRD(2); SBAR(); GAPA(C0=__builtin_amdgcn_mfma_f32_32x32x16_bf16(kf[4],qr[2],C0,0,0,0),   P1[2],P1[3],P1[4],P1[5],     pw2[0]=PKW(P1,0), pw2[1]=PKW(P1,2), pw2); \
    VRD(6); SBAR(); GAPA(C1=__builtin_amdgcn_mfma_f32_32x32x16_bf16(kf[5],qr[2],C1,0,0,0),   P1[6],P1[7],P1[8],P1[9],     pw2[2]=PKW(P1,4), pw2[3]=PKW(P1,6), pw2); \
    VRD(3); SBAR(); GAPA(C0=__builtin_amdgcn_mfma_f32_32x32x16_bf16(kf[6],qr[3],C0,0,0,0),   P1[10],P1[11],P1[12],P1[13], pw3[0]=PKW(P1,8), pw3[1]=PKW(P1,10), pw3); \
    VRD(7); SBAR(); GAPA(C1=__builtin_amdgcn_mfma_f32_32x32x16_bf16(kf[7],qr[3],C1,0,0,0),   P1[14],P1[15],0.f,0.f,       pw3[2]=PKW(P1,12),pw3[3]=PKW(P1,14), pw3); \
    l_reg+=sacc; \
    if(GK){DMA_K((t)+3,sl_cur);} if(GV){DMA_V((t)+1,sl_next);} \
    CMASK(C0,C1,t); \
    { float a=MX3(C0[0],C0[1],C1[0]),b=MX3(C0[2],C0[3],C1[1]); a=MX3(a,C1[2],C1[3]); \
      _Pragma("unroll") for(int r=4;r<16;r+=4){a=MX3(a,C0[r],C0[r+1]);b=MX3(b,C0[r+2],C0[r+3]);a=MX3(a,C1[r],C1[r+1]);b=MX3(b,C1[r+2],C1[r+3]);} \
      float rm=__builtin_fmaxf(a,b); { auto rr=__builtin_amdgcn_permlane32_swap(__float_as_uint(rm),__float_as_uint(rm),false,false); rm=__builtin_fmaxf(__uint_as_float(rr[0]),__uint_as_float(rr[1])); } \
      resc=false; \
      if(__builtin_expect(__any(rm>(float)THRL),0)){ const float dl=__builtin_fmaxf(rm,0.f); mhat+=dl; \
        _Pragma("unroll") for(int r=0;r<16;++r){C0[r]-=dl;C1[r]-=dl;} \
        _Pragma("unroll") for(int r=0;r<16;++r)negm[r]=-mhat; asm volatile("":"+v"(negm)); \
        const float f=__builtin_amdgcn_exp2f(-dl); l_reg*=f; if(hi==0)wsf[r32]=f; resc=true; } } \
    SBAR(); \
    GAPB(o[0]=__builtin_amdgcn_mfma_f32_32x32x16_bf16(PAF(0),VFR(0),o[0],0,0,0), C0,0); \
    GAPB(o[1]=__builtin_amdgcn_mfma_f32_32x32x16_bf16(PAF(0),VFR(4),o[1],0,0,0), C0,4); \
    KRD(GL,0); GAPB(o[0]=__builtin_amdgcn_mfma_f32_32x32x16_bf16(PAF(1),VFR(1),o[0],0,0,0), C0,8); \
    KRD(GL,1); GAPB(o[1]=__builtin_amdgcn_mfma_f32_32x32x16_bf16(PAF(1),VFR(5),o[1],0,0,0), C0,12); \
    KRD(GL,2); GAPB(o[0]=__builtin_amdgcn_mfma_f32_32x32x16_bf16(PAF(2),VFR(2),o[0],0,0,0), C1,0); \
    KRD(GL,3); GAPB(o[1]=__builtin_amdgcn_mfma_f32_32x32x16_bf16(PAF(2),VFR(6),o[1],0,0,0), C1,4); \
    GAPB(o[0]=__builtin_amdgcn_mfma_f32_32x32x16_bf16(PAF(3),VFR(3),o[0],0,0,0), C1,8); \
    GAPB(o[1]=__builtin_amdgcn_mfma_f32_32x32x16_bf16(PAF(3),VFR(7),o[1],0,0,0), C1,12); \
    }while(0)
  int t=1;
  #undef CMASK
  #define CMASK(P0,P1,t) do{}while(0)
  for(;t+5<NT;t+=2){
    STEP(pB0,pB1,pA0,pA1,t,true,true,true);     WAIT_BAR(2); RESC(); ROT();
    STEP(pA0,pA1,pB0,pB1,t+1,true,true,true);   WAIT_BAR(2); RESC(); ROT();
  }
  #undef CMASK
  #define CMASK(P0,P1,t) do{}while(0)
  #define ENDW(tt) do{ if((tt)+3<NT){WAIT_BAR(2);} else if((tt)+2<NT){WAIT_BAR(1);} else {WAIT_BAR(0);} }while(0)
  for(;t+1<NT;t+=2){
    STEP(pB0,pB1,pA0,pA1,t,(t+3<NT),(t+1<NT),(t+1<NT));       ENDW(t);   RESC(); ROT();
    STEP(pA0,pA1,pB0,pB1,t+1,(t+4<NT),(t+2<NT),(t+2<NT));     ENDW(t+1); RESC(); ROT();
  }
  STEP(pB0,pB1,pA0,pA1,NT-1,false,false,false); RESC();
  { float sacc=pB0[0]+pB0[1]; _Pragma("unroll") for(int r=2;r<16;++r)sacc+=pB0[r]; _Pragma("unroll") for(int r=0;r<16;++r)sacc+=pB1[r]; l_reg+=sacc;
    pw0=(u32x4){PKW(pB0,0),PKW(pB0,2),PKW(pB0,4),PKW(pB0,6)};pw1=(u32x4){PKW(pB0,8),PKW(pB0,10),PKW(pB0,12),PKW(pB0,14)};pw2=(u32x4){PKW(pB1,0),PKW(pB1,2),PKW(pB1,4),PKW(pB1,6)};pw3=(u32x4){PKW(pB1,8),PKW(pB1,10),PKW(pB1,12),PKW(pB1,14)};
    SBAR(); pv(o,vb0+sl_cur,PAF(0),PAF(1),PAF(2),PAF(3)); }
  #undef PKW
  #undef PAF
  #undef VFR
  #undef PIN
  #undef MX3
  #undef GAPA
  #undef GAPB
  #undef EX
  #undef VRD
  #undef KRD
  #undef STEP
  #undef ENDW
  {auto rr=__builtin_amdgcn_permlane32_swap(__float_as_uint(l_reg),__float_as_uint(l_reg),false,false);l_reg=__uint_as_float(rr[0])+__uint_as_float(rr[1]);}
  if(hi==0)wsf[32+r32]=l_reg;asm volatile("s_waitcnt lgkmcnt(0)":::"memory");
  float rli[16];
  #pragma unroll
  for(int r=0;r<16;++r)rli[r]=__builtin_amdgcn_rcpf(wsf[32+crow(r,hi)]);
  bf16*Ow=O+(rowbase+q0+wid*QBLK)*PO+OCOL+h*D;
  { bf16*stg=(bf16*)(shm+LDS_OST)+wid*2048;
    #pragma unroll
    for(int r=0;r<16;++r){const int orow=crow(r,hi);
      #pragma unroll
      for(int d0=0;d0<2;++d0)stg[orow*64+d0*32+r32]=__float2bfloat16(o[d0][r]*rli[r]);}
    asm volatile("s_waitcnt lgkmcnt(0)":::"memory");
    #pragma unroll
    for(int i=0;i<4;++i){const int row=i*8+(lane>>3),ch=lane&7; const u32x4 v=*(const u32x4*)(stg+row*64+ch*8); ATTN_STORE16(Ow+(long)row*PO+ch*8,v);} }
  asm volatile("s_waitcnt lgkmcnt(0)\n\ts_barrier":::"memory");
  #undef DMA_K
  #undef DMA_V
  #undef CMASK
  #undef START
  #undef RESC
  #undef ROT
}
constexpr int ATTN_LDS_BYTES=LDS_BYTES;
struct AttnTensors { const bf16* Q; const bf16* K; const bf16* V; bf16* O; };
struct AttnUnit { int bh; int qb; };
struct StaticOrder {
  int x, j;
  __device__ __forceinline__ explicit StaticOrder(int grid,int block):x(block%8),j(block/8){}
  __device__ __forceinline__ bool next(int i,AttnUnit&u)const{ if(i>=2||j>=32)return false; const int uu=2*j+i; u.bh=(x>>1)*NHEAD+(x&1)*4+(uu>>4); u.qb=uu&15; return true; }
  __device__ __forceinline__ void a_ready(const AttnUnit&)const{}
  __device__ __forceinline__ void done(const AttnUnit&)const{}
};
template<class Sched,int THRL=8> __device__ __forceinline__ void attn_phase(char*lds,const AttnTensors&T,const Sched&S){
  AttnUnit u;
  for(int i=0;S.next(i,u);++i){ S.a_ready(u); attn_unit<THRL>(u.bh/NHEAD,u.bh%NHEAD,u.qb,T.Q,T.K,T.V,T.O,lds); S.done(u); }
}
#undef SBAR
#undef WAIT_BAR
}
namespace memattn {
using bf16 = __hip_bfloat16;
constexpr int   D = 128, NW = 8, QBLK = 32, KVBLK = 64;
constexpr float SCALE = 0.088388347648318440f;
constexpr float THR = 0.f;
constexpr int SDEPTH = 2;
constexpr int LDQ = 512, LDK = 512, LDO = 512;
constexpr size_t SHM_V = KVBLK * D * 2, SHM_K = KVBLK * D * 2, SHM_ATTN = 2 * SHM_V + 2 * SHM_K + NW * 64 * 4;
using bf16x8 = __attribute__((ext_vector_type(8))) short;
using s16x4  = __attribute__((ext_vector_type(4))) short;
using f32x16 = __attribute__((ext_vector_type(16))) float;
using f32x8  = __attribute__((ext_vector_type(8))) float;
using u32x4  = __attribute__((ext_vector_type(4))) unsigned;
#define KSWZ(row, colB) ((row) * 256 + ((colB) ^ (((row) & 7) << 4)))
#define SBAR() __builtin_amdgcn_sched_barrier(0)
__device__ __forceinline__ int crow(int r, int hi) { return (r & 3) + 8 * (r >> 2) + 4 * hi; }
__device__ __forceinline__ unsigned cvtpk(float lo, float hi) {
  unsigned r; asm volatile("v_cvt_pk_bf16_f32 %0, %1, %2" : "=v"(r) : "v"(lo), "v"(hi)); return r;
}
template <typename TIn> struct Stage;
template <> struct Stage<bf16>  { using T = bf16x8;
  __device__ static __forceinline__ T ld8(const bf16* p) { return *reinterpret_cast<const bf16x8*>(p); }
  __device__ static __forceinline__ bf16x8 tobf(T x) { return x; } };
template <> struct Stage<float> { using T = f32x8;
  __device__ static __forceinline__ T ld8(const float* p) { return *reinterpret_cast<const f32x8*>(p); }
  __device__ static __forceinline__ bf16x8 tobf(T x) {
    u32x4 w = {cvtpk(x[0], x[1]), cvtpk(x[2], x[3]), cvtpk(x[4], x[5]), cvtpk(x[6], x[7])}; return *reinterpret_cast<bf16x8*>(&w); } };

__device__ __forceinline__ void partialSM(f32x16& p0, f32x16& p1, float& m_reg, float& mn, float& alpha) {
  constexpr float C = SCALE * 1.4426950408889634f;
  float pmax = p0[0]; for (int r = 1; r < 16; ++r) pmax = fmaxf(pmax, p0[r]); for (int r = 0; r < 16; ++r) pmax = fmaxf(pmax, p1[r]);
  { auto rr = __builtin_amdgcn_permlane32_swap(__float_as_uint(pmax), __float_as_uint(pmax), false, false);
    pmax = fmaxf(__uint_as_float(rr[0]), __uint_as_float(rr[1])); }
  if (__builtin_expect(__all(pmax - m_reg <= THR / SCALE), 1)) { mn = m_reg; alpha = 1.f; }
  else { mn = fmaxf(m_reg, pmax); alpha = __builtin_amdgcn_exp2f((m_reg - mn) * C); m_reg = mn; }
  float mnC = -mn * C;
  for (int r = 0; r < 16; ++r) p0[r] = fmaf(p0[r], C, mnC); for (int r = 0; r < 16; ++r) p1[r] = fmaf(p1[r], C, mnC);
  for (int r = 0; r < 16; ++r) p0[r] = __builtin_amdgcn_exp2f(p0[r]);
}
__device__ __forceinline__ void finishSM(f32x16& p0, f32x16& p1, float alpha, float& l_reg, bf16x8& pa0, bf16x8& pa1, bf16x8& pa2, bf16x8& pa3) {
  for (int r = 0; r < 16; ++r) p1[r] = __builtin_amdgcn_exp2f(p1[r]);
  float ps = 0; for (int r = 0; r < 16; ++r) ps += p0[r]; for (int r = 0; r < 16; ++r) ps += p1[r];
  { auto rr = __builtin_amdgcn_permlane32_swap(__float_as_uint(ps), __float_as_uint(ps), false, false);
    ps = __uint_as_float(rr[0]) + __uint_as_float(rr[1]); }
  l_reg = l_reg * alpha + ps;
#define PK4(P, BASE, OUT) do { unsigned a0 = cvtpk(P[BASE + 0], P[BASE + 1]), a1 = cvtpk(P[BASE + 2], P[BASE + 3]);   \
    unsigned b0 = cvtpk(P[BASE + 4], P[BASE + 5]), b1 = cvtpk(P[BASE + 6], P[BASE + 7]);                              \
    auto r0 = __builtin_amdgcn_permlane32_swap(a0, b0, false, false); auto r1 = __builtin_amdgcn_permlane32_swap(a1, b1, false, false); \
    u32x4 w = {r0[0], r1[0], r0[1], r1[1]}; OUT = *reinterpret_cast<bf16x8*>(&w); } while (0)
  PK4(p0, 0, pa0); PK4(p0, 8, pa1); PK4(p1, 0, pa2); PK4(p1, 8, pa3);
#undef PK4
}
__device__ __forceinline__ void qkt(f32x16& p0, f32x16& p1, const bf16* Ks, const bf16x8* qr, int r32, int hi) {
  p0 = f32x16{}; p1 = f32x16{};
  for (int d0 = 0; d0 < 8; ++d0) { int cb = (d0 * 16 + hi * 8) * 2;
    bf16x8 b0 = *reinterpret_cast<const bf16x8*>((const char*)Ks + KSWZ(r32, cb));
    bf16x8 b1 = *reinterpret_cast<const bf16x8*>((const char*)Ks + KSWZ(32 + r32, cb));
    p0 = __builtin_amdgcn_mfma_f32_32x32x16_bf16(b0, qr[d0], p0, 0, 0, 0);
    p1 = __builtin_amdgcn_mfma_f32_32x32x16_bf16(b1, qr[d0], p1, 0, 0, 0); }
}
__device__ __forceinline__ int v_st(int k, int c) { const int kk = (k & ~0xC) | ((k & 4) << 1) | ((k & 8) >> 1); return ((kk >> 3) * 4 + (c >> 5)) * 512 + ((kk & 7) * 32 + (c & 31)) * 2; }
__device__ __forceinline__ int v_rd_base(int lane) { return ((lane & 3) << 3) | (((lane >> 2) & 3) << 6) | (((lane >> 4) & 1) << 5) | (((lane >> 5) & 1) << 8); }
constexpr int v_rd_off(int d0, int ks, int half) { return d0 * 512 + ks * 4096 + half * 2048; }
template <int OFF> __device__ __forceinline__ s16x4 tr_read(int vb) {
  s16x4 r; asm volatile("ds_read_b64_tr_b16 %0, %1 offset:%2" : "=&v"(r) : "v"(vb), "i"(OFF) : "memory"); return r;
}
template <int D0> __device__ __forceinline__ void pv_one(f32x16& od, int vb, bf16x8 pa0, bf16x8 pa1, bf16x8 pa2, bf16x8 pa3) {
  const s16x4 l0 = tr_read<v_rd_off(D0, 0, 0)>(vb), h0 = tr_read<v_rd_off(D0, 0, 1)>(vb), l1 = tr_read<v_rd_off(D0, 1, 0)>(vb), h1 = tr_read<v_rd_off(D0, 1, 1)>(vb);
  const s16x4 l2 = tr_read<v_rd_off(D0, 2, 0)>(vb), h2 = tr_read<v_rd_off(D0, 2, 1)>(vb), l3 = tr_read<v_rd_off(D0, 3, 0)>(vb), h3 = tr_read<v_rd_off(D0, 3, 1)>(vb);
  asm volatile("s_waitcnt lgkmcnt(0)" ::: "memory"); SBAR();
#define PK(L, H) (bf16x8){L[0], L[1], L[2], L[3], H[0], H[1], H[2], H[3]}
  od = __builtin_amdgcn_mfma_f32_32x32x16_bf16(pa0, PK(l0, h0), od, 0, 0, 0);
  od = __builtin_amdgcn_mfma_f32_32x32x16_bf16(pa1, PK(l1, h1), od, 0, 0, 0);
  od = __builtin_amdgcn_mfma_f32_32x32x16_bf16(pa2, PK(l2, h2), od, 0, 0, 0);
  od = __builtin_amdgcn_mfma_f32_32x32x16_bf16(pa3, PK(l3, h3), od, 0, 0, 0);
#undef PK
}
__device__ __forceinline__ void pv_d0(f32x16* o, int vb, bf16x8 pa0, bf16x8 pa1, bf16x8 pa2, bf16x8 pa3) {
  pv_one<0>(o[0], vb, pa0, pa1, pa2, pa3); pv_one<1>(o[1], vb, pa0, pa1, pa2, pa3); pv_one<2>(o[2], vb, pa0, pa1, pa2, pa3); pv_one<3>(o[3], vb, pa0, pa1, pa2, pa3);
}

template <typename TQ>
__device__ __forceinline__ void attn_dense_body(const TQ* __restrict__ Qb, const bf16* __restrict__ Kh, const bf16* __restrict__ Vh,
                                                bf16* __restrict__ Ob, int seq, char* lds) {
  using St = Stage<bf16>; using SQ = Stage<TQ>;
  int tid_ = threadIdx.x; asm volatile("" : "+v"(tid_));
  const int tid = tid_, wid = tid >> 6, lane = tid & 63, r32 = lane & 31, hi = lane >> 5;
  bf16* V_lds = (bf16*)lds; bf16* K_lds = (bf16*)(lds + 2 * SHM_V);
  float* ws = (float*)(lds + 2 * SHM_V + 2 * SHM_K) + wid * 64; float* li_l = ws; float* al_l = ws + 32;
  float m_reg = -1e30f, l_reg = 0; f32x16 o[4] = {}; bf16x8 qr[8];
  const TQ* Qw = Qb + (long)(wid * QBLK + r32) * LDQ + hi * 8;
#pragma unroll
  for (int d0 = 0; d0 < 8; ++d0) qr[d0] = SQ::tobf(SQ::ld8(Qw + d0 * 16));
  const int sr = tid >> 4, sc = (tid & 15) * 8, vst0 = v_st(sr, sc), vst1 = v_st(32 + sr, sc);
  const int vb0 = (int)(uintptr_t)V_lds + v_rd_base(lane);
  struct { typename St::T vs0, vs1, ks0, ks1; } sr_[SDEPTH];
#define SLOAD(i, k0) do { sr_[i].vs0 = St::ld8(&Vh[(long)((k0) + sr) * LDK + sc]); sr_[i].vs1 = St::ld8(&Vh[(long)((k0) + 32 + sr) * LDK + sc]); \
    sr_[i].ks0 = St::ld8(&Kh[(long)((k0) + sr) * LDK + sc]); sr_[i].ks1 = St::ld8(&Kh[(long)((k0) + 32 + sr) * LDK + sc]); } while (0)
#define SWRITE(b, i) do { *(bf16x8*)((char*)V_lds + (b) * SHM_V + vst0) = St::tobf(sr_[i].vs0);          \
    *(bf16x8*)((char*)V_lds + (b) * SHM_V + vst1) = St::tobf(sr_[i].vs1); int kc = sc * 2;               \
    *(bf16x8*)((char*)K_lds + (b) * SHM_K + KSWZ(sr, kc)) = St::tobf(sr_[i].ks0);                       \
    *(bf16x8*)((char*)K_lds + (b) * SHM_K + KSWZ(32 + sr, kc)) = St::tobf(sr_[i].ks1); } while (0)
#define SWAIT() do { if constexpr (SDEPTH == 2) asm volatile("s_waitcnt vmcnt(4)" ::: "memory"); else asm volatile("s_waitcnt vmcnt(0)" ::: "memory"); } while (0)
#define RESC(a) do { if (__any((a) < 1.f)) { if (hi == 0) al_l[r32] = (a); asm volatile("s_waitcnt lgkmcnt(0)" ::: "memory"); \
    for (int d = 0; d < 4; ++d) for (int r = 0; r < 16; ++r) o[d][r] *= al_l[crow(r, hi)]; } } while (0)
  f32x16 pA0, pA1, pB0, pB1; float mnA, mnB, alA, alB; bf16x8 pa0, pa1, pa2, pa3; const int NT = seq / KVBLK;
  constexpr int SE = 0, SO = SDEPTH - 1;
  SLOAD(SE, 0); asm volatile("s_waitcnt vmcnt(0)" ::: "memory"); SWRITE(0, SE); __syncthreads();
  qkt(pA0, pA1, K_lds, qr, r32, hi); partialSM(pA0, pA1, m_reg, mnA, alA);
  SLOAD(SO, KVBLK); if constexpr (SDEPTH == 2) { if (2 < NT) SLOAD(SE, 2 * KVBLK); }
  SWAIT(); SWRITE(1, SO); __syncthreads();
  for (int j = 1; j + 1 < NT; j += 2) {
    SBAR(); qkt(pB0, pB1, (bf16*)((char*)K_lds + SHM_K), qr, r32, hi);
    finishSM(pA0, pA1, alA, l_reg, pa0, pa1, pa2, pa3); SBAR();
    SLOAD(SO, (j + SDEPTH) * KVBLK); SBAR();
    pv_d0(o, vb0, pa0, pa1, pa2, pa3); partialSM(pB0, pB1, m_reg, mnB, alB);
    __syncthreads(); SWAIT(); SWRITE(0, SE);
    RESC(alB); __syncthreads();
    SBAR(); qkt(pA0, pA1, K_lds, qr, r32, hi);
    finishSM(pB0, pB1, alB, l_reg, pa0, pa1, pa2, pa3); SBAR();
    if (SDEPTH == 1 || j + 3 < NT) SLOAD(SE, (j + 1 + SDEPTH) * KVBLK); SBAR();
    pv_d0(o, vb0 + (int)SHM_V, pa0, pa1, pa2, pa3); partialSM(pA0, pA1, m_reg, mnA, alA);
    __syncthreads(); SWAIT(); SWRITE(1, SO);
    RESC(alA); __syncthreads();
  }
  SBAR(); qkt(pB0, pB1, (bf16*)((char*)K_lds + SHM_K), qr, r32, hi);
  finishSM(pA0, pA1, alA, l_reg, pa0, pa1, pa2, pa3); SBAR();
  pv_d0(o, vb0, pa0, pa1, pa2, pa3); partialSM(pB0, pB1, m_reg, mnB, alB);
  __syncthreads(); RESC(alB);
  finishSM(pB0, pB1, alB, l_reg, pa0, pa1, pa2, pa3); SBAR();
  pv_d0(o, vb0 + (int)SHM_V, pa0, pa1, pa2, pa3);
  if (hi == 0) li_l[r32] = l_reg; asm volatile("s_waitcnt lgkmcnt(0)" ::: "memory");
  float rli[16];
#pragma unroll
  for (int r = 0; r < 16; ++r) rli[r] = __builtin_amdgcn_rcpf(li_l[crow(r, hi)]);
  bf16* Ow = Ob + (long)(wid * QBLK) * LDO;
#pragma unroll
  for (int r = 0; r < 16; ++r) { int orow = crow(r, hi);
    for (int d0 = 0; d0 < 4; ++d0) Ow[(long)orow * LDO + d0 * 32 + r32] = __float2bfloat16(o[d0][r] * rli[r]); }
#undef SLOAD
#undef SWRITE
#undef SWAIT
#undef RESC
}

#undef KSWZ
#undef SBAR
}
namespace na_body {
typedef short bf16x8 __attribute__((ext_vector_type(8)));
typedef short s16x4 __attribute__((ext_vector_type(4)));
typedef float f32x4 __attribute__((ext_vector_type(4)));
typedef unsigned u32x2 __attribute__((ext_vector_type(2)));
typedef unsigned short bf16;
#define NA_LAS __attribute__((address_space(3)))
constexpr int SLOT = 8192, NSLOT = 9, LDS_K = 0, LDS_V = NSLOT * SLOT, LDS_TBL = 2 * NSLOT * SLOT, NA_LDS_BYTES = LDS_TBL + 4096;
__device__ __forceinline__ s16x4 vtr(const NA_LAS unsigned char* p) { typedef short v4i16_t __attribute__((ext_vector_type(4)));
  return __builtin_bit_cast(s16x4, __builtin_amdgcn_ds_read_tr16_b64_v4i16((NA_LAS v4i16_t*)p)); }
__device__ __forceinline__ void na_unit(int b, int h, int r0, const bf16* NQ, const bf16* NK, const bf16* NV, bf16* OC, const float* rpb_h, NA_LAS unsigned char* L) {
  int tid_ = threadIdx.x; asm volatile("" : "+v"(tid_));
  const int tid = tid_, lane = tid & 63; const int wid = __builtin_amdgcn_readfirstlane(tid >> 6);
  const int kr0 = min(max(r0 - 4, 0), 56), rs1 = min(max(r0 - 3, 0), 56), nrows = rs1 + 8 - kr0;
  asm volatile("s_waitcnt lgkmcnt(0)\n\ts_barrier" ::: "memory");
  const unsigned lds0 = (unsigned)(uintptr_t)L;
  {
    const size_t tok0 = (size_t)b * 4096 + kr0 * 64;
    const bf16* ksrc = NK + (tok0 + lane) * 512 + h * 64 + wid * 8;
    const bf16* vsrc = NV + (tok0 + 16 * (wid & 3) + (lane >> 2)) * 512 + h * 64 + (wid >> 2) * 32 + (lane & 3) * 8;
    for (int s = 0; s < nrows; ++s) {
      attn_body::glds16(ksrc + (size_t)s * 64 * 512, (unsigned)__builtin_amdgcn_readfirstlane(lds0 + LDS_K + s * SLOT + wid * 1024));
      attn_body::glds16(vsrc + (size_t)s * 64 * 512, (unsigned)__builtin_amdgcn_readfirstlane(lds0 + LDS_V + s * SLOT + wid * 1024));
    }
  }
  NA_LAS float* tbl = (NA_LAS float*)(L + LDS_TBL);
  for (int i = tid; i < 960; i += 512) { const int ro = i >> 6, co = (i & 63) - 16; tbl[i] = (co >= 0 && co < 31) ? rpb_h[ro * 31 + co] * 1.4426950408889634f : 0.f; }
  const int qr = wid >> 2, cb = wid & 3, r = r0 + qr, c0 = 16 * cb, kc0 = min(max(c0 - 8, 0), 32);
  const int ql = lane & 15, g = lane >> 4;
  const int rsr = min(max(r - 4, 0), 56), so = rsr - kr0, ro0 = rsr - r + 7;
  const size_t tokq = (size_t)b * 4096 + r * 64 + c0 + ql;
  bf16x8 qf[2];
#pragma unroll
  for (int ks = 0; ks < 2; ++ks) qf[ks] = *(const bf16x8*)(NQ + tokq * 512 + h * 64 + 32 * ks + 8 * g);
  asm volatile("s_waitcnt vmcnt(0) lgkmcnt(0)\n\ts_barrier" ::: "memory");
  const NA_LAS unsigned char* kb = L + LDS_K + so * SLOT + g * 1024 + (kc0 + ql) * 16;
  f32x4 s[8][2];
#pragma unroll
  for (int i = 0; i < 8; ++i)
#pragma unroll
    for (int sb = 0; sb < 2; ++sb) { f32x4 a = {0.f, 0.f, 0.f, 0.f};
#pragma unroll
      for (int ks = 0; ks < 2; ++ks) { const bf16x8 kf = *(const NA_LAS bf16x8*)(kb + i * SLOT + ks * 4096 + sb * 256); a = __builtin_amdgcn_mfma_f32_16x16x32_bf16(kf, qf[ks], a, 0, 0, 0); }
      s[i][sb] = a; }
  const int c = c0 + ql, cs = min(max(c - 8, 0), 48), e0 = kc0 + 4 * g - cs;
  const NA_LAS float* tb = tbl + ro0 * 64 + (kc0 - c0 + 4 * g - ql + 31);
  float m = -1e30f;
#pragma unroll
  for (int i = 0; i < 8; ++i)
#pragma unroll
    for (int sb = 0; sb < 2; ++sb)
#pragma unroll
      for (int j = 0; j < 4; ++j) { const int e = e0 + 16 * sb + j; float v = s[i][sb][j] + tb[i * 64 + sb * 16 + j]; v = ((unsigned)e < 16u) ? v : -1e30f; s[i][sb][j] = v; m = fmaxf(m, v); }
  m = fmaxf(m, __shfl_xor(m, 16)); m = fmaxf(m, __shfl_xor(m, 32));
  float l = 0.f;
#pragma unroll
  for (int i = 0; i < 8; ++i)
#pragma unroll
    for (int sb = 0; sb < 2; ++sb)
#pragma unroll
      for (int j = 0; j < 4; ++j) { const float p = __builtin_amdgcn_exp2f(s[i][sb][j] - m); s[i][sb][j] = p; l += p; }
  l += __shfl_xor(l, 16); l += __shfl_xor(l, 32);
  const NA_LAS unsigned char* vb = L + LDS_V + so * SLOT + (kc0 + 4 * g + ((lane & 15) >> 2)) * 64 + (lane & 3) * 8;
  f32x4 o[4];
#pragma unroll
  for (int d = 0; d < 4; ++d) o[d] = (f32x4){0.f, 0.f, 0.f, 0.f};
#pragma unroll
  for (int i = 0; i < 8; ++i) {
    typedef unsigned u32x4_t __attribute__((ext_vector_type(4)));
    u32x4_t pw; pw.x = pg8::cvt_pk_bf16(s[i][0][0], s[i][0][1]); pw.y = pg8::cvt_pk_bf16(s[i][0][2], s[i][0][3]); pw.z = pg8::cvt_pk_bf16(s[i][1][0], s[i][1][1]); pw.w = pg8::cvt_pk_bf16(s[i][1][2], s[i][1][3]);
    const bf16x8 pf = __builtin_bit_cast(bf16x8, pw);
#pragma unroll
    for (int d = 0; d < 4; ++d) { const NA_LAS unsigned char* p = vb + i * SLOT + (d >> 1) * 4096 + (d & 1) * 32;
      const s16x4 lo = vtr(p), hi = vtr(p + 16 * 64);
      const bf16x8 vf = (bf16x8){lo[0], lo[1], lo[2], lo[3], hi[0], hi[1], hi[2], hi[3]};
      o[d] = __builtin_amdgcn_mfma_f32_16x16x32_bf16(vf, pf, o[d], 0, 0, 0); }
  }
  const float rl = 1.0f / l;
  bf16* op = OC + tokq * 1024 + h * 64 + 4 * g;
#pragma unroll
  for (int d = 0; d < 4; ++d) { u32x2 w; w.x = pg8::cvt_pk_bf16(o[d][0] * rl, o[d][1] * rl); w.y = pg8::cvt_pk_bf16(o[d][2] * rl, o[d][3] * rl); *(u32x2*)(op + 16 * d) = w; }
}
}
#define GAS __attribute__((address_space(1)))
#define LAS __attribute__((address_space(3)))
typedef unsigned short bf16;
typedef unsigned v4u __attribute__((ext_vector_type(4)));
typedef float f32x4 __attribute__((ext_vector_type(4)));
typedef short bf16x8 __attribute__((ext_vector_type(8)));
typedef GAS unsigned gu32;
typedef GAS unsigned long long gu64;
#define RLX_AGENT __ATOMIC_RELAXED, __HIP_MEMORY_SCOPE_AGENT
#define LDS_WAIT() asm volatile("s_waitcnt lgkmcnt(0)" ::: "memory")
#define VM_WAIT() asm volatile("s_waitcnt vmcnt(0)" ::: "memory")
__device__ __forceinline__ unsigned long long rt() { return __builtin_amdgcn_s_memrealtime(); }
__device__ __forceinline__ unsigned f2bf(float f) { unsigned u = __builtin_bit_cast(unsigned, f); return (u + 0x7fffu + ((u >> 16) & 1u)) >> 16; }
__device__ __forceinline__ unsigned pk2(float lo, float hi) { return f2bf(lo) | (f2bf(hi) << 16); }

#define XB_TMO      128
#define XB_XCNT(j)  (256  + 64 * (j))
#define XB_XSUB(j)  (1280 + 64 * (j))
#define XB_XGEN(j)  (2304 + 64 * (j))
#define XB_TOP      3328
#define XB_TOPGEN   3392
#define XCD_BAR_WORDS 3456
#define XB_SPIN_CAP (1u << 18)

__device__ __forceinline__ unsigned xb_ld(unsigned* p)              { return __hip_atomic_load(p, __ATOMIC_RELAXED, __HIP_MEMORY_SCOPE_AGENT); }
__device__ __forceinline__ unsigned xb_add(unsigned* p, unsigned v) { return __hip_atomic_fetch_add(p, v, __ATOMIC_RELAXED, __HIP_MEMORY_SCOPE_AGENT); }
__device__ __forceinline__ unsigned xb_xcc_id() { return (unsigned)__builtin_amdgcn_s_getreg((3 << 11) | 20) & 0xFu; }
#define XB_SPIN(cond, bar) do { unsigned _sp = 0; while (cond) { __builtin_amdgcn_s_sleep(1); \
    if ((++_sp & 255u) == 0u) { if (xb_ld(&(bar)[XB_TMO])) break; if (_sp > XB_SPIN_CAP) { atomicAdd(&(bar)[XB_TMO], 1u); break; } } } } while (0)

struct XcdBarrier {
    unsigned* bar; unsigned x;
    volatile LAS unsigned* st;
};

__device__ __forceinline__ XcdBarrier xcd_barrier_post(unsigned* bar, volatile LAS unsigned* st) {
    XcdBarrier b; b.bar = bar; b.x = xb_xcc_id(); b.st = st;
    if (threadIdx.x == 0) (void)xb_add(&bar[XB_XCNT(b.x)], 1u);
    return b;
}
__device__ __forceinline__ void xcd_barrier_complete(unsigned* bar, unsigned x, unsigned& nloc, unsigned& nx) {
    const unsigned G = gridDim.x * gridDim.y * gridDim.z;
    unsigned sum, cnt, mine, sp = 0u;
    for (;;) {
        sum = 0u; cnt = 0u; mine = 0u;
#pragma unroll
        for (unsigned j = 0; j < 16; ++j) { const unsigned c = xb_ld(&bar[XB_XCNT(j)]); sum += c; cnt += (c > 0u) ? 1u : 0u; mine = (j == x) ? c : mine; }
        if (sum == G) break;
        __builtin_amdgcn_s_sleep(1);
        if ((++sp & 255u) == 0u) { if (xb_ld(&bar[XB_TMO])) break; if (sp > XB_SPIN_CAP) { atomicAdd(&bar[XB_TMO], 1u); break; } }
    }
    nloc = mine > 0u ? mine : 1u; nx = cnt > 0u ? cnt : 1u;
}

__device__ __forceinline__ void xcd_barrier(const XcdBarrier& b) {
    asm volatile("s_waitcnt vmcnt(0)" ::: "memory");
    __syncthreads();
    if (threadIdx.x == 0) {
        unsigned* bar = b.bar;
        __builtin_amdgcn_s_waitcnt(0);
        unsigned nloc = b.st[0], nx = b.st[1];
        if (nloc == 0u) { xcd_barrier_complete(bar, b.x, nloc, nx); b.st[0] = nloc; b.st[1] = nx; }
        const unsigned old = xb_add(&bar[XB_XSUB(b.x)], 1u);
        const unsigned gen = old / nloc;
        if (old + 1u == (gen + 1u) * nloc) {
            __builtin_amdgcn_fence(__ATOMIC_RELEASE, "agent");
            asm volatile("s_waitcnt vmcnt(0)" ::: "memory");
            const unsigned og = xb_add(&bar[XB_TOP], 1u);
            const unsigned tg = og / nx;
            if (og + 1u == (tg + 1u) * nx) xb_add(&bar[XB_TOPGEN], 1u);
            else XB_SPIN(xb_ld(&bar[XB_TOPGEN]) == tg, bar);
            __builtin_amdgcn_fence(__ATOMIC_ACQUIRE, "agent");
            xb_add(&bar[XB_XGEN(b.x)], 1u);
            asm volatile("s_waitcnt vmcnt(0)" ::: "memory");
        } else {
            XB_SPIN(xb_ld(&bar[XB_XGEN(b.x)]) == gen, bar);
            __builtin_amdgcn_fence(__ATOMIC_ACQUIRE, "agent");
            asm volatile("s_waitcnt vmcnt(0)" ::: "memory");
        }
    }
    __syncthreads();
}
#ifndef NAIVE_GQA
#define NAIVE_GQA 0
#endif
#ifndef NAIVE_NA
#define NAIVE_NA 0
#endif
#ifndef NAIVE_MEM
#define NAIVE_MEM 0
#endif
#ifndef PG8_SP2
#define PG8_SP2 true
#endif
#ifndef PG8_ALIGN
#define PG8_ALIGN true
#endif

constexpr int NB = 4, SEQ = 4096, D = 1024, T = NB * SEQ;
constexpr int GW = 64;
constexpr int NINW = 2304, NAW = 512, GQW = 512, KVW = 128;
constexpr int MEML = 256, MEMT = NB * MEML, MEMW = 512;
constexpr int DFF = 2816, DFF2 = 5632;
constexpr float LOG2E = 1.4426950408889634f;
constexpr float QS_NA = 0.125f * LOG2E;
constexpr float QS_G = 0.125f * LOG2E;
constexpr float QS_M = 0.08838834764831845f * LOG2E;
constexpr int NTHREADS = 512, NWAVES = 8;

constexpr size_t MiB = 1u << 20;
constexpr size_t WS_CTL = 0, CTL_ZERO_BYTES = 1 * MiB;
constexpr size_t WS_ROPE = 1 * MiB, WS_SS = 2 * MiB, WS_MSS = 3 * MiB;
constexpr size_t WS_WIN = 4 * MiB, WS_WOUT = 13 * MiB, WS_WMQ = 17 * MiB, WS_WMKV = 19 * MiB, WS_WMO = 23 * MiB, WS_WUP = 25 * MiB, WS_WDN = 47 * MiB;
constexpr size_t WS_XB = 58 * MiB, WS_MXB = 90 * MiB, WS_MKV = 92 * MiB;
constexpr size_t WS_R = 96 * MiB;
constexpr size_t WS_NQ = WS_R, WS_NK = WS_R + 16 * MiB, WS_NV = WS_R + 32 * MiB, WS_GQ = WS_R + 48 * MiB, WS_GK = WS_R + 64 * MiB, WS_GV = WS_R + 68 * MiB, WS_OC = WS_R + 72 * MiB;
constexpr size_t WS_QM = WS_R, WS_OM = WS_R + 16 * MiB;
constexpr size_t WS_UP = WS_R, WS_ACT = WS_R + 64 * MiB, WS_END = 256 * MiB;
static_assert(WS_ACT + (size_t)T * DFF * 2 <= WS_END, "ws map");
constexpr int CW_BAR = 4096;

constexpr int RING_OFF = 0, RING_BYTES = 131072;
constexpr int LDSCTL_OFF = 151552, MISC_OFF = LDSCTL_OFF + 320;
constexpr int LDS_BYTES = 155648;

__device__ __forceinline__ float wave_sum(float v) {
#pragma unroll
    for (int o = 1; o < 64; o <<= 1) v += __shfl_xor(v, o);
    return v;
}
__device__ __forceinline__ float wave_max(float v) {
#pragma unroll
    for (int o = 1; o < 64; o <<= 1) v = fmaxf(v, __shfl_xor(v, o));
    return v;
}
__device__ __forceinline__ float bf_lo(unsigned w) { return __uint_as_float(w << 16); }
__device__ __forceinline__ float bf_hi(unsigned w) { return __uint_as_float(w & 0xffff0000u); }
__device__ __forceinline__ float bf2f(bf16 h) { return __uint_as_float((unsigned)h << 16); }
__device__ __forceinline__ float rdlane(float v, int l) { return __int_as_float(__builtin_amdgcn_readlane(__float_as_int(v), l)); }

__device__ __forceinline__ int rowmap(int kind, int n) {
    if (kind == 1) {
        if (n < 1536) return n;
        int pn, wc;
        if (n < 2048) { const int hh = (n - 1536) >> 6; pn = 6 + (hh >> 2); wc = hh & 3; }
        else if (n < 2176) { pn = 8; wc = (n - 2048) >> 6; }
        else { pn = 8; wc = 2 + ((n - 2176) >> 6); }
        const int d = n & 63, bj = d >> 5, nn = (d >> 4) & 1, fq = (d >> 2) & 3, e = d & 3;
        return 256 * pn + 128 * bj + 32 * wc + 8 * fq + 4 * nn + e;
    }
    if (kind == 2) { if (n < DFF) return 256 * (n >> 7) + (n & 127); const int ch = n - DFF; return 256 * (ch >> 7) + 128 + (ch & 127); }
    return n;
}
__device__ __forceinline__ void p0_transpose_item(const float* W, int K, int N, const float* gain, int kind, bf16* WT, LAS float* scr, int item, int lane) {
    const int nblk = N / 32, kb = item / nblk, nb = item % nblk, k0 = 64 * kb, n0 = 32 * nb;
#pragma unroll 8
    for (int i = 0; i < 32; ++i) { const int kk = 2 * i + (lane >> 5); const float gk = gain ? gain[k0 + kk] : 1.f; scr[kk * 33 + (lane & 31)] = W[(size_t)(k0 + kk) * N + n0 + (lane & 31)] * gk; }
    LDS_WAIT(); asm volatile("" ::: "memory");
    const int c = lane & 7;
#pragma unroll
    for (int j = 0; j < 4; ++j) { const int n = (lane >> 3) + 8 * j; const LAS float* s = scr + (8 * c) * 33 + n;
        v4u o; o.x = pk2(s[0 * 33], s[1 * 33]); o.y = pk2(s[2 * 33], s[3 * 33]); o.z = pk2(s[4 * 33], s[5 * 33]); o.w = pk2(s[6 * 33], s[7 * 33]);
        *(GAS v4u*)(WT + (size_t)rowmap(kind, n0 + n) * K + k0 + 8 * c) = o; }
    LDS_WAIT(); asm volatile("" ::: "memory");
}
__device__ __forceinline__ void row_to_bf16_ss(const float* xrow, bf16* orow, float* ssrow, int lane) {
    const GAS f32x4* xr = (const GAS f32x4*)xrow + lane;
    f32x4 v[4]; float s = 0.f;
#pragma unroll
    for (int j = 0; j < 4; ++j) { v[j] = xr[64 * j]; s += (v[j].x * v[j].x + v[j].y * v[j].y) + (v[j].z * v[j].z + v[j].w * v[j].w); }
    s = wave_sum(s);
    GAS unsigned long long* o8 = (GAS unsigned long long*)orow + lane;
#pragma unroll
    for (int j = 0; j < 4; ++j) o8[64 * j] = (unsigned long long)pk2(v[j].x, v[j].y) | ((unsigned long long)pk2(v[j].z, v[j].w) << 32);
    if (lane < 16) ssrow[lane] = lane == 0 ? s : 0.f;
}

struct Args { const float* in[19]; float* out; unsigned char* ws; };

__device__ __forceinline__ void na_naive(const bf16* NQ, const bf16* NK, const bf16* NV, bf16* OC, const float* rpb, int gw, int NGW, int lane) {
    for (int task = gw; task < T * 8; task += NGW) {
        const int h = task & 7, t = task >> 3;
        const int b = t >> 12, r = (t >> 6) & 63, c = t & 63;
        const int rs = min(max(r - 4, 0), 56), cs = min(max(c - 8, 0), 48);
        const float q = bf2f(NQ[(size_t)t * 512 + h * 64 + lane]);
        float s[2];
#pragma unroll
        for (int half = 0; half < 2; ++half) {
            const int kk = lane + 64 * half, i = kk >> 4, jj = kk & 15;
            const int tk = (b << 12) + ((rs + i) << 6) + cs + jj;
            const v4u* kp = (const v4u*)(NK + (size_t)tk * 512 + h * 64);
            v4u kv[8];
#pragma unroll
            for (int j = 0; j < 8; ++j) kv[j] = kp[j];
            float a = 0.f;
#pragma unroll
            for (int d = 0; d < 64; d += 2) { const unsigned w = kv[d >> 3][(d >> 1) & 3]; a += rdlane(q, d) * bf_lo(w) + rdlane(q, d + 1) * bf_hi(w); }
            s[half] = a + rpb[(h * 15 + (rs + i - r + 7)) * 31 + (cs + jj - c + 15)] * LOG2E;
        }
        const float m = wave_max(fmaxf(s[0], s[1]));
        const float p0 = exp2f(s[0] - m), p1 = exp2f(s[1] - m);
        const float l = wave_sum(p0 + p1);
        float o = 0.f;
        for (int kk = 0; kk < 64; ++kk) { const int i = kk >> 4, jj = kk & 15; const int tk = (b << 12) + ((rs + i) << 6) + cs + jj;
            o += rdlane(p0, kk) * bf2f(NV[(size_t)tk * 512 + h * 64 + lane]); }
        for (int kk = 0; kk < 64; ++kk) { const int i = 4 + (kk >> 4), jj = kk & 15; const int tk = (b << 12) + ((rs + i) << 6) + cs + jj;
            o += rdlane(p1, kk) * bf2f(NV[(size_t)tk * 512 + h * 64 + lane]); }
        OC[(size_t)t * 1024 + h * 64 + lane] = (bf16)f2bf(o / l);
    }
}
__device__ __forceinline__ void gqa_naive(const bf16* GQ, const bf16* GK, const bf16* GV, bf16* OC, int gw, int NGW, int lane) {
    for (int task = gw; task < T * 8; task += NGW) {
        const int h = task & 7, t = task >> 3, b = t >> 12, kvh = h >> 2;
        const float q = bf2f(GQ[(size_t)t * 512 + h * 64 + lane]);
        float m = -1e30f, l = 0.f, o = 0.f;
        for (int ch = 0; ch < 64; ++ch) {
            const int tk = (b << 12) + ch * 64 + lane;
            const v4u* kp = (const v4u*)(GK + (size_t)tk * 128 + kvh * 64);
            v4u kv[8];
#pragma unroll
            for (int j = 0; j < 8; ++j) kv[j] = kp[j];
            float a = 0.f;
#pragma unroll
            for (int d = 0; d < 64; d += 2) { const unsigned w = kv[d >> 3][(d >> 1) & 3]; a += rdlane(q, d) * bf_lo(w) + rdlane(q, d + 1) * bf_hi(w); }
            const float cm = wave_max(a), mn = fmaxf(m, cm), alpha = exp2f(m - mn), p = exp2f(a - mn);
            l = l * alpha + wave_sum(p); o *= alpha; m = mn;
            const bf16* vp = GV + (size_t)((b << 12) + ch * 64) * 128 + kvh * 64 + lane;
            for (int kk = 0; kk < 64; ++kk) o += rdlane(p, kk) * bf2f(vp[(size_t)kk * 128]);
        }
        OC[(size_t)t * 1024 + 512 + h * 64 + lane] = (bf16)f2bf(o / l);
    }
}
__device__ __forceinline__ void mem_naive(const bf16* QM, const bf16* MK, const bf16* MV, bf16* OM, int gw, int NGW, int lane) {
    for (int task = gw; task < T * 4; task += NGW) {
        const int h = task & 3, t = task >> 2, b = t >> 12;
        const float q0 = bf2f(QM[(size_t)t * 512 + h * 128 + lane]), q1 = bf2f(QM[(size_t)t * 512 + h * 128 + 64 + lane]);
        float s[4];
#pragma unroll
        for (int j = 0; j < 4; ++j) {
            const int row = b * 256 + 64 * j + lane;
            const v4u* kp = (const v4u*)(MK + (size_t)row * 512 + h * 128);
            v4u kv[16];
#pragma unroll
            for (int i = 0; i < 16; ++i) kv[i] = kp[i];
            float a = 0.f;
#pragma unroll
            for (int d = 0; d < 64; d += 2) { const unsigned w = kv[d >> 3][(d >> 1) & 3]; a += rdlane(q0, d) * bf_lo(w) + rdlane(q0, d + 1) * bf_hi(w); }
#pragma unroll
            for (int d = 0; d < 64; d += 2) { const unsigned w = kv[8 + (d >> 3)][(d >> 1) & 3]; a += rdlane(q1, d) * bf_lo(w) + rdlane(q1, d + 1) * bf_hi(w); }
            s[j] = a * QS_M;
        }
        const float m = wave_max(fmaxf(fmaxf(s[0], s[1]), fmaxf(s[2], s[3])));
        float p[4], ps = 0.f;
#pragma unroll
        for (int j = 0; j < 4; ++j) { p[j] = exp2f(s[j] - m); ps += p[j]; }
        const float l = wave_sum(ps);
        float o0 = 0.f, o1 = 0.f;
#pragma unroll
        for (int j = 0; j < 4; ++j) {
            const bf16* vp = MV + (size_t)(b * 256 + 64 * j) * 512 + h * 128 + lane;
            for (int kk = 0; kk < 64; ++kk) { const float pk = rdlane(p[j], kk); o0 += pk * bf2f(vp[(size_t)kk * 512]); o1 += pk * bf2f(vp[(size_t)kk * 512 + 64]); }
        }
        OM[(size_t)t * 512 + h * 128 + lane] = (bf16)f2bf(o0 / l); OM[(size_t)t * 512 + h * 128 + 64 + lane] = (bf16)f2bf(o1 / l);
    }
}
__device__ __forceinline__ void conv_act_pass(const bf16* U, int ntp, int tp0, const float* cw, const float* cb, bf16* ACT, int gtid, int NGT) {
    const int ldu = ntp * 256, nitem = T * ntp * 16;
    for (int it = gtid; it < nitem; it += NGT) {
        const int g8 = it & 15, j = (it >> 4) % ntp, t = (it >> 4) / ntp;
        const int ch = 128 * (tp0 + j) + 8 * g8;
        const bf16* ug = U + (size_t)t * ldu + 256 * j + 8 * g8; const bf16* uv = ug + 128;
        const bool hp = (t & 4095) != 0, hn = (t & 4095) != 4095;
        const v4u z = {0u, 0u, 0u, 0u};
        const v4u g0 = hp ? *(const v4u*)(ug - ldu) : z, g1 = *(const v4u*)ug, g2 = hn ? *(const v4u*)(ug + ldu) : z;
        const v4u v0 = hp ? *(const v4u*)(uv - ldu) : z, v1 = *(const v4u*)uv, v2 = hn ? *(const v4u*)(uv + ldu) : z;
        float r[8];
#pragma unroll
        for (int e = 0; e < 8; ++e) {
            const int c = ch + e; const unsigned sh = e >> 1;
            const float a0 = (e & 1) ? bf_hi(g0[sh]) : bf_lo(g0[sh]), a1 = (e & 1) ? bf_hi(g1[sh]) : bf_lo(g1[sh]), a2 = (e & 1) ? bf_hi(g2[sh]) : bf_lo(g2[sh]);
            const float b0 = (e & 1) ? bf_hi(v0[sh]) : bf_lo(v0[sh]), b1 = (e & 1) ? bf_hi(v1[sh]) : bf_lo(v1[sh]), b2 = (e & 1) ? bf_hi(v2[sh]) : bf_lo(v2[sh]);
            const float gg = a0 * cw[c] + a1 * cw[DFF2 + c] + a2 * cw[2 * DFF2 + c] + cb[c];
            const float vv = b0 * cw[DFF + c] + b1 * cw[DFF2 + DFF + c] + b2 * cw[2 * DFF2 + DFF + c] + cb[DFF + c];
            r[e] = gg / (1.f + __expf(-gg)) * vv;
        }
        v4u o; o.x = pk2(r[0], r[1]); o.y = pk2(r[2], r[3]); o.z = pk2(r[4], r[5]); o.w = pk2(r[6], r[7]);
        *(v4u*)(ACT + (size_t)t * DFF + ch) = o;
    }
}

__device__ __forceinline__ const void* karg(int i) {
    unsigned off = (unsigned)i * 8u; asm volatile("" : "+s"(off));
    return *(const void* const __attribute__((address_space(4)))*)((const char __attribute__((address_space(4)))*)__builtin_amdgcn_kernarg_segment_ptr() + off);
}
#define WSP() ((unsigned char*)karg(20))
#define OUTP() ((float*)karg(19))
#define INP(i) ((const float*)karg(i))
#define WSB(off) ((bf16*)(WSP() + (off)))
#define WSF(off) ((float*)(WSP() + (off)))
struct Ids { int tid, lane, wave, vcu, gw, NGW, gtid, NGT, G, bx; };
__device__ __forceinline__ Ids ids() {
    Ids I; int t = threadIdx.x; asm volatile("" : "+v"(t)); I.tid = t; I.lane = t & 63; I.wave = __builtin_amdgcn_readfirstlane(t >> 6);
    I.G = gridDim.x; I.bx = blockIdx.x; I.vcu = (I.G % 8 == 0) ? (I.bx % 8) * (I.G / 8) + I.bx / 8 : I.bx;
    I.gw = I.vcu * NWAVES + I.wave; I.NGW = I.G * NWAVES; I.gtid = I.vcu * NTHREADS + I.tid; I.NGT = I.G * NTHREADS; return I;
}
__device__ __forceinline__ void grid_bar(LAS unsigned char* L) {
    XcdBarrier b; b.bar = (unsigned*)(WSP() + WS_CTL) + CW_BAR; b.x = xb_xcc_id(); b.st = (volatile LAS unsigned*)(L + MISC_OFF) + 8;
    xcd_barrier(b);
}
__global__ void __launch_bounds__(NTHREADS, 2) mk_fwd(Args args) {
    extern __shared__ __attribute__((aligned(16))) unsigned char lds[];
    LAS unsigned char* L = (LAS unsigned char*)lds;
    {
        const int tid = threadIdx.x;
        for (int u = tid; u < (LDS_BYTES - LDSCTL_OFF) / 4; u += NTHREADS) ((LAS unsigned*)(L + LDSCTL_OFF))[u] = 0u;
        __syncthreads();
        (void)xcd_barrier_post((unsigned*)(WSP() + WS_CTL) + CW_BAR, (volatile LAS unsigned*)(L + MISC_OFF) + 8);
    }
#define GRID_BAR() grid_bar(L)

    {
        const Ids I = ids(); const int lane = I.lane;
        LAS float* scr = (LAS float*)(L + RING_OFF + I.wave * 16384);
        constexpr int I_IN = 16 * (NINW / 32), I_OUT = 16 * 32, I_MQ = 16 * 16, I_MKV = 16 * 32, I_MO = 8 * 32, I_UP = 16 * (DFF2 / 32), I_DN = 44 * 32;
        constexpr int I_L = I_IN + I_OUT + I_MQ + I_MKV + I_MO + I_UP + I_DN;
        for (int it = I.gw; it < 2 * I_L; it += I.NGW) {
            const int l = it / I_L; int r = it % I_L;
            if (r < I_IN) { p0_transpose_item(INP(3) + (size_t)l * D * NINW, D, NINW, INP(2) + l * D, 1, WSB(WS_WIN) + (size_t)l * NINW * D, scr, r, lane); continue; } r -= I_IN;
            if (r < I_OUT) { p0_transpose_item(INP(7) + (size_t)l * D * D, D, D, nullptr, 0, WSB(WS_WOUT) + (size_t)l * D * D, scr, r, lane); continue; } r -= I_OUT;
            if (r < I_MQ) { p0_transpose_item(INP(10) + (size_t)l * D * MEMW, D, MEMW, INP(8) + l * D, 0, WSB(WS_WMQ) + (size_t)l * MEMW * D, scr, r, lane); continue; } r -= I_MQ;
            if (r < I_MKV) { p0_transpose_item(INP(11) + (size_t)l * D * 1024, D, 1024, INP(9) + l * D, 0, WSB(WS_WMKV) + (size_t)l * 1024 * D, scr, r, lane); continue; } r -= I_MKV;
            if (r < I_MO) { p0_transpose_item(INP(12) + (size_t)l * MEMW * D, MEMW, D, nullptr, 0, WSB(WS_WMO) + (size_t)l * D * MEMW, scr, r, lane); continue; } r -= I_MO;
            if (r < I_UP) { p0_transpose_item(INP(14) + (size_t)l * D * DFF2, D, DFF2, INP(13) + l * D, 2, WSB(WS_WUP) + (size_t)l * DFF2 * D, scr, r, lane); continue; } r -= I_UP;
            p0_transpose_item(INP(17) + (size_t)l * DFF * D, DFF, D, nullptr, 0, WSB(WS_WDN) + (size_t)l * D * DFF, scr, r, lane);
        }
        { const float* x_in = INP(0); bf16* XB = WSB(WS_XB); float* SS = WSF(WS_SS);
          for (int m = I.gw; m < T; m += I.NGW) row_to_bf16_ss(x_in + (size_t)m * D, XB + (size_t)m * D, SS + (size_t)m * 16, lane); }
        { const float* mem_in = INP(1); bf16* MXB = WSB(WS_MXB); float* MSS = WSF(WS_MSS);
          for (int m = I.gw; m < MEMT; m += I.NGW) row_to_bf16_ss(mem_in + (size_t)m * D, MXB + (size_t)m * D, MSS + (size_t)m * 16, lane); }
        if (I.bx == 0) { float* ROPE = WSF(WS_ROPE); for (int i = I.tid; i < 1024; i += NTHREADS) { const int pos = i >> 4, f = i & 15;
            const float inv_freq = powf(10000.0f, -(float)f / 16.0f); const float ang = (float)pos * inv_freq;
            ROPE[pos * 32 + f] = cosf(ang); ROPE[pos * 32 + 16 + f] = sinf(ang); } }
    }
    GRID_BAR();

    {
        pg8::Gemm g{WSB(WS_MXB), WSB(WS_WMKV), MEMT, 2048, D}; pg8::StaticOrder S; S.init(MEMT, 2048, gridDim.x, blockIdx.x);
        pg8::EpiSB E{WSB(WS_MKV), MEMW, WSF(WS_MSS), 512, (size_t)MEMT * MEMW, 1.f};
        pg8::gemm_phase<pg8::EpiSB, pg8::StaticOrder, PG8_ALIGN, PG8_SP2>(L + RING_OFF, g, S, E);
    }

    for (int l = 0; l < 2; ++l) {
        {
            pg8::Gemm g{WSB(WS_XB), WSB(WS_WIN) + (size_t)l * NINW * D, T, NINW, D}; pg8::StaticOrder S; S.init(T, NINW, gridDim.x, blockIdx.x);
            pg8::EpiInProj E{WSF(WS_SS), WSB(WS_NQ), (size_t)T * 512, WSB(WS_GQ), WSB(WS_GK), WSB(WS_GV), WSF(WS_ROPE), INP(5) + l * 64, INP(6) + l * 64, QS_NA, QS_G};
            pg8::gemm_phase<pg8::EpiInProj, pg8::StaticOrder, PG8_ALIGN, PG8_SP2>(L + RING_OFF, g, S, E);
        }
        GRID_BAR();
#if NAIVE_NA
        { const Ids I = ids(); na_naive(WSB(WS_NQ), WSB(WS_NK), WSB(WS_NV), WSB(WS_OC), INP(4) + (size_t)l * 8 * 15 * 31, I.gw, I.NGW, I.lane); }
#endif
#if NAIVE_GQA
        { const Ids I = ids(); gqa_naive(WSB(WS_GQ), WSB(WS_GK), WSB(WS_GV), WSB(WS_OC), I.gw, I.NGW, I.lane); }
#else
        { const attn_body::AttnTensors AT{(const attn_body::bf16*)WSB(WS_GQ), (const attn_body::bf16*)WSB(WS_GK), (const attn_body::bf16*)WSB(WS_GV), (attn_body::bf16*)WSB(WS_OC)};
          const attn_body::StaticOrder S((int)gridDim.x, (int)blockIdx.x);
          attn_body::attn_phase<attn_body::StaticOrder>((char*)lds + RING_OFF, AT, S); }
#endif
#if !NAIVE_NA
        {
            const int G_ = gridDim.x, bx_ = blockIdx.x;
            for (int i = 0; i < 1024; ++i) {
                int u;
                if (G_ == 256) { if (i >= 4) break; const int uu = 4 * (bx_ >> 3) + i; u = ((4 * (bx_ & 7) + (uu >> 5)) << 5) + (uu & 31); }
                else { u = bx_ + i * G_; if (u >= 1024) break; }
                const int pair = u >> 5, r0 = 2 * (u & 31);
                na_body::na_unit(pair >> 3, pair & 7, r0, WSB(WS_NQ), WSB(WS_NK), WSB(WS_NV), WSB(WS_OC), INP(4) + ((size_t)l * 8 + (pair & 7)) * 15 * 31, L);
            }
        }
#endif
        GRID_BAR();
        {
            pg8::Gemm g{WSB(WS_OC), WSB(WS_WOUT) + (size_t)l * D * D, T, D, D}; pg8::StaticOrder S; S.init(T, D, gridDim.x, blockIdx.x);
            pg8::EpiRes E{l == 0 ? INP(0) : (const float*)OUTP(), OUTP(), WSB(WS_XB), WSF(WS_SS)};
            pg8::gemm_phase<pg8::EpiRes, pg8::StaticOrder, PG8_ALIGN, PG8_SP2>(L + RING_OFF, g, S, E);
        }
        GRID_BAR();
        {
            pg8::Gemm g{WSB(WS_XB), WSB(WS_WMQ) + (size_t)l * MEMW * D, T, MEMW, D}; pg8::StaticOrder S; S.init(T, MEMW, gridDim.x, blockIdx.x);
            pg8::EpiSB E{WSB(WS_QM), MEMW, WSF(WS_SS), 0, 0, 1.f};
            pg8::gemm_phase<pg8::EpiSB, pg8::StaticOrder, PG8_ALIGN, PG8_SP2>(L + RING_OFF, g, S, E);
        }
        GRID_BAR();
#if NAIVE_MEM
        { const Ids I = ids(); const bf16* MK = WSB(WS_MKV) + (size_t)l * 2 * MEMT * MEMW;
          mem_naive(WSB(WS_QM), MK, MK + (size_t)MEMT * MEMW, WSB(WS_OM), I.gw, I.NGW, I.lane); }
#else
        { const bf16* MK = WSB(WS_MKV) + (size_t)l * 2 * MEMT * MEMW; const bf16* MV = MK + (size_t)MEMT * MEMW;
          for (int u = blockIdx.x; u < 256; u += gridDim.x) {
              const int b = u >> 6, h = (u >> 4) & 3, qb = u & 15; const size_t qoff = (size_t)(b * SEQ + qb * 256) * MEMW + h * 128, koff = (size_t)(b * MEML) * MEMW + h * 128;
              memattn::attn_dense_body<memattn::bf16>((const memattn::bf16*)(WSB(WS_QM) + qoff), (const memattn::bf16*)(MK + koff), (const memattn::bf16*)(MV + koff),
                                                      (memattn::bf16*)(WSB(WS_OM) + qoff), MEML, (char*)lds + RING_OFF);
              __syncthreads(); } }
#endif
        GRID_BAR();
        {
            pg8::Gemm g{WSB(WS_OM), WSB(WS_WMO) + (size_t)l * D * MEMW, T, D, MEMW}; pg8::StaticOrder S; S.init(T, D, gridDim.x, blockIdx.x);
            pg8::EpiRes E{OUTP(), OUTP(), WSB(WS_XB), WSF(WS_SS)};
            pg8::gemm_phase<pg8::EpiRes, pg8::StaticOrder, PG8_ALIGN, PG8_SP2>(L + RING_OFF, g, S, E);
        }
        GRID_BAR();
        for (int p = 0; p < 3; ++p) {
            const int tp0 = 8 * p, ntp = p < 2 ? 8 : 6;
            {
                pg8::Gemm g{WSB(WS_XB), WSB(WS_WUP) + (size_t)l * DFF2 * D + (size_t)tp0 * 256 * D, T, ntp * 256, D}; pg8::StaticOrder S; S.init(T, ntp * 256, gridDim.x, blockIdx.x);
                pg8::EpiSB E{WSB(WS_UP), ntp * 256, WSF(WS_SS), 0, 0, 1.f};
                pg8::gemm_phase<pg8::EpiSB, pg8::StaticOrder, PG8_ALIGN, PG8_SP2>(L + RING_OFF, g, S, E);
            }
            GRID_BAR();
            { const Ids I = ids(); conv_act_pass(WSB(WS_UP), ntp, tp0, INP(15) + (size_t)l * 3 * DFF2, INP(16) + (size_t)l * DFF2, WSB(WS_ACT), I.gtid, I.NGT); }
            GRID_BAR();
        }
        {
            pg8::Gemm g{WSB(WS_ACT), WSB(WS_WDN) + (size_t)l * D * DFF, T, D, DFF}; pg8::StaticOrder S; S.init(T, D, gridDim.x, blockIdx.x);
            pg8::EpiRes E{OUTP(), OUTP(), WSB(WS_XB), WSF(WS_SS)};
            pg8::gemm_phase<pg8::EpiRes, pg8::StaticOrder, PG8_ALIGN, PG8_SP2>(L + RING_OFF, g, S, E);
        }
        GRID_BAR();
    }
    {
        const Ids I = ids(); const int lane = I.lane;
        const float* gf = INP(18); float* X = OUTP();
        for (int m = I.gw; m < T; m += I.NGW) {
            GAS f32x4* xr = (GAS f32x4*)(X + (size_t)m * D) + lane;
            f32x4 v[4]; float s = 0.f;
#pragma unroll
            for (int j = 0; j < 4; ++j) { v[j] = xr[64 * j]; s += (v[j].x * v[j].x + v[j].y * v[j].y) + (v[j].z * v[j].z + v[j].w * v[j].w); }
            const float rs = 1.0f / sqrtf(wave_sum(s) * (1.0f / D) + 1e-6f);
#pragma unroll
            for (int j = 0; j < 4; ++j) { const f32x4 gg = *((const f32x4*)gf + lane + 64 * j); xr[64 * j] = v[j] * rs * gg; }
        }
    }
}

extern "C" void kernel_launch(void* const* d_in, const int* in_sizes, int n_in, void* d_out, int out_size, void* d_ws, size_t ws_size, hipStream_t stream) {
    static int grid = 0;
    if (grid == 0) {
        if (n_in != 19 || in_sizes[0] != T * D || out_size != T * D || ws_size < WS_END) { fprintf(stderr, "kernel_launch: shape mismatch n_in %d in0 %d out %d ws %zu\n", n_in, n_in > 0 ? in_sizes[0] : -1, out_size, ws_size); grid = -1; return; }
        int dev = 0, cus = 0;
        if (hipGetDevice(&dev) != hipSuccess || hipDeviceGetAttribute(&cus, hipDeviceAttributeMultiprocessorCount, dev) != hipSuccess) { grid = -1; return; }
        if (hipFuncSetAttribute((const void*)mk_fwd, hipFuncAttributeMaxDynamicSharedMemorySize, LDS_BYTES) != hipSuccess) { fprintf(stderr, "kernel_launch: hipFuncSetAttribute failed\n"); grid = -1; return; }
        int per_cu = 0;
        if (hipOccupancyMaxActiveBlocksPerMultiprocessor(&per_cu, (const void*)mk_fwd, NTHREADS, LDS_BYTES) != hipSuccess || per_cu < 1) fprintf(stderr, "kernel_launch: occupancy query says %d\n", per_cu);
        (void)hipGetLastError();
        grid = cus;
    }
    if (grid < 0) return;
    if (hipMemsetAsync((char*)d_ws + WS_CTL, 0, CTL_ZERO_BYTES, stream) != hipSuccess) { fprintf(stderr, "kernel_launch: memset failed\n"); return; }
    Args a{};
    for (int i = 0; i < 19; ++i) a.in[i] = (const float*)d_in[i];
    a.out = (float*)d_out; a.ws = (unsigned char*)d_ws;
    hipLaunchKernelGGL(mk_fwd, dim3(grid), dim3(NTHREADS), LDS_BYTES, stream, a);
    const hipError_t le = hipPeekAtLastError();
    if (le != hipSuccess) fprintf(stderr, "kernel_launch: launch failed: %s\n", hipGetErrorName(le));
}
```

```cpp
#include <hip/hip_runtime.h>
#include <hip/hip_bf16.h>
#include <cstdio>
#include <cstdint>
#include <cmath>
namespace pg8 {
#define PG8_LAS __attribute__((address_space(3)))
typedef unsigned short bf16_t;
typedef short bf16x8 __attribute__((ext_vector_type(8)));
typedef float f32x4 __attribute__((ext_vector_type(4)));
typedef unsigned u32x4 __attribute__((ext_vector_type(4)));
constexpr int BM = 256, BK = 64, HALF = 128, HTB = HALF * BK * 2  , STAGE_BYTES = 8 * HTB, NXCD = 8, WGM = 8;

__host__ __device__ __forceinline__ int lds_byte(int r, int c) { const int st = (r >> 4) * 2 + (c >> 5), rr = r & 15, cc = c & 31, ob = rr * 64 + cc * 2; return st * 1024 + (ob ^ (((ob >> 9) & 1) << 5)); }
__host__ __device__ __forceinline__ void stage_rc(int b, int& R, int& C) { const int st = b / 1024, sb = b % 1024, swz = sb ^ (((sb >> 9) & 1) << 5); R = (st >> 1) * 16 + swz / 64; C = (st & 1) * 32 + (swz % 64) / 2; }
__host__ __device__ __forceinline__ int perm32(int rho) { const int n = rho >> 4, i = rho & 15; return 8 * (i >> 2) + 4 * n + (i & 3); }

struct Unit { int pm, pn; };
struct Gemm { const bf16_t* A; const bf16_t* Bt; int M, N, K; };

struct StaticOrder {
    int nM, nN, nwg, G, c;
    __host__ __device__ void init(int M, int N, int G_, int c_) { nM = M / BM; nN = N / BM; nwg = nM * nN; G = G_; c = c_; }
    __host__ __device__ bool next(int i, Unit& u) const {
        const long L = (long)i * G + c; if (L >= nwg) return false;
        int wgid = (int)L; { const int q = nwg / NXCD, r = nwg % NXCD, xcd = wgid % NXCD, off = wgid / NXCD; wgid = (xcd < r ? xcd * (q + 1) : r * (q + 1) + (xcd - r) * q) + off; }
        const int nig = WGM * nN, gid = wgid / nig, fm = gid * WGM, gsz = (nM - fm) < WGM ? (nM - fm) : WGM;
        u.pm = fm + ((wgid % nig) % gsz); u.pn = (wgid % nig) / gsz; return true;
    }
    __device__ __forceinline__ void a_ready(const Unit&) const {}
    __device__ __forceinline__ void done(const Unit&) const {}
};

__device__ __forceinline__ unsigned cvt_pk_bf16(float lo, float hi) { unsigned r; asm volatile("v_cvt_pk_bf16_f32 %0, %1, %2" : "=v"(r) : "v"(lo), "v"(hi)); return r; }
typedef float f32x2 __attribute__((ext_vector_type(2)));
typedef unsigned u32x2 __attribute__((ext_vector_type(2)));
__device__ __forceinline__ float row_rs(const float* SS, int row, int fq) {
    const f32x4 v = *(const f32x4*)(SS + (size_t)row * 16 + fq * 4);
    float s = (v[0] + v[1]) + (v[2] + v[3]);
    s += __shfl_xor(s, 16); s += __shfl_xor(s, 32);
    return __builtin_amdgcn_rsqf(s * (1.0f / 1024.0f) + 1e-6f);
}
struct EpiSB {
    static constexpr bool PERM = true, AFTER_DRAIN = false;
    bf16_t* O; int ldc; const float* SS; int split_cols; size_t split_stride; float scale0;
    __device__ __forceinline__ void operator()(const f32x4 (&acc)[2][2][4][2], const Unit& u, int wr, int wc, int fr, int fq) const {
        const int row0 = u.pm * BM + wr * 64 + fr; int colt = u.pn * BM; bf16_t* base = O;
        float sc = 1.f; if (split_cols) { const int t = colt / split_cols; base += (size_t)t * split_stride; colt -= t * split_cols; if (t == 0) sc = scale0; }
        const int col0 = colt + wc * 32 + 8 * fq;
#pragma unroll
        for (int ai = 0; ai < 2; ++ai)
#pragma unroll
            for (int m = 0; m < 4; ++m) { const int row = row0 + ai * HALF + m * 16; const float rs = SS ? row_rs(SS, row, fq) * sc : sc;
                bf16_t* rowp = base + (size_t)row * ldc + col0;
#pragma unroll
                for (int bj = 0; bj < 2; ++bj) { const f32x4 v0 = acc[ai][bj][m][0] * rs, v1 = acc[ai][bj][m][1] * rs;
                    u32x4 w; w.x = cvt_pk_bf16(v0[0], v0[1]); w.y = cvt_pk_bf16(v0[2], v0[3]); w.z = cvt_pk_bf16(v1[0], v1[1]); w.w = cvt_pk_bf16(v1[2], v1[3]);
                    *(u32x4*)(rowp + bj * HALF) = w; } }
    }
};
struct EpiRes {
    static constexpr bool PERM = true, AFTER_DRAIN = false;
    const float* xold; float* xnew; bf16_t* xb; float* SSo;
    __device__ __forceinline__ void operator()(const f32x4 (&acc)[2][2][4][2], const Unit& u, int wr, int wc, int fr, int fq) const {
        const int row0 = u.pm * BM + wr * 64 + fr, col0 = u.pn * BM + wc * 32 + 8 * fq;
#pragma unroll
        for (int ai = 0; ai < 2; ++ai)
#pragma unroll
            for (int m = 0; m < 4; ++m) { const int row = row0 + ai * HALF + m * 16; const size_t off = (size_t)row * 1024 + col0; float ssq = 0.f;
#pragma unroll
                for (int bj = 0; bj < 2; ++bj) {
                    const f32x4 a0 = *(const f32x4*)(xold + off + bj * HALF), a1 = *(const f32x4*)(xold + off + bj * HALF + 4);
                    const f32x4 v0 = a0 + acc[ai][bj][m][0], v1 = a1 + acc[ai][bj][m][1];
                    *(f32x4*)(xnew + off + bj * HALF) = v0; *(f32x4*)(xnew + off + bj * HALF + 4) = v1;
                    u32x4 w; w.x = cvt_pk_bf16(v0[0], v0[1]); w.y = cvt_pk_bf16(v0[2], v0[3]); w.z = cvt_pk_bf16(v1[0], v1[1]); w.w = cvt_pk_bf16(v1[2], v1[3]);
                    *(u32x4*)(xb + off + bj * HALF) = w;
                    ssq += (v0[0] * v0[0] + v0[1] * v0[1]) + (v0[2] * v0[2] + v0[3] * v0[3]) + (v1[0] * v1[0] + v1[1] * v1[1]) + (v1[2] * v1[2] + v1[3] * v1[3]); }
                ssq += __shfl_xor(ssq, 16); ssq += __shfl_xor(ssq, 32);
                if (fq == 0) SSo[(size_t)row * 16 + u.pn * 4 + wc] = ssq; }
    }
};
struct EpiInProj {
    static constexpr bool PERM = true, AFTER_DRAIN = false;
    const float* SS; bf16_t* NQKV; size_t nstride; bf16_t* GQ; bf16_t* GK; bf16_t* GV; const float* rope; const float* qn; const float* kn; float qs_na, qs_g;
    __device__ __forceinline__ void operator()(const f32x4 (&acc)[2][2][4][2], const Unit& u, int wr, int wc, int fr, int fq) const {
        const int row0 = u.pm * BM + wr * 64 + fr;
        if (u.pn < 6) {
            bf16_t* base = NQKV + (size_t)(u.pn >> 1) * nstride; const int col0 = (u.pn & 1) * 256 + wc * 32 + 8 * fq; const float sc = u.pn < 2 ? qs_na : 1.f;
#pragma unroll
            for (int ai = 0; ai < 2; ++ai)
#pragma unroll
                for (int m = 0; m < 4; ++m) { const int row = row0 + ai * HALF + m * 16; const float rs = row_rs(SS, row, fq) * sc;
                    bf16_t* rowp = base + (size_t)row * 512 + col0;
#pragma unroll
                    for (int bj = 0; bj < 2; ++bj) { const f32x4 v0 = acc[ai][bj][m][0] * rs, v1 = acc[ai][bj][m][1] * rs;
                        u32x4 w; w.x = cvt_pk_bf16(v0[0], v0[1]); w.y = cvt_pk_bf16(v0[2], v0[3]); w.z = cvt_pk_bf16(v1[0], v1[1]); w.w = cvt_pk_bf16(v1[2], v1[3]);
                        *(u32x4*)(rowp + bj * HALF) = w; } }
            return;
        }
        const bool isq = u.pn < 8, isv = (u.pn == 8) && (wc >= 2);
        bf16_t* dst; int ld; const float* gain; float post;
        if (isq) { dst = GQ + (4 * (u.pn - 6) + wc) * 64; ld = 512; gain = qn; post = qs_g; }
        else if (!isv) { dst = GK + wc * 64; ld = 128; gain = kn; post = 1.f; }
        else { dst = GV + (wc - 2) * 64; ld = 128; gain = kn; post = 1.f; }
        f32x4 g[2][2];
#pragma unroll
        for (int bj = 0; bj < 2; ++bj)
#pragma unroll
            for (int n = 0; n < 2; ++n) g[bj][n] = *(const f32x4*)(gain + 32 * bj + 16 * n + 4 * fq) * post;
#pragma unroll
        for (int ai = 0; ai < 2; ++ai)
#pragma unroll
            for (int m = 0; m < 4; ++m) { const int row = row0 + ai * HALF + m * 16; const float rs = row_rs(SS, row, fq);
                f32x4 v[2][2]; float ssq = 0.f;
#pragma unroll
                for (int bj = 0; bj < 2; ++bj)
#pragma unroll
                    for (int n = 0; n < 2; ++n) { v[bj][n] = acc[ai][bj][m][n] * rs; const f32x4 x = v[bj][n]; ssq += (x[0] * x[0] + x[1] * x[1]) + (x[2] * x[2] + x[3] * x[3]); }
                bf16_t* rowp = dst + (size_t)row * ld;
                if (!isv) {
                    ssq += __shfl_xor(ssq, 16); ssq += __shfl_xor(ssq, 32);
                    const float inv = __builtin_amdgcn_rsqf(ssq * (1.0f / 64.0f) + 1e-6f);
                    const int pos0 = (row & 4095) >> 6, pos1 = row & 63;
#pragma unroll
                    for (int bj = 0; bj < 2; ++bj) { const int pos = bj == 0 ? pos0 : pos1;
                        const f32x4 c = *(const f32x4*)(rope + pos * 32 + 4 * fq), s = *(const f32x4*)(rope + pos * 32 + 16 + 4 * fq);
                        const f32x4 x1 = v[bj][0] * inv * g[bj][0], x2 = v[bj][1] * inv * g[bj][1];
                        v[bj][0] = x1 * c - x2 * s; v[bj][1] = x1 * s + x2 * c; }
                }
#pragma unroll
                for (int bj = 0; bj < 2; ++bj)
#pragma unroll
                    for (int n = 0; n < 2; ++n) { u32x2 w; w.x = cvt_pk_bf16(v[bj][n][0], v[bj][n][1]); w.y = cvt_pk_bf16(v[bj][n][2], v[bj][n][3]);
                        *(u32x2*)(rowp + 32 * bj + 16 * n + 4 * fq) = w; } }
    }
};

template <int CTRL> __device__ __forceinline__ float dppf(float old, float src) { return __int_as_float(__builtin_amdgcn_update_dpp(__float_as_int(old), __float_as_int(src), CTRL, 0xf, 0xf, false)); }
struct EpiUpConv {
    static constexpr bool PERM = true, AFTER_DRAIN = false;
    const float* SS; const float* cw; const float* cb; bf16_t* ACT; float* EDGE;
    __device__ __forceinline__ void operator()(const f32x4 (&acc)[2][2][4][2], const Unit& u, int wr, int wc, int fr, int fq) const {
        constexpr int FF = 2816, FF2 = 5632;
        const int row0 = u.pm * BM + wr * 64 + fr, ch0 = u.pn * 128 + wc * 32 + 8 * fq;
        float rs[2][4];
#pragma unroll
        for (int ai = 0; ai < 2; ++ai)
#pragma unroll
            for (int m = 0; m < 4; ++m) rs[ai][m] = row_rs(SS, row0 + ai * HALF + m * 16, fq);
        u32x2 pk0[2][4];
#pragma unroll
        for (int n = 0; n < 2; ++n) {
            const int ch = ch0 + 4 * n;
            f32x4 wg[3], wv[3];
#pragma unroll
            for (int k = 0; k < 3; ++k) { wg[k] = *(const f32x4*)(cw + k * FF2 + ch); wv[k] = *(const f32x4*)(cw + k * FF2 + FF + ch); }
            const f32x4 bg = *(const f32x4*)(cb + ch), bv = *(const f32x4*)(cb + FF + ch);
#pragma unroll
            for (int ai = 0; ai < 2; ++ai) {
                f32x4 ug[4], uv[4];
#pragma unroll
                for (int m = 0; m < 4; ++m) { ug[m] = acc[ai][0][m][n] * rs[ai][m]; uv[m] = acc[ai][1][m][n] * rs[ai][m]; }
                { const int blk = u.pm * 4 + ai * 2 + wr;
                  if (fr < 2) { float* ep = EDGE + ((size_t)blk * 4 + fr) * FF2 + ch; *(f32x4*)ep = ug[0]; *(f32x4*)(ep + FF) = uv[0]; }
                  if (fr >= 14) { float* ep = EDGE + ((size_t)blk * 4 + (fr - 12)) * FF2 + ch; *(f32x4*)ep = ug[3]; *(f32x4*)(ep + FF) = uv[3]; } }
#pragma unroll
                for (int m = 0; m < 4; ++m) {
                    float a[4];
#pragma unroll
                    for (int e = 0; e < 4; ++e) {
                        const float gp = dppf<0x111>(m > 0 ? dppf<0x121>(0.f, ug[m > 0 ? m - 1 : 0][e]) : 0.f, ug[m][e]);
                        const float gn = dppf<0x101>(m < 3 ? dppf<0x12F>(0.f, ug[m < 3 ? m + 1 : 3][e]) : 0.f, ug[m][e]);
                        const float vp = dppf<0x111>(m > 0 ? dppf<0x121>(0.f, uv[m > 0 ? m - 1 : 0][e]) : 0.f, uv[m][e]);
                        const float vn = dppf<0x101>(m < 3 ? dppf<0x12F>(0.f, uv[m < 3 ? m + 1 : 3][e]) : 0.f, uv[m][e]);
                        const float gg = wg[0][e] * gp + wg[1][e] * ug[m][e] + wg[2][e] * gn + bg[e];
                        const float vv = wv[0][e] * vp + wv[1][e] * uv[m][e] + wv[2][e] * vn + bv[e];
                        a[e] = gg * __builtin_amdgcn_rcpf(1.0f + __builtin_amdgcn_exp2f(gg * -1.4426950408889634f)) * vv;
                    }
                    u32x2 w; w.x = cvt_pk_bf16(a[0], a[1]); w.y = cvt_pk_bf16(a[2], a[3]);
                    if (n == 0) pk0[ai][m] = w;
                    else { u32x4 o; o.x = pk0[ai][m].x; o.y = pk0[ai][m].y; o.z = w.x; o.w = w.y;
                           *(u32x4*)(ACT + (size_t)(row0 + ai * HALF + m * 16) * FF + ch0) = o; }
                }
            }
        }
    }
};

template <class Epi, class Sched, bool ALIGN_EPI = false, bool SP2 = false>
__device__ __forceinline__ void gemm_phase(PG8_LAS unsigned char* lds, const Gemm g, const Sched& S, const Epi& E) {
    int tid_ = threadIdx.x; asm volatile("" : "+v"(tid_));
    const int tid = tid_, wid = __builtin_amdgcn_readfirstlane(tid >> 6), lane = tid & 63, wr = wid >> 2, wc = wid & 3, fr = lane & 15, fq = lane >> 4;
    const int K = g.K, nt = K / BK;
    unsigned voffA[2], voffB[2];
#pragma unroll
    for (int i = 0; i < 2; ++i) { int R, C; stage_rc(tid * 16 + i * 8192, R, C); const int Rb = Epi::PERM ? ((R & ~31) + perm32(R & 31)) : R;
        voffA[i] = (unsigned)(R * K + C) * 2u; voffB[i] = (unsigned)(Rb * K + C) * 2u; }
    const size_t kstep = (size_t)(BK * 2);
    const size_t hstep = (size_t)HALF * K * 2;
    const size_t tstep = 2 * hstep;
    const unsigned ldsw = (unsigned)wid * 1024u;
    const int aoff = lds_byte(wr * 64 + fr, fq * 8), boff = lds_byte(wc * 32 + fr, fq * 8);
#define PG8_SA(b, h) (((b) * 2 + (h)) * HTB)
#define PG8_SB(b, h) ((4 + (b) * 2 + (h)) * HTB)
#define PG8_STAGE(bufoff, gbase, voff) do { _Pragma("unroll") for (int _i = 0; _i < 2; ++_i) \
        __builtin_amdgcn_global_load_lds((const unsigned*)((const char*)(gbase) + (voff)[_i]), (PG8_LAS unsigned*)(lds + (bufoff) + ldsw + _i * 8192), 16, 0, 0); } while (0)
#define PG8_LDA(dst, b, h) do { _Pragma("unroll") for (int m = 0; m < 4; ++m) _Pragma("unroll") for (int k = 0; k < 2; ++k) dst[m][k] = *(const PG8_LAS bf16x8*)(lds + PG8_SA(b, h) + aoff + m * 2048 + k * 1024); } while (0)
#define PG8_LDB(dst, b, h) do { _Pragma("unroll") for (int n = 0; n < 2; ++n) _Pragma("unroll") for (int k = 0; k < 2; ++k) dst[n][k] = *(const PG8_LAS bf16x8*)(lds + PG8_SB(b, h) + boff + n * 2048 + k * 1024); } while (0)
#define PG8_MMA(ai, bj, At, Bt) do { __builtin_amdgcn_s_setprio(1); _Pragma("unroll") for (int m = 0; m < 4; ++m) _Pragma("unroll") for (int n = 0; n < 2; ++n) _Pragma("unroll") for (int k = 0; k < 2; ++k) \
        acc[ai][bj][m][n] = __builtin_amdgcn_mfma_f32_16x16x32_bf16(Bt[n][k], At[m][k], acc[ai][bj][m][n], 0, 0, 0); __builtin_amdgcn_s_setprio(0); } while (0)
#define PG8_WAIT_V(n) asm volatile("s_waitcnt vmcnt(" #n ")" ::: "memory")
#define PG8_WAIT_L(n) asm volatile("s_waitcnt lgkmcnt(" #n ")" ::: "memory")
#define PG8_BAR __builtin_amdgcn_s_barrier()
#define PG8_SCHED __builtin_amdgcn_sched_barrier(0)
    Unit cur, nxt; int ui = 0;
    if (!S.next(0, cur)) return;
    f32x4 acc[2][2][4][2];
#pragma unroll
    for (int a = 0; a < 2; ++a)
#pragma unroll
        for (int b = 0; b < 2; ++b)
#pragma unroll
            for (int m = 0; m < 4; ++m)
#pragma unroll
                for (int n = 0; n < 2; ++n) acc[a][b][m][n] = (f32x4){0.f, 0.f, 0.f, 0.f};
    bf16x8 At[4][2], B0[2][2], B1[2][2];
    const char* cA = (const char*)g.A + (size_t)cur.pm * tstep; const char* cB = (const char*)g.Bt + (size_t)cur.pn * tstep;
    S.a_ready(cur);
    if constexpr (SP2) {
        PG8_STAGE(PG8_SB(0, 0), cB, voffB); PG8_STAGE(PG8_SB(0, 1), cB + hstep, voffB); PG8_STAGE(PG8_SA(0, 0), cA, voffA); PG8_STAGE(PG8_SA(0, 1), cA + hstep, voffA);
        if (wr == 1) PG8_BAR;
        PG8_WAIT_V(2); PG8_BAR;
        PG8_STAGE(PG8_SB(1, 0), cB + kstep, voffB); PG8_STAGE(PG8_SA(1, 0), cA + kstep, voffA); PG8_STAGE(PG8_SB(1, 1), cB + hstep + kstep, voffB);
        PG8_WAIT_V(6); PG8_BAR;
    } else {
        PG8_STAGE(PG8_SB(0, 0), cB, voffB); PG8_STAGE(PG8_SA(0, 0), cA, voffA); PG8_STAGE(PG8_SB(0, 1), cB + hstep, voffB); PG8_STAGE(PG8_SA(0, 1), cA + hstep, voffA);
        if (wr == 1) PG8_BAR;
        PG8_WAIT_V(4); PG8_BAR;
        PG8_STAGE(PG8_SB(1, 0), cB + kstep, voffB); PG8_STAGE(PG8_SA(1, 0), cA + kstep, voffA); PG8_STAGE(PG8_SB(1, 1), cB + hstep + kstep, voffB);
        PG8_WAIT_V(6); PG8_BAR;
    }
    for (;;) {
        const bool has_next = S.next(ui + 1, nxt);
        const char* nA = has_next ? (const char*)g.A + (size_t)nxt.pm * tstep : cA; const char* nB = has_next ? (const char*)g.Bt + (size_t)nxt.pn * tstep : cB;
        for (int t = 0; t < nt; t += 2) {
            const bool last = (t == nt - 2);
            const char* a1 = cA + (size_t)(t + 1) * kstep;
            const char* a2 = last ? nA : cA + (size_t)(t + 2) * kstep; const char* b2 = last ? nB : cB + (size_t)(t + 2) * kstep;
            const char* a3 = a2 + kstep; const char* b3 = b2 + kstep;
            if (last && has_next) S.a_ready(nxt);
            if constexpr (SP2) {
            PG8_LDB(B0, 0, 0); PG8_LDB(B1, 0, 1); PG8_SCHED; PG8_LDA(At, 0, 0); PG8_STAGE(PG8_SA(1, 1), a1 + hstep, voffA);
            PG8_WAIT_V(8); PG8_WAIT_L(0); PG8_BAR; PG8_MMA(0, 0, At, B0); PG8_MMA(0, 1, At, B1); PG8_BAR; PG8_SCHED;
            PG8_LDA(At, 0, 1); PG8_STAGE(PG8_SB(0, 0), b2, voffB); PG8_STAGE(PG8_SB(0, 1), b2 + hstep, voffB); PG8_STAGE(PG8_SA(0, 0), a2, voffA);
            PG8_WAIT_V(8); PG8_WAIT_L(0); PG8_BAR; PG8_MMA(1, 0, At, B0); PG8_MMA(1, 1, At, B1); PG8_BAR; PG8_SCHED;
            PG8_LDB(B0, 1, 0); PG8_LDB(B1, 1, 1); PG8_SCHED; PG8_LDA(At, 1, 0); PG8_STAGE(PG8_SA(0, 1), a2 + hstep, voffA);
            PG8_WAIT_V(8); PG8_WAIT_L(0); PG8_BAR; PG8_MMA(0, 0, At, B0); PG8_MMA(0, 1, At, B1); PG8_BAR; PG8_SCHED;
            PG8_LDA(At, 1, 1); PG8_STAGE(PG8_SB(1, 0), b3, voffB); PG8_STAGE(PG8_SB(1, 1), b3 + hstep, voffB); PG8_STAGE(PG8_SA(1, 0), a3, voffA);
            PG8_WAIT_V(8); PG8_WAIT_L(0); PG8_BAR; PG8_MMA(1, 0, At, B0); PG8_MMA(1, 1, At, B1); PG8_BAR; PG8_SCHED;
            } else {
            PG8_LDB(B0, 0, 0); PG8_SCHED; PG8_LDA(At, 0, 0); PG8_STAGE(PG8_SA(1, 1), a1 + hstep, voffA);
            PG8_WAIT_L(8); PG8_BAR; PG8_WAIT_L(0); PG8_MMA(0, 0, At, B0); PG8_BAR; PG8_SCHED;
            PG8_LDB(B1, 0, 1); PG8_STAGE(PG8_SB(0, 0), b2, voffB);
            PG8_BAR; PG8_WAIT_L(0); PG8_MMA(0, 1, At, B1); PG8_BAR;
            PG8_LDA(At, 0, 1); PG8_STAGE(PG8_SA(0, 0), a2, voffA);
            PG8_BAR; PG8_WAIT_L(0); PG8_MMA(1, 0, At, B0); PG8_BAR; PG8_SCHED;
            PG8_STAGE(PG8_SB(0, 1), b2 + hstep, voffB);
            PG8_WAIT_V(6); PG8_BAR; PG8_MMA(1, 1, At, B1); PG8_BAR;
            PG8_LDB(B0, 1, 0); PG8_SCHED; PG8_LDA(At, 1, 0); PG8_STAGE(PG8_SA(0, 1), a2 + hstep, voffA);
            PG8_WAIT_L(8); PG8_BAR; PG8_WAIT_L(0); PG8_MMA(0, 0, At, B0); PG8_BAR; PG8_SCHED;
            PG8_LDB(B1, 1, 1); PG8_STAGE(PG8_SB(1, 0), b3, voffB);
            PG8_BAR; PG8_WAIT_L(0); PG8_MMA(0, 1, At, B1); PG8_BAR;
            PG8_LDA(At, 1, 1); PG8_STAGE(PG8_SA(1, 0), a3, voffA);
            PG8_BAR; PG8_WAIT_L(0); PG8_MMA(1, 0, At, B0); PG8_BAR; PG8_SCHED;
            PG8_STAGE(PG8_SB(1, 1), b3 + hstep, voffB);
            PG8_WAIT_V(6); PG8_BAR; PG8_MMA(1, 1, At, B1); PG8_BAR;
            }
        }
        if constexpr (ALIGN_EPI) { if (wr == 0) PG8_BAR; }
        if constexpr (!Epi::AFTER_DRAIN) { E(acc, cur, wr, wc, fr, fq); S.done(cur); }
        if (!has_next) break;
#pragma unroll
        for (int a = 0; a < 2; ++a)
#pragma unroll
            for (int b = 0; b < 2; ++b)
#pragma unroll
                for (int m = 0; m < 4; ++m)
#pragma unroll
                    for (int n = 0; n < 2; ++n) acc[a][b][m][n] = (f32x4){0.f, 0.f, 0.f, 0.f};
        cur = nxt; cA = nA; cB = nB; ++ui;
        if constexpr (ALIGN_EPI) { if (wr == 1) PG8_BAR; }
    }
    PG8_WAIT_V(0);
    if constexpr (!ALIGN_EPI) { if (wr == 0) PG8_BAR; }
    PG8_BAR;
    if constexpr (Epi::AFTER_DRAIN) { E.fused(acc, cur, wr, wc, fr, fq, lds, wid, lane); S.done(cur); }
#undef PG8_SA
#undef PG8_SB
#undef PG8_STAGE
#undef PG8_LDA
#undef PG8_LDB
#undef PG8_MMA
#undef PG8_WAIT_V
#undef PG8_WAIT_L
#undef PG8_BAR
#undef PG8_SCHED
}
}
namespace attn_body {
using bf16=__hip_bfloat16;
using bf16x8=__attribute__((ext_vector_type(8)))short;
using s16x4=__attribute__((ext_vector_type(4)))short;
using f32x16=__attribute__((ext_vector_type(16)))float;
using u32x4=__attribute__((ext_vector_type(4)))unsigned;
constexpr int BATCH=4,NHEAD=8,SEQ=4096,D=64;
constexpr int PQ=512,PK=128,PO=1024,OCOL=512;
constexpr int NW=8,QBLK=32,QB=QBLK*NW,KVBLK=64,NQB=SEQ/QB;
constexpr int ATTN_UNIT_ROWS=QB;
__device__ __forceinline__ int crow(int r,int hi){return (r&3)+8*(r>>2)+4*hi;}
#define SBAR() __builtin_amdgcn_sched_barrier(0)
__device__ __forceinline__ void cmask(f32x16&p0,f32x16&p1,int jb,int qrel,int hi){
  const float NEG=-INFINITY; int kb=64*jb+4*hi;
  #pragma unroll
  for(int r=0;r<16;++r){int kv=kb+(r&3)+8*(r>>2); if(kv>qrel)p0[r]=NEG; if(kv+32>qrel)p1[r]=NEG;}
}

constexpr int NSLOT=3, SLOTB=8192;
constexpr int LDS_K=0, LDS_V=NSLOT*SLOTB, LDS_WS=2*NSLOT*SLOTB, LDS_OST=LDS_WS+NW*64*4, LDS_BYTES=LDS_OST+NW*4096;
constexpr float C2=0.125f*1.4426950408889634f;
__device__ __forceinline__ void glds16(const void*gsrc,unsigned lds_dst){unsigned keep;
  asm volatile("s_mov_b32 %0, m0\n\ts_mov_b32 m0, %2\n\ts_nop 0\n\tglobal_load_lds_dwordx4 %1, off\n\ts_mov_b32 m0, %0":"=&s"(keep):"v"(gsrc),"s"(lds_dst):"memory");}
__device__ __forceinline__ float max3f(float a,float b,float c){float r;asm("v_max3_f32 %0, %1, %2, %3":"=v"(r):"v"(a),"v"(b),"v"(c));return r;}
__device__ __forceinline__ float max2f(float a,float b){float r;asm("v_max_f32_e32 %0, %1, %2":"=v"(r):"v"(a),"v"(b));return r;}
__device__ __forceinline__ float fadd_s(float a,float b){float r;asm("v_add_f32_e32 %0, %1, %2":"=v"(r):"v"(a),"v"(b));return r;}
__device__ __forceinline__ float fsub_s(float a,float b){float r;asm("v_sub_f32_e32 %0, %1, %2":"=v"(r):"v"(a),"v"(b));return r;}
typedef float f32x2_t __attribute__((ext_vector_type(2))); typedef __bf16 bf16x2_t __attribute__((ext_vector_type(2)));
__device__ __forceinline__ unsigned cvtpk_s(float lo,float hi){f32x2_t v={lo,hi};bf16x2_t b=__builtin_convertvector(v,bf16x2_t);return __builtin_bit_cast(unsigned,b);}
#define WAIT_BAR(N) asm volatile("s_waitcnt vmcnt(" #N ") lgkmcnt(0)\n\ts_barrier":::"memory")

__device__ __forceinline__ void qkt(f32x16&p0,f32x16&p1,const char*Kslot,const bf16x8*qr,const f32x16&negm,int r32,int hi){
  const char*kb=Kslot+hi*1024+r32*16;
  #pragma unroll
  for(int d0=0;d0<4;++d0){
    const bf16x8 b0=*reinterpret_cast<const bf16x8*>(kb+d0*2048);
    const bf16x8 b1=*reinterpret_cast<const bf16x8*>(kb+d0*2048+512);
    if(d0==0){p0=__builtin_amdgcn_mfma_f32_32x32x16_bf16(b0,qr[0],negm,0,0,0);p1=__builtin_amdgcn_mfma_f32_32x32x16_bf16(b1,qr[0],negm,0,0,0);}
    else{p0=__builtin_amdgcn_mfma_f32_32x32x16_bf16(b0,qr[d0],p0,0,0,0);p1=__builtin_amdgcn_mfma_f32_32x32x16_bf16(b1,qr[d0],p1,0,0,0);}}
}
typedef __attribute__((address_space(3))) const char* lds_cptr;
typedef short v4i16_t __attribute__((ext_vector_type(4)));
__device__ __forceinline__ void kload8(bf16x8*kf,lds_cptr kp){
  kf[0]=*(const __attribute__((address_space(3))) bf16x8*)(kp);      kf[1]=*(const __attribute__((address_space(3))) bf16x8*)(kp+512);
  kf[2]=*(const __attribute__((address_space(3))) bf16x8*)(kp+2048); kf[3]=*(const __attribute__((address_space(3))) bf16x8*)(kp+2560);
  kf[4]=*(const __attribute__((address_space(3))) bf16x8*)(kp+4096); kf[5]=*(const __attribute__((address_space(3))) bf16x8*)(kp+4608);
  kf[6]=*(const __attribute__((address_space(3))) bf16x8*)(kp+6144); kf[7]=*(const __attribute__((address_space(3))) bf16x8*)(kp+6656);
}
__device__ __forceinline__ void kload2(bf16x8*kf,lds_cptr kp,int j){ kf[2*j]=*(const __attribute__((address_space(3))) bf16x8*)(kp+j*2048); kf[2*j+1]=*(const __attribute__((address_space(3))) bf16x8*)(kp+j*2048+512); }
__device__ __forceinline__ s16x4 vtr(lds_cptr p){ return __builtin_bit_cast(s16x4,__builtin_amdgcn_ds_read_tr16_b64_v4i16((__attribute__((address_space(3))) v4i16_t*)p)); }
__device__ __forceinline__ float rowmax(const f32x16&p0,const f32x16&p1){
  float a=max3f(p0[0],p0[1],p1[0]),b=max3f(p0[2],p0[3],p1[1]);a=max3f(a,p1[2],p1[3]);
  #pragma unroll
  for(int r=4;r<16;r+=4){a=max3f(a,p0[r],p0[r+1]);b=max3f(b,p0[r+2],p0[r+3]);a=max3f(a,p1[r],p1[r+1]);b=max3f(b,p1[r+2],p1[r+3]);}
  const float m=max2f(a,b);
  auto rr=__builtin_amdgcn_permlane32_swap(__float_as_uint(m),__float_as_uint(m),false,false);
  return max2f(__uint_as_float(rr[0]),__uint_as_float(rr[1]));
}
__device__ __forceinline__ void pv(f32x16*o,int vb,bf16x8 pa0,bf16x8 pa1,bf16x8 pa2,bf16x8 pa3){
  #pragma unroll
  for(int d0=0;d0<2;++d0){s16x4 lo[4],hi[4];
    #pragma unroll
    for(int ks=0;ks<4;++ks){
      asm volatile("ds_read_b64_tr_b16 %0,%1 offset:%c2":"=&v"(lo[ks]):"v"(vb),"i"(d0*4096+ks*1024):"memory");
      asm volatile("ds_read_b64_tr_b16 %0,%1 offset:%c2":"=&v"(hi[ks]):"v"(vb),"i"(d0*4096+ks*1024+512):"memory");}
    asm volatile("s_waitcnt lgkmcnt(0)":::"memory");SBAR();
    #define PK(k) (bf16x8){lo[k][0],lo[k][1],lo[k][2],lo[k][3],hi[k][0],hi[k][1],hi[k][2],hi[k][3]}
    o[d0]=__builtin_amdgcn_mfma_f32_32x32x16_bf16(pa0,PK(0),o[d0],0,0,0);
    o[d0]=__builtin_amdgcn_mfma_f32_32x32x16_bf16(pa1,PK(1),o[d0],0,0,0);
    o[d0]=__builtin_amdgcn_mfma_f32_32x32x16_bf16(pa2,PK(2),o[d0],0,0,0);
    o[d0]=__builtin_amdgcn_mfma_f32_32x32x16_bf16(pa3,PK(3),o[d0],0,0,0);
    #undef PK
  }
}

#ifndef ATTN_STORE16
#define ATTN_STORE16(p,v) (*(u32x4*)(p)=(v))
#endif
template<int THRL> __device__ __forceinline__ void attn_unit(int b,int h,int qb,const bf16*Q,const bf16*__restrict__ K,const bf16*__restrict__ V,bf16*O,char*shm){
  int tid_=threadIdx.x; asm volatile("":"+v"(tid_));
  const int tid=tid_,lane=tid&63,r32=lane&31,hi=lane>>5; const int wid=__builtin_amdgcn_readfirstlane(tid>>6);
  const long rowbase=(long)b*SEQ; const int q0=qb*QB;
  const bf16*Qw=Q+(rowbase+q0+wid*QBLK)*PQ+h*D;
  const bf16*Kh=K+rowbase*PK+(h>>2)*D,*Vh=V+rowbase*PK+(h>>2)*D;
  const unsigned lds0=(unsigned)(uintptr_t)shm;
  float*wsf=(float*)(shm+LDS_WS)+wid*64;
  const bf16*ksrc=Kh+(long)lane*PK+wid*8;
  const bf16*vsrc=Vh+(long)(16*(wid&3)+(lane>>2))*PK+(wid>>2)*32+(lane&3)*8;
  const unsigned kdst=lds0+LDS_K+wid*1024, vdst=lds0+LDS_V+wid*1024;
  #define DMA_K(t,slot) glds16(ksrc+(long)(t)*KVBLK*PK,(unsigned)__builtin_amdgcn_readfirstlane(kdst+(slot)))
  #define DMA_V(t,slot) glds16(vsrc+(long)(t)*KVBLK*PK,(unsigned)__builtin_amdgcn_readfirstlane(vdst+(slot)))
  const int vb0=(int)(lds0+LDS_V)+((lane>>4)&1)*32+(lane&3)*8+(4*hi+((lane&15)>>2))*64;
  const char*Kbase=shm+LDS_K; bf16x8 kf[8];
  const lds_cptr shm3=(lds_cptr)shm; const lds_cptr kp0=shm3+LDS_K+hi*1024+r32*16; const lds_cptr vp0=shm3+LDS_V+((lane>>4)&1)*32+(lane&3)*8+(4*hi+((lane&15)>>2))*64;
  constexpr int NT=SEQ/KVBLK;
  DMA_K(0,0);DMA_V(0,0);DMA_K(1,SLOTB);
  bf16x8 qr[4];
  #pragma unroll
  for(int d0=0;d0<4;++d0)qr[d0]=*reinterpret_cast<const bf16x8*>(&Qw[(long)r32*PQ+d0*16+hi*8]);
  float mhat=0.f,l_reg=0.f;f32x16 o[2];o[0]=f32x16{};o[1]=f32x16{};f32x16 negm=f32x16{};asm volatile("":"+v"(negm));
  #define CMASK(P0,P1,t) do{}while(0)
  bool resc=false;
  #define START(P0,P1) do{ const float rm=rowmax(P0,P1); resc=false; \
    { const float dl=rm; mhat=fadd_s(mhat,dl); \
      _Pragma("unroll") for(int r=0;r<16;++r){P0[r]=fsub_s(P0[r],dl);P1[r]=fsub_s(P1[r],dl);} \
      _Pragma("unroll") for(int r=0;r<16;++r)negm[r]=-mhat; asm volatile("":"+v"(negm)); } \
    _Pragma("unroll") for(int r=0;r<16;++r)P0[r]=__builtin_amdgcn_exp2f(P0[r]); }while(0)
  #define RESC() do{ if(resc){ asm volatile("s_waitcnt lgkmcnt(0)":::"memory"); \
      _Pragma("unroll") for(int d_=0;d_<2;++d_) _Pragma("unroll") for(int r=0;r<16;++r)o[d_][r]*=wsf[crow(r,hi)]; } }while(0)
  f32x16 pA0,pA1,pB0,pB1;
  int sl_prev=0,sl_cur=0,sl_next=SLOTB;
  #define ROT() do{sl_prev=sl_cur;sl_cur=sl_next;sl_next=(sl_next==(NSLOT-1)*SLOTB)?0:sl_next+SLOTB;}while(0)
  DMA_K(2,2*SLOTB);
  WAIT_BAR(3);
  qkt(pA0,pA1,Kbase,qr,negm,r32,hi);asm volatile("s_nop 15\n\ts_nop 7":"+v"(pA0),"+v"(pA1));CMASK(pA0,pA1,0);
  START(pA0,pA1);
  _Pragma("unroll") for(int r=0;r<16;++r)pA1[r]=__builtin_amdgcn_exp2f(pA1[r]);
  WAIT_BAR(0);
  DMA_K(3,0);DMA_V(1,SLOTB);
  ROT();
  kload8(kf,kp0+sl_cur);
  WAIT_BAR(2);
  s16x4 vlo[8],vhi[8]; u32x4 pw0,pw1,pw2,pw3;
  #define PKW(P,B) cvtpk_s(P[B],P[B+1])
  #define PAF(k) __builtin_bit_cast(bf16x8,pw##k)
  #define VFR(i) (bf16x8){vlo[i][0],vlo[i][1],vlo[i][2],vlo[i][3],vhi[i][0],vhi[i][1],vhi[i][2],vhi[i][3]}
  #define PIN(x) asm volatile("":"+v"(x))
  #define MX3(a,b,c) __builtin_fmaxf(__builtin_fmaxf((a),(b)),(c))
  #define GAPA(MF,A0,A1,A2,A3,W0,W1,PW) do{ MF; sacc+=A0; sacc+=A1; sacc+=A2; sacc+=A3; PIN(sacc); W0; W1; PIN(PW); SBAR(); }while(0)
  #define EX(v) __builtin_amdgcn_exp2f(v)
  #define GAPB(MF,X,B) do{ MF; X[B]=EX(X[B]); X[B+1]=EX(X[B+1]); X[B+2]=EX(X[B+2]); X[B+3]=EX(X[B+3]); PIN(X); SBAR(); }while(0)
  #define VRD(i) do{ vlo[i]=vtr(vp_+(((i)>>2)*4096+((i)&3)*1024)); vhi[i]=vtr(vp_+(((i)>>2)*4096+((i)&3)*1024+512)); }while(0)
  #define KRD(G,j) do{ if(G){ kload2(kf,kp0+sl_next,j); SBAR(); } }while(0)
  #define STEP(C0,C1,P0,P1,t,GK,GV,GL) do{ SBAR(); \
    const lds_cptr vp_=vp0+sl_prev; \
    VRD(0); SBAR(); float sacc=(P0[0]+P0[1]); \
    GAPA(C0=__builtin_amdgcn_mfma_f32_32x32x16_bf16(kf[0],qr[0],negm,0,0,0), P0[2],P0[3],P0[4],P0[5],     pw0[0]=PKW(P0,0), pw0[1]=PKW(P0,2), pw0); \
    VRD(4); SBAR(); GAPA(C1=__builtin_amdgcn_mfma_f32_32x32x16_bf16(kf[1],qr[0],negm,0,0,0), P0[6],P0[7],P0[8],P0[9],     pw0[2]=PKW(P0,4), pw0[3]=PKW(P0,6), pw0); \
    VRD(1); SBAR(); GAPA(C0=__builtin_amdgcn_mfma_f32_32x32x16_bf16(kf[2],qr[1],C0,0,0,0),   P0[10],P0[11],P0[12],P0[13], pw1[0]=PKW(P0,8), pw1[1]=PKW(P0,10), pw1); \
    VRD(5); SBAR(); GAPA(C1=__builtin_amdgcn_mfma_f32_32x32x16_bf16(kf[3],qr[1],C1,0,0,0),   P0[14],P0[15],P1[0],P1[1],   pw1[2]=PKW(P0,12),pw1[3]=PKW(P0,14), pw1); \
    VRD(2); SBAR(); GAPA(C0=__builtin_amdgcn_mfma_f32_32x32x16_bf16(kf[4],qr[2],C0,0,0,0),   P1[2],P1[3],P1[4],P1[5],     pw2[0]=PKW(P1,0), pw2[1]=PKW(P1,2), pw2); \
    VRD(6); SBAR(); GAPA(C1=__builtin_amdgcn_mfma_f32_32x32x16_bf16(kf[5],qr[2],C1,0,0,0),   P1[6],P1[7],P1[8],P1[9],     pw2[2]=PKW(P1,4), pw2[3]=PKW(P1,6), pw2); \
    VRD(3); SBAR(); GAPA(C0=__builtin_amdgcn_mfma_f32_32x32x16_bf16(kf[6],qr[3],C0,0,0,0),   P1[10],P1[11],P1[12],P1[13], pw3[0]=PKW(P1,8), pw3[1]=PKW(P1,10), pw3); \
    VRD(7); SBAR(); GAPA(C1=__builtin_amdgcn_mfma_f32_32x32x16_bf16(kf[7],qr[3],C1,0,0,0),   P1[14],P1[15],0.f,0.f,       pw3[2]=PKW(P1,12),pw3[3]=PKW(P1,14), pw3); \
    l_reg+=sacc; \
    if(GK){DMA_K((t)+3,sl_cur);} if(GV){DMA_V((t)+1,sl_next);} \
    CMASK(C0,C1,t); \
    { float a=MX3(C0[0],C0[1],C1[0]),b=MX3(C0[2],C0[3],C1[1]); a=MX3(a,C1[2],C1[3]); \
      _Pragma("unroll") for(int r=4;r<16;r+=4){a=MX3(a,C0[r],C0[r+1]);b=MX3(b,C0[r+2],C0[r+3]);a=MX3(a,C1[r],C1[r+1]);b=MX3(b,C1[r+2],C1[r+3]);} \
      float rm=__builtin_fmaxf(a,b); { auto rr=__builtin_amdgcn_permlane32_swap(__float_as_uint(rm),__float_as_uint(rm),false,false); rm=__builtin_fmaxf(__uint_as_float(rr[0]),__uint_as_float(rr[1])); } \
      resc=false; \
      if(__builtin_expect(__any(rm>(float)THRL),0)){ const float dl=__builtin_fmaxf(rm,0.f); mhat+=dl; \
        _Pragma("unroll") for(int r=0;r<16;++r){C0[r]-=dl;C1[r]-=dl;} \
        _Pragma("unroll") for(int r=0;r<16;++r)negm[r]=-mhat; asm volatile("":"+v"(negm)); \
        const float f=__builtin_amdgcn_exp2f(-dl); l_reg*=f; if(hi==0)wsf[r32]=f; resc=true; } } \
    SBAR(); \
    GAPB(o[0]=__builtin_amdgcn_mfma_f32_32x32x16_bf16(PAF(0),VFR(0),o[0],0,0,0), C0,0); \
    GAPB(o[1]=__builtin_amdgcn_mfma_f32_32x32x16_bf16(PAF(0),VFR(4),o[1],0,0,0), C0,4); \
    KRD(GL,0); GAPB(o[0]=__builtin_amdgcn_mfma_f32_32x32x16_bf16(PAF(1),VFR(1),o[0],0,0,0), C0,8); \
    KRD(GL,1); GAPB(o[1]=__builtin_amdgcn_mfma_f32_32x32x16_bf16(PAF(1),VFR(5),o[1],0,0,0), C0,12); \
    KRD(GL,2); GAPB(o[0]=__builtin_amdgcn_mfma_f32_32x32x16_bf16(PAF(2),VFR(2),o[0],0,0,0), C1,0); \
    KRD(GL,3); GAPB(o[1]=__builtin_amdgcn_mfma_f32_32x32x16_bf16(PAF(2),VFR(6),o[1],0,0,0), C1,4); \
    GAPB(o[0]=__builtin_amdgcn_mfma_f32_32x32x16_bf16(PAF(3),VFR(3),o[0],0,0,0), C1,8); \
    GAPB(o[1]=__builtin_amdgcn_mfma_f32_32x32x16_bf16(PAF(3),VFR(7),o[1],0,0,0), C1,12); \
    }while(0)
  int t=1;
  #undef CMASK
  #define CMASK(P0,P1,t) do{}while(0)
  for(;t+5<NT;t+=2){
    STEP(pB0,pB1,pA0,pA1,t,true,true,true);     WAIT_BAR(2); RESC(); ROT();
    STEP(pA0,pA1,pB0,pB1,t+1,true,true,true);   WAIT_BAR(2); RESC(); ROT();
  }
  #undef CMASK
  #define CMASK(P0,P1,t) do{}while(0)
  #define ENDW(tt) do{ if((tt)+3<NT){WAIT_BAR(2);} else if((tt)+2<NT){WAIT_BAR(1);} else {WAIT_BAR(0);} }while(0)
  for(;t+1<NT;t+=2){
    STEP(pB0,pB1,pA0,pA1,t,(t+3<NT),(t+1<NT),(t+1<NT));       ENDW(t);   RESC(); ROT();
    STEP(pA0,pA1,pB0,pB1,t+1,(t+4<NT),(t+2<NT),(t+2<NT));     ENDW(t+1); RESC(); ROT();
  }
  STEP(pB0,pB1,pA0,pA1,NT-1,false,false,false); RESC();
  { float sacc=pB0[0]+pB0[1]; _Pragma("unroll") for(int r=2;r<16;++r)sacc+=pB0[r]; _Pragma("unroll") for(int r=0;r<16;++r)sacc+=pB1[r]; l_reg+=sacc;
    pw0=(u32x4){PKW(pB0,0),PKW(pB0,2),PKW(pB0,4),PKW(pB0,6)};pw1=(u32x4){PKW(pB0,8),PKW(pB0,10),PKW(pB0,12),PKW(pB0,14)};pw2=(u32x4){PKW(pB1,0),PKW(pB1,2),PKW(pB1,4),PKW(pB1,6)};pw3=(u32x4){PKW(pB1,8),PKW(pB1,10),PKW(pB1,12),PKW(pB1,14)};
    SBAR(); pv(o,vb0+sl_cur,PAF(0),PAF(1),PAF(2),PAF(3)); }
  #undef PKW
  #undef PAF
  #undef VFR
  #undef PIN
  #undef MX3
  #undef GAPA
  #undef GAPB
  #undef EX
  #undef VRD
  #undef KRD
  #undef STEP
  #undef ENDW
  {auto rr=__builtin_amdgcn_permlane32_swap(__float_as_uint(l_reg),__float_as_uint(l_reg),false,false);l_reg=__uint_as_float(rr[0])+__uint_as_float(rr[1]);}
  if(hi==0)wsf[32+r32]=l_reg;asm volatile("s_waitcnt lgkmcnt(0)":::"memory");
  float rli[16];
  #pragma unroll
  for(int r=0;r<16;++r)rli[r]=__builtin_amdgcn_rcpf(wsf[32+crow(r,hi)]);
  bf16*Ow=O+(rowbase+q0+wid*QBLK)*PO+OCOL+h*D;
  { bf16*stg=(bf16*)(shm+LDS_OST)+wid*2048;
    #pragma unroll
    for(int r=0;r<16;++r){const int orow=crow(r,hi);
      #pragma unroll
      for(int d0=0;d0<2;++d0)stg[orow*64+d0*32+r32]=__float2bfloat16(o[d0][r]*rli[r]);}
    asm volatile("s_waitcnt lgkmcnt(0)":::"memory");
    #pragma unroll
    for(int i=0;i<4;++i){const int row=i*8+(lane>>3),ch=lane&7; const u32x4 v=*(const u32x4*)(stg+row*64+ch*8); ATTN_STORE16(Ow+(long)row*PO+ch*8,v);} }
  asm volatile("s_waitcnt lgkmcnt(0)\n\ts_barrier":::"memory");
  #undef DMA_K
  #undef DMA_V
  #undef CMASK
  #undef START
  #undef RESC
  #undef ROT
}
constexpr int ATTN_LDS_BYTES=LDS_BYTES;
struct AttnTensors { const bf16* Q; const bf16* K; const bf16* V; bf16* O; };
struct AttnUnit { int bh; int qb; };
struct StaticOrder {
  int x, j;
  __device__ __forceinline__ explicit StaticOrder(int grid,int block):x(block%8),j(block/8){}
  __device__ __forceinline__ bool next(int i,AttnUnit&u)const{ if(i>=2||j>=32)return false; const int uu=2*j+i; u.bh=(x>>1)*NHEAD+(x&1)*4+(uu>>4); u.qb=uu&15; return true; }
  __device__ __forceinline__ void a_ready(const AttnUnit&)const{}
  __device__ __forceinline__ void done(const AttnUnit&)const{}
};
template<class Sched,int THRL=8> __device__ __forceinline__ void attn_phase(char*lds,const AttnTensors&T,const Sched&S){
  AttnUnit u;
  for(int i=0;S.next(i,u);++i){ S.a_ready(u); attn_unit<THRL>(u.bh/NHEAD,u.bh%NHEAD,u.qb,T.Q,T.K,T.V,T.O,lds); S.done(u); }
}
#undef SBAR
#undef WAIT_BAR
}
namespace memattn {
using bf16 = __hip_bfloat16;
constexpr int   D = 128, NW = 8, QBLK = 32, KVBLK = 64;
constexpr float SCALE = 0.088388347648318440f;
constexpr float THR = 0.f;
constexpr int SDEPTH = 2;
constexpr int LDQ = 512, LDK = 512, LDO = 512;
constexpr size_t SHM_V = KVBLK * D * 2, SHM_K = KVBLK * D * 2, SHM_ATTN = 2 * SHM_V + 2 * SHM_K + NW * 64 * 4;
using bf16x8 = __attribute__((ext_vector_type(8))) short;
using s16x4  = __attribute__((ext_vector_type(4))) short;
using f32x16 = __attribute__((ext_vector_type(16))) float;
using f32x8  = __attribute__((ext_vector_type(8))) float;
using u32x4  = __attribute__((ext_vector_type(4))) unsigned;
#define KSWZ(row, colB) ((row) * 256 + ((colB) ^ (((row) & 7) << 4)))
#define SBAR() __builtin_amdgcn_sched_barrier(0)
__device__ __forceinline__ int crow(int r, int hi) { return (r & 3) + 8 * (r >> 2) + 4 * hi; }
__device__ __forceinline__ unsigned cvtpk(float lo, float hi) {
  unsigned r; asm volatile("v_cvt_pk_bf16_f32 %0, %1, %2" : "=v"(r) : "v"(lo), "v"(hi)); return r;
}
template <typename TIn> struct Stage;
template <> struct Stage<bf16>  { using T = bf16x8;
  __device__ static __forceinline__ T ld8(const bf16* p) { return *reinterpret_cast<const bf16x8*>(p); }
  __device__ static __forceinline__ bf16x8 tobf(T x) { return x; } };
template <> struct Stage<float> { using T = f32x8;
  __device__ static __forceinline__ T ld8(const float* p) { return *reinterpret_cast<const f32x8*>(p); }
  __device__ static __forceinline__ bf16x8 tobf(T x) {
    u32x4 w = {cvtpk(x[0], x[1]), cvtpk(x[2], x[3]), cvtpk(x[4], x[5]), cvtpk(x[6], x[7])}; return *reinterpret_cast<bf16x8*>(&w); } };

__device__ __forceinline__ void partialSM(f32x16& p0, f32x16& p1, float& m_reg, float& mn, float& alpha) {
  constexpr float C = SCALE * 1.4426950408889634f;
  float pmax = p0[0]; for (int r = 1; r < 16; ++r) pmax = fmaxf(pmax, p0[r]); for (int r = 0; r < 16; ++r) pmax = fmaxf(pmax, p1[r]);
  { auto rr = __builtin_amdgcn_permlane32_swap(__float_as_uint(pmax), __float_as_uint(pmax), false, false);
    pmax = fmaxf(__uint_as_float(rr[0]), __uint_as_float(rr[1])); }
  if (__builtin_expect(__all(pmax - m_reg <= THR / SCALE), 1)) { mn = m_reg; alpha = 1.f; }
  else { mn = fmaxf(m_reg, pmax); alpha = __builtin_amdgcn_exp2f((m_reg - mn) * C); m_reg = mn; }
  float mnC = -mn * C;
  for (int r = 0; r < 16; ++r) p0[r] = fmaf(p0[r], C, mnC); for (int r = 0; r < 16; ++r) p1[r] = fmaf(p1[r], C, mnC);
  for (int r = 0; r < 16; ++r) p0[r] = __builtin_amdgcn_exp2f(p0[r]);
}
__device__ __forceinline__ void finishSM(f32x16& p0, f32x16& p1, float alpha, float& l_reg, bf16x8& pa0, bf16x8& pa1, bf16x8& pa2, bf16x8& pa3) {
  for (int r = 0; r < 16; ++r) p1[r] = __builtin_amdgcn_exp2f(p1[r]);
  float ps = 0; for (int r = 0; r < 16; ++r) ps += p0[r]; for (int r = 0; r < 16; ++r) ps += p1[r];
  { auto rr = __builtin_amdgcn_permlane32_swap(__float_as_uint(ps), __float_as_uint(ps), false, false);
    ps = __uint_as_float(rr[0]) + __uint_as_float(rr[1]); }
  l_reg = l_reg * alpha + ps;
#define PK4(P, BASE, OUT) do { unsigned a0 = cvtpk(P[BASE + 0], P[BASE + 1]), a1 = cvtpk(P[BASE + 2], P[BASE + 3]);   \
    unsigned b0 = cvtpk(P[BASE + 4], P[BASE + 5]), b1 = cvtpk(P[BASE + 6], P[BASE + 7]);                              \
    auto r0 = __builtin_amdgcn_permlane32_swap(a0, b0, false, false); auto r1 = __builtin_amdgcn_permlane32_swap(a1, b1, false, false); \
    u32x4 w = {r0[0], r1[0], r0[1], r1[1]}; OUT = *reinterpret_cast<bf16x8*>(&w); } while (0)
  PK4(p0, 0, pa0); PK4(p0, 8, pa1); PK4(p1, 0, pa2); PK4(p1, 8, pa3);
#undef PK4
}
__device__ __forceinline__ void qkt(f32x16& p0, f32x16& p1, const bf16* Ks, const bf16x8* qr, int r32, int hi) {
  p0 = f32x16{}; p1 = f32x16{};
  for (int d0 = 0; d0 < 8; ++d0) { int cb = (d0 * 16 + hi * 8) * 2;
    bf16x8 b0 = *reinterpret_cast<const bf16x8*>((const char*)Ks + KSWZ(r32, cb));
    bf16x8 b1 = *reinterpret_cast<const bf16x8*>((const char*)Ks + KSWZ(32 + r32, cb));
    p0 = __builtin_amdgcn_mfma_f32_32x32x16_bf16(b0, qr[d0], p0, 0, 0, 0);
    p1 = __builtin_amdgcn_mfma_f32_32x32x16_bf16(b1, qr[d0], p1, 0, 0, 0); }
}
__device__ __forceinline__ int v_st(int k, int c) { const int kk = (k & ~0xC) | ((k & 4) << 1) | ((k & 8) >> 1); return ((kk >> 3) * 4 + (c >> 5)) * 512 + ((kk & 7) * 32 + (c & 31)) * 2; }
__device__ __forceinline__ int v_rd_base(int lane) { return ((lane & 3) << 3) | (((lane >> 2) & 3) << 6) | (((lane >> 4) & 1) << 5) | (((lane >> 5) & 1) << 8); }
constexpr int v_rd_off(int d0, int ks, int half) { return d0 * 512 + ks * 4096 + half * 2048; }
template <int OFF> __device__ __forceinline__ s16x4 tr_read(int vb) {
  s16x4 r; asm volatile("ds_read_b64_tr_b16 %0, %1 offset:%2" : "=&v"(r) : "v"(vb), "i"(OFF) : "memory"); return r;
}
template <int D0> __device__ __forceinline__ void pv_one(f32x16& od, int vb, bf16x8 pa0, bf16x8 pa1, bf16x8 pa2, bf16x8 pa3) {
  const s16x4 l0 = tr_read<v_rd_off(D0, 0, 0)>(vb), h0 = tr_read<v_rd_off(D0, 0, 1)>(vb), l1 = tr_read<v_rd_off(D0, 1, 0)>(vb), h1 = tr_read<v_rd_off(D0, 1, 1)>(vb);
  const s16x4 l2 = tr_read<v_rd_off(D0, 2, 0)>(vb), h2 = tr_read<v_rd_off(D0, 2, 1)>(vb), l3 = tr_read<v_rd_off(D0, 3, 0)>(vb), h3 = tr_read<v_rd_off(D0, 3, 1)>(vb);
  asm volatile("s_waitcnt lgkmcnt(0)" ::: "memory"); SBAR();
#define PK(L, H) (bf16x8){L[0], L[1], L[2], L[3], H[0], H[1], H[2], H[3]}
  od = __builtin_amdgcn_mfma_f32_32x32x16_bf16(pa0, PK(l0, h0), od, 0, 0, 0);
  od = __builtin_amdgcn_mfma_f32_32x32x16_bf16(pa1, PK(l1, h1), od, 0, 0, 0);
  od = __builtin_amdgcn_mfma_f32_32x32x16_bf16(pa2, PK(l2, h2), od, 0, 0, 0);
  od = __builtin_amdgcn_mfma_f32_32x32x16_bf16(pa3, PK(l3, h3), od, 0, 0, 0);
#undef PK
}
__device__ __forceinline__ void pv_d0(f32x16* o, int vb, bf16x8 pa0, bf16x8 pa1, bf16x8 pa2, bf16x8 pa3) {
  pv_one<0>(o[0], vb, pa0, pa1, pa2, pa3); pv_one<1>(o[1], vb, pa0, pa1, pa2, pa3); pv_one<2>(o[2], vb, pa0, pa1, pa2, pa3); pv_one<3>(o[3], vb, pa0, pa1, pa2, pa3);
}

template <typename TQ>
__device__ __forceinline__ void attn_dense_body(const TQ* __restrict__ Qb, const bf16* __restrict__ Kh, const bf16* __restrict__ Vh,
                                                bf16* __restrict__ Ob, int seq, char* lds) {
  using St = Stage<bf16>; using SQ = Stage<TQ>;
  int tid_ = threadIdx.x; asm volatile("" : "+v"(tid_));
  const int tid = tid_, wid = tid >> 6, lane = tid & 63, r32 = lane & 31, hi = lane >> 5;
  bf16* V_lds = (bf16*)lds; bf16* K_lds = (bf16*)(lds + 2 * SHM_V);
  float* ws = (float*)(lds + 2 * SHM_V + 2 * SHM_K) + wid * 64; float* li_l = ws; float* al_l = ws + 32;
  float m_reg = -1e30f, l_reg = 0; f32x16 o[4] = {}; bf16x8 qr[8];
  const TQ* Qw = Qb + (long)(wid * QBLK + r32) * LDQ + hi * 8;
#pragma unroll
  for (int d0 = 0; d0 < 8; ++d0) qr[d0] = SQ::tobf(SQ::ld8(Qw + d0 * 16));
  const int sr = tid >> 4, sc = (tid & 15) * 8, vst0 = v_st(sr, sc), vst1 = v_st(32 + sr, sc);
  const int vb0 = (int)(uintptr_t)V_lds + v_rd_base(lane);
  struct { typename St::T vs0, vs1, ks0, ks1; } sr_[SDEPTH];
#define SLOAD(i, k0) do { sr_[i].vs0 = St::ld8(&Vh[(long)((k0) + sr) * LDK + sc]); sr_[i].vs1 = St::ld8(&Vh[(long)((k0) + 32 + sr) * LDK + sc]); \
    sr_[i].ks0 = St::ld8(&Kh[(long)((k0) + sr) * LDK + sc]); sr_[i].ks1 = St::ld8(&Kh[(long)((k0) + 32 + sr) * LDK + sc]); } while (0)
#define SWRITE(b, i) do { *(bf16x8*)((char*)V_lds + (b) * SHM_V + vst0) = St::tobf(sr_[i].vs0);          \
    *(bf16x8*)((char*)V_lds + (b) * SHM_V + vst1) = St::tobf(sr_[i].vs1); int kc = sc * 2;               \
    *(bf16x8*)((char*)K_lds + (b) * SHM_K + KSWZ(sr, kc)) = St::tobf(sr_[i].ks0);                       \
    *(bf16x8*)((char*)K_lds + (b) * SHM_K + KSWZ(32 + sr, kc)) = St::tobf(sr_[i].ks1); } while (0)
#define SWAIT() do { if constexpr (SDEPTH == 2) asm volatile("s_waitcnt vmcnt(4)" ::: "memory"); else asm volatile("s_waitcnt vmcnt(0)" ::: "memory"); } while (0)
#define RESC(a) do { if (__any((a) < 1.f)) { if (hi == 0) al_l[r32] = (a); asm volatile("s_waitcnt lgkmcnt(0)" ::: "memory"); \
    for (int d = 0; d < 4; ++d) for (int r = 0; r < 16; ++r) o[d][r] *= al_l[crow(r, hi)]; } } while (0)
  f32x16 pA0, pA1, pB0, pB1; float mnA, mnB, alA, alB; bf16x8 pa0, pa1, pa2, pa3; const int NT = seq / KVBLK;
  constexpr int SE = 0, SO = SDEPTH - 1;
  SLOAD(SE, 0); asm volatile("s_waitcnt vmcnt(0)" ::: "memory"); SWRITE(0, SE); __syncthreads();
  qkt(pA0, pA1, K_lds, qr, r32, hi); partialSM(pA0, pA1, m_reg, mnA, alA);
  SLOAD(SO, KVBLK); if constexpr (SDEPTH == 2) { if (2 < NT) SLOAD(SE, 2 * KVBLK); }
  SWAIT(); SWRITE(1, SO); __syncthreads();
  for (int j = 1; j + 1 < NT; j += 2) {
    SBAR(); qkt(pB0, pB1, (bf16*)((char*)K_lds + SHM_K), qr, r32, hi);
    finishSM(pA0, pA1, alA, l_reg, pa0, pa1, pa2, pa3); SBAR();
    SLOAD(SO, (j + SDEPTH) * KVBLK); SBAR();
    pv_d0(o, vb0, pa0, pa1, pa2, pa3); partialSM(pB0, pB1, m_reg, mnB, alB);
    __syncthreads(); SWAIT(); SWRITE(0, SE);
    RESC(alB); __syncthreads();
    SBAR(); qkt(pA0, pA1, K_lds, qr, r32, hi);
    finishSM(pB0, pB1, alB, l_reg, pa0, pa1, pa2, pa3); SBAR();
    if (SDEPTH == 1 || j + 3 < NT) SLOAD(SE, (j + 1 + SDEPTH) * KVBLK); SBAR();
    pv_d0(o, vb0 + (int)SHM_V, pa0, pa1, pa2, pa3); partialSM(pA0, pA1, m_reg, mnA, alA);
    __syncthreads(); SWAIT(); SWRITE(1, SO);
    RESC(alA); __syncthreads();
  }
  SBAR(); qkt(pB0, pB1, (bf16*)((char*)K_lds + SHM_K), qr, r32, hi);
  finishSM(pA0, pA1, alA, l_reg, pa0, pa1, pa2, pa3); SBAR();
  pv_d0(o, vb0, pa0, pa1, pa2, pa3); partialSM(pB0, pB1, m_reg, mnB, alB);
  __syncthreads(); RESC(alB);
  finishSM(pB0, pB1, alB, l_reg, pa0, pa1, pa2, pa3); SBAR();
  pv_d0(o, vb0 + (int)SHM_V, pa0, pa1, pa2, pa3);
  if (hi == 0) li_l[r32] = l_reg; asm volatile("s_waitcnt lgkmcnt(0)" ::: "memory");
  float rli[16];
#pragma unroll
  for (int r = 0; r < 16; ++r) rli[r] = __builtin_amdgcn_rcpf(li_l[crow(r, hi)]);
  bf16* Ow = Ob + (long)(wid * QBLK) * LDO;
#pragma unroll
  for (int r = 0; r < 16; ++r) { int orow = crow(r, hi);
    for (int d0 = 0; d0 < 4; ++d0) Ow[(long)orow * LDO + d0 * 32 + r32] = __float2bfloat16(o[d0][r] * rli[r]); }
#undef SLOAD
#undef SWRITE
#undef SWAIT
#undef RESC
}

#undef KSWZ
#undef SBAR
}
namespace na_body {
typedef short bf16x8 __attribute__((ext_vector_type(8)));
typedef short s16x4 __attribute__((ext_vector_type(4)));
typedef float f32x4 __attribute__((ext_vector_type(4)));
typedef unsigned u32x2 __attribute__((ext_vector_type(2)));
typedef unsigned short bf16;
#define NA_LAS __attribute__((address_space(3)))
constexpr int SLOT = 8192, NSLOT = 9, LDS_K = 0, LDS_V = NSLOT * SLOT, LDS_TBL = 2 * NSLOT * SLOT, NA_LDS_BYTES = LDS_TBL + 4096;
__device__ __forceinline__ s16x4 vtr(const NA_LAS unsigned char* p) { typedef short v4i16_t __attribute__((ext_vector_type(4)));
  return __builtin_bit_cast(s16x4, __builtin_amdgcn_ds_read_tr16_b64_v4i16((NA_LAS v4i16_t*)p)); }
__device__ __forceinline__ void na_unit(int b, int h, int r0, const bf16* NQ, const bf16* NK, const bf16* NV, bf16* OC, const float* rpb_h, NA_LAS unsigned char* L) {
  int tid_ = threadIdx.x; asm volatile("" : "+v"(tid_));
  const int tid = tid_, lane = tid & 63; const int wid = __builtin_amdgcn_readfirstlane(tid >> 6);
  const int kr0 = min(max(r0 - 4, 0), 56), rs1 = min(max(r0 - 3, 0), 56), nrows = rs1 + 8 - kr0;
  asm volatile("s_waitcnt lgkmcnt(0)\n\ts_barrier" ::: "memory");
  const unsigned lds0 = (unsigned)(uintptr_t)L;
  {
    const size_t tok0 = (size_t)b * 4096 + kr0 * 64;
    const bf16* ksrc = NK + (tok0 + lane) * 512 + h * 64 + wid * 8;
    const bf16* vsrc = NV + (tok0 + 16 * (wid & 3) + (lane >> 2)) * 512 + h * 64 + (wid >> 2) * 32 + (lane & 3) * 8;
    for (int s = 0; s < nrows; ++s) {
      attn_body::glds16(ksrc + (size_t)s * 64 * 512, (unsigned)__builtin_amdgcn_readfirstlane(lds0 + LDS_K + s * SLOT + wid * 1024));
      attn_body::glds16(vsrc + (size_t)s * 64 * 512, (unsigned)__builtin_amdgcn_readfirstlane(lds0 + LDS_V + s * SLOT + wid * 1024));
    }
  }
  NA_LAS float* tbl = (NA_LAS float*)(L + LDS_TBL);
  for (int i = tid; i < 960; i += 512) { const int ro = i >> 6, co = (i & 63) - 16; tbl[i] = (co >= 0 && co < 31) ? rpb_h[ro * 31 + co] * 1.4426950408889634f : 0.f; }
  const int qr = wid >> 2, cb = wid & 3, r = r0 + qr, c0 = 16 * cb, kc0 = min(max(c0 - 8, 0), 32);
  const int ql = lane & 15, g = lane >> 4;
  const int rsr = min(max(r - 4, 0), 56), so = rsr - kr0, ro0 = rsr - r + 7;
  const size_t tokq = (size_t)b * 4096 + r * 64 + c0 + ql;
  bf16x8 qf[2];
#pragma unroll
  for (int ks = 0; ks < 2; ++ks) qf[ks] = *(const bf16x8*)(NQ + tokq * 512 + h * 64 + 32 * ks + 8 * g);
  asm volatile("s_waitcnt vmcnt(0) lgkmcnt(0)\n\ts_barrier" ::: "memory");
  const NA_LAS unsigned char* kb = L + LDS_K + so * SLOT + g * 1024 + (kc0 + ql) * 16;
  f32x4 s[8][2];
#pragma unroll
  for (int i = 0; i < 8; ++i)
#pragma unroll
    for (int sb = 0; sb < 2; ++sb) { f32x4 a = {0.f, 0.f, 0.f, 0.f};
#pragma unroll
      for (int ks = 0; ks < 2; ++ks) { const bf16x8 kf = *(const NA_LAS bf16x8*)(kb + i * SLOT + ks * 4096 + sb * 256); a = __builtin_amdgcn_mfma_f32_16x16x32_bf16(kf, qf[ks], a, 0, 0, 0); }
      s[i][sb] = a; }
  const int c = c0 + ql, cs = min(max(c - 8, 0), 48), e0 = kc0 + 4 * g - cs;
  const NA_LAS float* tb = tbl + ro0 * 64 + (kc0 - c0 + 4 * g - ql + 31);
  float m = -1e30f;
#pragma unroll
  for (int i = 0; i < 8; ++i)
#pragma unroll
    for (int sb = 0; sb < 2; ++sb)
#pragma unroll
      for (int j = 0; j < 4; ++j) { const int e = e0 + 16 * sb + j; float v = s[i][sb][j] + tb[i * 64 + sb * 16 + j]; v = ((unsigned)e < 16u) ? v : -1e30f; s[i][sb][j] = v; m = fmaxf(m, v); }
  m = fmaxf(m, __shfl_xor(m, 16)); m = fmaxf(m, __shfl_xor(m, 32));
  float l = 0.f;
#pragma unroll
  for (int i = 0; i < 8; ++i)
#pragma unroll
    for (int sb = 0; sb < 2; ++sb)
#pragma unroll
      for (int j = 0; j < 4; ++j) { const float p = __builtin_amdgcn_exp2f(s[i][sb][j] - m); s[i][sb][j] = p; l += p; }
  l += __shfl_xor(l, 16); l += __shfl_xor(l, 32);
  const NA_LAS unsigned char* vb = L + LDS_V + so * SLOT + (kc0 + 4 * g + ((lane & 15) >> 2)) * 64 + (lane & 3) * 8;
  f32x4 o[4];
#pragma unroll
  for (int d = 0; d < 4; ++d) o[d] = (f32x4){0.f, 0.f, 0.f, 0.f};
#pragma unroll
  for (int i = 0; i < 8; ++i) {
    typedef unsigned u32x4_t __attribute__((ext_vector_type(4)));
    u32x4_t pw; pw.x = pg8::cvt_pk_bf16(s[i][0][0], s[i][0][1]); pw.y = pg8::cvt_pk_bf16(s[i][0][2], s[i][0][3]); pw.z = pg8::cvt_pk_bf16(s[i][1][0], s[i][1][1]); pw.w = pg8::cvt_pk_bf16(s[i][1][2], s[i][1][3]);
    const bf16x8 pf = __builtin_bit_cast(bf16x8, pw);
#pragma unroll
    for (int d = 0; d < 4; ++d) { const NA_LAS unsigned char* p = vb + i * SLOT + (d >> 1) * 4096 + (d & 1) * 32;
      const s16x4 lo = vtr(p), hi = vtr(p + 16 * 64);
      const bf16x8 vf = (bf16x8){lo[0], lo[1], lo[2], lo[3], hi[0], hi[1], hi[2], hi[3]};
      o[d] = __builtin_amdgcn_mfma_f32_16x16x32_bf16(vf, pf, o[d], 0, 0, 0); }
  }
  const float rl = 1.0f / l;
  bf16* op = OC + tokq * 1024 + h * 64 + 4 * g;
#pragma unroll
  for (int d = 0; d < 4; ++d) { u32x2 w; w.x = pg8::cvt_pk_bf16(o[d][0] * rl, o[d][1] * rl); w.y = pg8::cvt_pk_bf16(o[d][2] * rl, o[d][3] * rl); *(u32x2*)(op + 16 * d) = w; }
}
}
#define GAS __attribute__((address_space(1)))
#define LAS __attribute__((address_space(3)))
typedef unsigned short bf16;
typedef unsigned v4u __attribute__((ext_vector_type(4)));
typedef float f32x4 __attribute__((ext_vector_type(4)));
typedef short bf16x8 __attribute__((ext_vector_type(8)));
typedef GAS unsigned gu32;
typedef GAS unsigned long long gu64;
#define RLX_AGENT __ATOMIC_RELAXED, __HIP_MEMORY_SCOPE_AGENT
#define LDS_WAIT() asm volatile("s_waitcnt lgkmcnt(0)" ::: "memory")
#define VM_WAIT() asm volatile("s_waitcnt vmcnt(0)" ::: "memory")
__device__ __forceinline__ unsigned long long rt() { return __builtin_amdgcn_s_memrealtime(); }
__device__ __forceinline__ unsigned f2bf(float f) { unsigned u = __builtin_bit_cast(unsigned, f); return (u + 0x7fffu + ((u >> 16) & 1u)) >> 16; }
__device__ __forceinline__ unsigned pk2(float lo, float hi) { return f2bf(lo) | (f2bf(hi) << 16); }

#define XB_TMO      128
#define XB_XCNT(j)  (256  + 64 * (j))
#define XB_XSUB(j)  (1280 + 64 * (j))
#define XB_XGEN(j)  (2304 + 64 * (j))
#define XB_TOP      3328
#define XB_TOPGEN   3392
#define XCD_BAR_WORDS 3456
#define XB_SPIN_CAP (1u << 18)

__device__ __forceinline__ unsigned xb_ld(unsigned* p)              { return __hip_atomic_load(p, __ATOMIC_RELAXED, __HIP_MEMORY_SCOPE_AGENT); }
__device__ __forceinline__ unsigned xb_add(unsigned* p, unsigned v) { return __hip_atomic_fetch_add(p, v, __ATOMIC_RELAXED, __HIP_MEMORY_SCOPE_AGENT); }
__device__ __forceinline__ unsigned xb_xcc_id() { return (unsigned)__builtin_amdgcn_s_getreg((3 << 11) | 20) & 0xFu; }
#define XB_SPIN(cond, bar) do { unsigned _sp = 0; while (cond) { __builtin_amdgcn_s_sleep(1); \
    if ((++_sp & 255u) == 0u) { if (xb_ld(&(bar)[XB_TMO])) break; if (_sp > XB_SPIN_CAP) { atomicAdd(&(bar)[XB_TMO], 1u); break; } } } } while (0)

struct XcdBarrier {
    unsigned* bar; unsigned x;
    volatile LAS unsigned* st;
};

__device__ __forceinline__ XcdBarrier xcd_barrier_post(unsigned* bar, volatile LAS unsigned* st) {
    XcdBarrier b; b.bar = bar; b.x = xb_xcc_id(); b.st = st;
    if (threadIdx.x == 0) (void)xb_add(&bar[XB_XCNT(b.x)], 1u);
    return b;
}
__device__ __forceinline__ void xcd_barrier_complete(unsigned* bar, unsigned x, unsigned& nloc, unsigned& nx) {
    const unsigned G = gridDim.x * gridDim.y * gridDim.z;
    unsigned sum, cnt, mine, sp = 0u;
    for (;;) {
        sum = 0u; cnt = 0u; mine = 0u;
#pragma unroll
        for (unsigned j = 0; j < 16; ++j) { const unsigned c = xb_ld(&bar[XB_XCNT(j)]); sum += c; cnt += (c > 0u) ? 1u : 0u; mine = (j == x) ? c : mine; }
        if (sum == G) break;
        __builtin_amdgcn_s_sleep(1);
        if ((++sp & 255u) == 0u) { if (xb_ld(&bar[XB_TMO])) break; if (sp > XB_SPIN_CAP) { atomicAdd(&bar[XB_TMO], 1u); break; } }
    }
    nloc = mine > 0u ? mine : 1u; nx = cnt > 0u ? cnt : 1u;
}

__device__ __forceinline__ void xcd_barrier(const XcdBarrier& b) {
    asm volatile("s_waitcnt vmcnt(0)" ::: "memory");
    __syncthreads();
    if (threadIdx.x == 0) {
        unsigned* bar = b.bar;
        __builtin_amdgcn_s_waitcnt(0);
        unsigned nloc = b.st[0], nx = b.st[1];
        if (nloc == 0u) { xcd_barrier_complete(bar, b.x, nloc, nx); b.st[0] = nloc; b.st[1] = nx; }
        const unsigned old = xb_add(&bar[XB_XSUB(b.x)], 1u);
        const unsigned gen = old / nloc;
        if (old + 1u == (gen + 1u) * nloc) {
            __builtin_amdgcn_fence(__ATOMIC_RELEASE, "agent");
            asm volatile("s_waitcnt vmcnt(0)" ::: "memory");
            const unsigned og = xb_add(&bar[XB_TOP], 1u);
            const unsigned tg = og / nx;
            if (og + 1u == (tg + 1u) * nx) xb_add(&bar[XB_TOPGEN], 1u);
            else XB_SPIN(xb_ld(&bar[XB_TOPGEN]) == tg, bar);
            __builtin_amdgcn_fence(__ATOMIC_ACQUIRE, "agent");
            xb_add(&bar[XB_XGEN(b.x)], 1u);
            asm volatile("s_waitcnt vmcnt(0)" ::: "memory");
        } else {
            XB_SPIN(xb_ld(&bar[XB_XGEN(b.x)]) == gen, bar);
            __builtin_amdgcn_fence(__ATOMIC_ACQUIRE, "agent");
            asm volatile("s_waitcnt vmcnt(0)" ::: "memory");
        }
    }
    __syncthreads();
}
#ifndef NAIVE_GQA
#define NAIVE_GQA 0
#endif
#ifndef NAIVE_NA
#define NAIVE_NA 0
#endif
#ifndef NAIVE_MEM
#define NAIVE_MEM 0
#endif
#ifndef PG8_SP2
#define PG8_SP2 true
#endif
#ifndef PG8_ALIGN
#define PG8_ALIGN true
#endif

constexpr int NB = 4, SEQ = 4096, D = 1024, T = NB * SEQ;
constexpr int GW = 64;
constexpr int NINW = 2304, NAW = 512, GQW = 512, KVW = 128;
constexpr int MEML = 256, MEMT = NB * MEML, MEMW = 512;
constexpr int DFF = 2816, DFF2 = 5632;
constexpr float LOG2E = 1.4426950408889634f;
constexpr float QS_NA = 0.125f * LOG2E;
constexpr float QS_G = 0.125f * LOG2E;
constexpr float QS_M = 0.08838834764831845f * LOG2E;
constexpr int NTHREADS = 512, NWAVES = 8;

constexpr size_t MiB = 1u << 20;
constexpr size_t WS_CTL = 0, CTL_ZERO_BYTES = 1 * MiB;
constexpr size_t WS_ROPE = 1 * MiB, WS_SS = 2 * MiB, WS_MSS = 3 * MiB;
constexpr size_t WS_WIN = 4 * MiB, WS_WOUT = 13 * MiB, WS_WMQ = 17 * MiB, WS_WMKV = 19 * MiB, WS_WMO = 23 * MiB, WS_WUP = 25 * MiB, WS_WDN = 47 * MiB;
constexpr size_t WS_XB = 58 * MiB, WS_MXB = 90 * MiB, WS_MKV = 92 * MiB;
constexpr size_t WS_R = 96 * MiB;
constexpr size_t WS_NQ = WS_R, WS_NK = WS_R + 16 * MiB, WS_NV = WS_R + 32 * MiB, WS_GQ = WS_R + 48 * MiB, WS_GK = WS_R + 64 * MiB, WS_GV = WS_R + 68 * MiB, WS_OC = WS_R + 72 * MiB;
constexpr size_t WS_QM = WS_R, WS_OM = WS_R + 16 * MiB;
constexpr size_t WS_EDGE = WS_R, WS_ACT = WS_R + 64 * MiB, WS_END = 256 * MiB;
static_assert(WS_ACT + (size_t)T * DFF * 2 <= WS_END, "ws map");
constexpr int CW_BAR = 4096;

constexpr int RING_OFF = 0, RING_BYTES = 131072;
constexpr int LDSCTL_OFF = 151552, MISC_OFF = LDSCTL_OFF + 320;
constexpr int LDS_BYTES = 155648;

__device__ __forceinline__ float wave_sum(float v) {
#pragma unroll
    for (int o = 1; o < 64; o <<= 1) v += __shfl_xor(v, o);
    return v;
}
__device__ __forceinline__ float wave_max(float v) {
#pragma unroll
    for (int o = 1; o < 64; o <<= 1) v = fmaxf(v, __shfl_xor(v, o));
    return v;
}
__device__ __forceinline__ float bf_lo(unsigned w) { return __uint_as_float(w << 16); }
__device__ __forceinline__ float bf_hi(unsigned w) { return __uint_as_float(w & 0xffff0000u); }
__device__ __forceinline__ float bf2f(bf16 h) { return __uint_as_float((unsigned)h << 16); }
__device__ __forceinline__ float rdlane(float v, int l) { return __int_as_float(__builtin_amdgcn_readlane(__float_as_int(v), l)); }

__device__ __forceinline__ int rowmap(int kind, int n) {
    if (kind == 1) {
        if (n < 1536) return n;
        int pn, wc;
        if (n < 2048) { const int hh = (n - 1536) >> 6; pn = 6 + (hh >> 2); wc = hh & 3; }
        else if (n < 2176) { pn = 8; wc = (n - 2048) >> 6; }
        else { pn = 8; wc = 2 + ((n - 2176) >> 6); }
        const int d = n & 63, bj = d >> 5, nn = (d >> 4) & 1, fq = (d >> 2) & 3, e = d & 3;
        return 256 * pn + 128 * bj + 32 * wc + 8 * fq + 4 * nn + e;
    }
    if (kind == 2) { if (n < DFF) return 256 * (n >> 7) + (n & 127); const int ch = n - DFF; return 256 * (ch >> 7) + 128 + (ch & 127); }
    return n;
}
__device__ __forceinline__ void p0_transpose_item(const float* W, int K, int N, const float* gain, int kind, bf16* WT, LAS float* scr, int item, int lane) {
    const int nblk = N / 32, kb = item / nblk, nb = item % nblk, k0 = 64 * kb, n0 = 32 * nb;
#pragma unroll 8
    for (int i = 0; i < 32; ++i) { const int kk = 2 * i + (lane >> 5); const float gk = gain ? gain[k0 + kk] : 1.f; scr[kk * 33 + (lane & 31)] = W[(size_t)(k0 + kk) * N + n0 + (lane & 31)] * gk; }
    LDS_WAIT(); asm volatile("" ::: "memory");
    const int c = lane & 7;
#pragma unroll
    for (int j = 0; j < 4; ++j) { const int n = (lane >> 3) + 8 * j; const LAS float* s = scr + (8 * c) * 33 + n;
        v4u o; o.x = pk2(s[0 * 33], s[1 * 33]); o.y = pk2(s[2 * 33], s[3 * 33]); o.z = pk2(s[4 * 33], s[5 * 33]); o.w = pk2(s[6 * 33], s[7 * 33]);
        *(GAS v4u*)(WT + (size_t)rowmap(kind, n0 + n) * K + k0 + 8 * c) = o; }
    LDS_WAIT(); asm volatile("" ::: "memory");
}
__device__ __forceinline__ void row_to_bf16_ss(const float* xrow, bf16* orow, float* ssrow, int lane) {
    const GAS f32x4* xr = (const GAS f32x4*)xrow + lane;
    f32x4 v[4]; float s = 0.f;
#pragma unroll
    for (int j = 0; j < 4; ++j) { v[j] = xr[64 * j]; s += (v[j].x * v[j].x + v[j].y * v[j].y) + (v[j].z * v[j].z + v[j].w * v[j].w); }
    s = wave_sum(s);
    GAS unsigned long long* o8 = (GAS unsigned long long*)orow + lane;
#pragma unroll
    for (int j = 0; j < 4; ++j) o8[64 * j] = (unsigned long long)pk2(v[j].x, v[j].y) | ((unsigned long long)pk2(v[j].z, v[j].w) << 32);
    if (lane < 16) ssrow[lane] = lane == 0 ? s : 0.f;
}

struct Args { const float* in[19]; float* out; unsigned char* ws; };

__device__ __forceinline__ void na_naive(const bf16* NQ, const bf16* NK, const bf16* NV, bf16* OC, const float* rpb, int gw, int NGW, int lane) {
    for (int task = gw; task < T * 8; task += NGW) {
        const int h = task & 7, t = task >> 3;
        const int b = t >> 12, r = (t >> 6) & 63, c = t & 63;
        const int rs = min(max(r - 4, 0), 56), cs = min(max(c - 8, 0), 48);
        const float q = bf2f(NQ[(size_t)t * 512 + h * 64 + lane]);
        float s[2];
#pragma unroll
        for (int half = 0; half < 2; ++half) {
            const int kk = lane + 64 * half, i = kk >> 4, jj = kk & 15;
            const int tk = (b << 12) + ((rs + i) << 6) + cs + jj;
            const v4u* kp = (const v4u*)(NK + (size_t)tk * 512 + h * 64);
            v4u kv[8];
#pragma unroll
            for (int j = 0; j < 8; ++j) kv[j] = kp[j];
            float a = 0.f;
#pragma unroll
            for (int d = 0; d < 64; d += 2) { const unsigned w = kv[d >> 3][(d >> 1) & 3]; a += rdlane(q, d) * bf_lo(w) + rdlane(q, d + 1) * bf_hi(w); }
            s[half] = a + rpb[(h * 15 + (rs + i - r + 7)) * 31 + (cs + jj - c + 15)] * LOG2E;
        }
        const float m = wave_max(fmaxf(s[0], s[1]));
        const float p0 = exp2f(s[0] - m), p1 = exp2f(s[1] - m);
        const float l = wave_sum(p0 + p1);
        float o = 0.f;
        for (int kk = 0; kk < 64; ++kk) { const int i = kk >> 4, jj = kk & 15; const int tk = (b << 12) + ((rs + i) << 6) + cs + jj;
            o += rdlane(p0, kk) * bf2f(NV[(size_t)tk * 512 + h * 64 + lane]); }
        for (int kk = 0; kk < 64; ++kk) { const int i = 4 + (kk >> 4), jj = kk & 15; const int tk = (b << 12) + ((rs + i) << 6) + cs + jj;
            o += rdlane(p1, kk) * bf2f(NV[(size_t)tk * 512 + h * 64 + lane]); }
        OC[(size_t)t * 1024 + h * 64 + lane] = (bf16)f2bf(o / l);
    }
}
__device__ __forceinline__ void gqa_naive(const bf16* GQ, const bf16* GK, const bf16* GV, bf16* OC, int gw, int NGW, int lane) {
    for (int task = gw; task < T * 8; task += NGW) {
        const int h = task & 7, t = task >> 3, b = t >> 12, kvh = h >> 2;
        const float q = bf2f(GQ[(size_t)t * 512 + h * 64 + lane]);
        float m = -1e30f, l = 0.f, o = 0.f;
        for (int ch = 0; ch < 64; ++ch) {
            const int tk = (b << 12) + ch * 64 + lane;
            const v4u* kp = (const v4u*)(GK + (size_t)tk * 128 + kvh * 64);
            v4u kv[8];
#pragma unroll
            for (int j = 0; j < 8; ++j) kv[j] = kp[j];
            float a = 0.f;
#pragma unroll
            for (int d = 0; d < 64; d += 2) { const unsigned w = kv[d >> 3][(d >> 1) & 3]; a += rdlane(q, d) * bf_lo(w) + rdlane(q, d + 1) * bf_hi(w); }
            const float cm = wave_max(a), mn = fmaxf(m, cm), alpha = exp2f(m - mn), p = exp2f(a - mn);
            l = l * alpha + wave_sum(p); o *= alpha; m = mn;
            const bf16* vp = GV + (size_t)((b << 12) + ch * 64) * 128 + kvh * 64 + lane;
            for (int kk = 0; kk < 64; ++kk) o += rdlane(p, kk) * bf2f(vp[(size_t)kk * 128]);
        }
        OC[(size_t)t * 1024 + 512 + h * 64 + lane] = (bf16)f2bf(o / l);
    }
}
__device__ __forceinline__ void mem_naive(const bf16* QM, const bf16* MK, const bf16* MV, bf16* OM, int gw, int NGW, int lane) {
    for (int task = gw; task < T * 4; task += NGW) {
        const int h = task & 3, t = task >> 2, b = t >> 12;
        const float q0 = bf2f(QM[(size_t)t * 512 + h * 128 + lane]), q1 = bf2f(QM[(size_t)t * 512 + h * 128 + 64 + lane]);
        float s[4];
#pragma unroll
        for (int j = 0; j < 4; ++j) {
            const int row = b * 256 + 64 * j + lane;
            const v4u* kp = (const v4u*)(MK + (size_t)row * 512 + h * 128);
            v4u kv[16];
#pragma unroll
            for (int i = 0; i < 16; ++i) kv[i] = kp[i];
            float a = 0.f;
#pragma unroll
            for (int d = 0; d < 64; d += 2) { const unsigned w = kv[d >> 3][(d >> 1) & 3]; a += rdlane(q0, d) * bf_lo(w) + rdlane(q0, d + 1) * bf_hi(w); }
#pragma unroll
            for (int d = 0; d < 64; d += 2) { const unsigned w = kv[8 + (d >> 3)][(d >> 1) & 3]; a += rdlane(q1, d) * bf_lo(w) + rdlane(q1, d + 1) * bf_hi(w); }
            s[j] = a * QS_M;
        }
        const float m = wave_max(fmaxf(fmaxf(s[0], s[1]), fmaxf(s[2], s[3])));
        float p[4], ps = 0.f;
#pragma unroll
        for (int j = 0; j < 4; ++j) { p[j] = exp2f(s[j] - m); ps += p[j]; }
        const float l = wave_sum(ps);
        float o0 = 0.f, o1 = 0.f;
#pragma unroll
        for (int j = 0; j < 4; ++j) {
            const bf16* vp = MV + (size_t)(b * 256 + 64 * j) * 512 + h * 128 + lane;
            for (int kk = 0; kk < 64; ++kk) { const float pk = rdlane(p[j], kk); o0 += pk * bf2f(vp[(size_t)kk * 512]); o1 += pk * bf2f(vp[(size_t)kk * 512 + 64]); }
        }
        OM[(size_t)t * 512 + h * 128 + lane] = (bf16)f2bf(o0 / l); OM[(size_t)t * 512 + h * 128 + 64 + lane] = (bf16)f2bf(o1 / l);
    }
}
__device__ __forceinline__ void conv_act_pass(const bf16* U, int ntp, int tp0, const float* cw, const float* cb, bf16* ACT, int gtid, int NGT) {
    const int ldu = ntp * 256, nitem = T * ntp * 16;
    for (int it = gtid; it < nitem; it += NGT) {
        const int g8 = it & 15, j = (it >> 4) % ntp, t = (it >> 4) / ntp;
        const int ch = 128 * (tp0 + j) + 8 * g8;
        const bf16* ug = U + (size_t)t * ldu + 256 * j + 8 * g8; const bf16* uv = ug + 128;
        const bool hp = (t & 4095) != 0, hn = (t & 4095) != 4095;
        const v4u z = {0u, 0u, 0u, 0u};
        const v4u g0 = hp ? *(const v4u*)(ug - ldu) : z, g1 = *(const v4u*)ug, g2 = hn ? *(const v4u*)(ug + ldu) : z;
        const v4u v0 = hp ? *(const v4u*)(uv - ldu) : z, v1 = *(const v4u*)uv, v2 = hn ? *(const v4u*)(uv + ldu) : z;
        float r[8];
#pragma unroll
        for (int e = 0; e < 8; ++e) {
            const int c = ch + e; const unsigned sh = e >> 1;
            const float a0 = (e & 1) ? bf_hi(g0[sh]) : bf_lo(g0[sh]), a1 = (e & 1) ? bf_hi(g1[sh]) : bf_lo(g1[sh]), a2 = (e & 1) ? bf_hi(g2[sh]) : bf_lo(g2[sh]);
            const float b0 = (e & 1) ? bf_hi(v0[sh]) : bf_lo(v0[sh]), b1 = (e & 1) ? bf_hi(v1[sh]) : bf_lo(v1[sh]), b2 = (e & 1) ? bf_hi(v2[sh]) : bf_lo(v2[sh]);
            const float gg = a0 * cw[c] + a1 * cw[DFF2 + c] + a2 * cw[2 * DFF2 + c] + cb[c];
            const float vv = b0 * cw[DFF + c] + b1 * cw[DFF2 + DFF + c] + b2 * cw[2 * DFF2 + DFF + c] + cb[DFF + c];
            r[e] = gg / (1.f + __expf(-gg)) * vv;
        }
        v4u o; o.x = pk2(r[0], r[1]); o.y = pk2(r[2], r[3]); o.z = pk2(r[4], r[5]); o.w = pk2(r[6], r[7]);
        *(v4u*)(ACT + (size_t)t * DFF + ch) = o;
    }
}

__device__ __forceinline__ void conv_edge_fix(int pm, const float* EDGE, const float* cw, const float* cb, bf16* ACT, int tid) {
    const f32x4 z = {0.f, 0.f, 0.f, 0.f};
    for (int it = tid; it < 8 * (DFF / 4); it += NTHREADS) {
        const int c4 = it % (DFF / 4), e8 = it / (DFF / 4), blk = pm * 4 + (e8 >> 1), last = e8 & 1, ch = 4 * c4;
        const int row = blk * 64 + (last ? 63 : 0);
        const float* eb = EDGE + (size_t)blk * 4 * DFF2 + ch;
        f32x4 g0, g1, g2, v0, v1, v2;
        if (!last) { const bool hp = (row & 4095) != 0;
            g0 = hp ? *(const f32x4*)(eb - DFF2) : z; v0 = hp ? *(const f32x4*)(eb - DFF2 + DFF) : z;
            g1 = *(const f32x4*)eb; v1 = *(const f32x4*)(eb + DFF); g2 = *(const f32x4*)(eb + DFF2); v2 = *(const f32x4*)(eb + DFF2 + DFF); }
        else { const bool hn = (row & 4095) != 4095;
            g0 = *(const f32x4*)(eb + 2 * DFF2); v0 = *(const f32x4*)(eb + 2 * DFF2 + DFF); g1 = *(const f32x4*)(eb + 3 * DFF2); v1 = *(const f32x4*)(eb + 3 * DFF2 + DFF);
            g2 = hn ? *(const f32x4*)(eb + 4 * DFF2) : z; v2 = hn ? *(const f32x4*)(eb + 4 * DFF2 + DFF) : z; }
        const f32x4 gg = *(const f32x4*)(cw + ch) * g0 + *(const f32x4*)(cw + DFF2 + ch) * g1 + *(const f32x4*)(cw + 2 * DFF2 + ch) * g2 + *(const f32x4*)(cb + ch);
        const f32x4 vv = *(const f32x4*)(cw + DFF + ch) * v0 + *(const f32x4*)(cw + DFF2 + DFF + ch) * v1 + *(const f32x4*)(cw + 2 * DFF2 + DFF + ch) * v2 + *(const f32x4*)(cb + DFF + ch);
        float a[4];
#pragma unroll
        for (int e = 0; e < 4; ++e) a[e] = gg[e] * __builtin_amdgcn_rcpf(1.0f + __builtin_amdgcn_exp2f(gg[e] * -LOG2E)) * vv[e];
        pg8::u32x2 w; w.x = pg8::cvt_pk_bf16(a[0], a[1]); w.y = pg8::cvt_pk_bf16(a[2], a[3]);
        *(pg8::u32x2*)(ACT + (size_t)row * DFF + ch) = w;
    }
}

__device__ __forceinline__ const void* karg(int i) {
    unsigned off = (unsigned)i * 8u; asm volatile("" : "+s"(off));
    return *(const void* const __attribute__((address_space(4)))*)((const char __attribute__((address_space(4)))*)__builtin_amdgcn_kernarg_segment_ptr() + off);
}
#define WSP() ((unsigned char*)karg(20))
#define OUTP() ((float*)karg(19))
#define INP(i) ((const float*)karg(i))
#define WSB(off) ((bf16*)(WSP() + (off)))
#define WSF(off) ((float*)(WSP() + (off)))
struct Ids { int tid, lane, wave, vcu, gw, NGW, gtid, NGT, G, bx; };
__device__ __forceinline__ Ids ids() {
    Ids I; int t = threadIdx.x; asm volatile("" : "+v"(t)); I.tid = t; I.lane = t & 63; I.wave = __builtin_amdgcn_readfirstlane(t >> 6);
    I.G = gridDim.x; I.bx = blockIdx.x; I.vcu = (I.G % 8 == 0) ? (I.bx % 8) * (I.G / 8) + I.bx / 8 : I.bx;
    I.gw = I.vcu * NWAVES + I.wave; I.NGW = I.G * NWAVES; I.gtid = I.vcu * NTHREADS + I.tid; I.NGT = I.G * NTHREADS; return I;
}
__device__ __forceinline__ void grid_bar(LAS unsigned char* L) {
    XcdBarrier b; b.bar = (unsigned*)(WSP() + WS_CTL) + CW_BAR; b.x = xb_xcc_id(); b.st = (volatile LAS unsigned*)(L + MISC_OFF) + 8;
    xcd_barrier(b);
}
__global__ void __launch_bounds__(NTHREADS, 2) mk_fwd(Args args) {
    extern __shared__ __attribute__((aligned(16))) unsigned char lds[];
    LAS unsigned char* L = (LAS unsigned char*)lds;
    {
        const int tid = threadIdx.x;
        for (int u = tid; u < (LDS_BYTES - LDSCTL_OFF) / 4; u += NTHREADS) ((LAS unsigned*)(L + LDSCTL_OFF))[u] = 0u;
        __syncthreads();
        (void)xcd_barrier_post((unsigned*)(WSP() + WS_CTL) + CW_BAR, (volatile LAS unsigned*)(L + MISC_OFF) + 8);
    }
#define GRID_BAR() grid_bar(L)

    {
        const Ids I = ids(); const int lane = I.lane;
        LAS float* scr = (LAS float*)(L + RING_OFF + I.wave * 16384);
        constexpr int I_IN = 16 * (NINW / 32), I_OUT = 16 * 32, I_MQ = 16 * 16, I_MKV = 16 * 32, I_MO = 8 * 32, I_UP = 16 * (DFF2 / 32), I_DN = 44 * 32;
        constexpr int I_L = I_IN + I_OUT + I_MQ + I_MKV + I_MO + I_UP + I_DN;
        for (int it = I.gw; it < 2 * I_L; it += I.NGW) {
            const int l = it / I_L; int r = it % I_L;
            if (r < I_IN) { p0_transpose_item(INP(3) + (size_t)l * D * NINW, D, NINW, INP(2) + l * D, 1, WSB(WS_WIN) + (size_t)l * NINW * D, scr, r, lane); continue; } r -= I_IN;
            if (r < I_OUT) { p0_transpose_item(INP(7) + (size_t)l * D * D, D, D, nullptr, 0, WSB(WS_WOUT) + (size_t)l * D * D, scr, r, lane); continue; } r -= I_OUT;
            if (r < I_MQ) { p0_transpose_item(INP(10) + (size_t)l * D * MEMW, D, MEMW, INP(8) + l * D, 0, WSB(WS_WMQ) + (size_t)l * MEMW * D, scr, r, lane); continue; } r -= I_MQ;
            if (r < I_MKV) { p0_transpose_item(INP(11) + (size_t)l * D * 1024, D, 1024, INP(9) + l * D, 0, WSB(WS_WMKV) + (size_t)l * 1024 * D, scr, r, lane); continue; } r -= I_MKV;
            if (r < I_MO) { p0_transpose_item(INP(12) + (size_t)l * MEMW * D, MEMW, D, nullptr, 0, WSB(WS_WMO) + (size_t)l * D * MEMW, scr, r, lane); continue; } r -= I_MO;
            if (r < I_UP) { p0_transpose_item(INP(14) + (size_t)l * D * DFF2, D, DFF2, INP(13) + l * D, 2, WSB(WS_WUP) + (size_t)l * DFF2 * D, scr, r, lane); continue; } r -= I_UP;
            p0_transpose_item(INP(17) + (size_t)l * DFF * D, DFF, D, nullptr, 0, WSB(WS_WDN) + (size_t)l * D * DFF, scr, r, lane);
        }
        { const float* x_in = INP(0); bf16* XB = WSB(WS_XB); float* SS = WSF(WS_SS);
          for (int m = I.gw; m < T; m += I.NGW) row_to_bf16_ss(x_in + (size_t)m * D, XB + (size_t)m * D, SS + (size_t)m * 16, lane); }
        { const float* mem_in = INP(1); bf16* MXB = WSB(WS_MXB); float* MSS = WSF(WS_MSS);
          for (int m = I.gw; m < MEMT; m += I.NGW) row_to_bf16_ss(mem_in + (size_t)m * D, MXB + (size_t)m * D, MSS + (size_t)m * 16, lane); }
        if (I.bx == 0) { float* ROPE = WSF(WS_ROPE); for (int i = I.tid; i < 1024; i += NTHREADS) { const int pos = i >> 4, f = i & 15;
            const float inv_freq = powf(10000.0f, -(float)f / 16.0f); const float ang = (float)pos * inv_freq;
            ROPE[pos * 32 + f] = cosf(ang); ROPE[pos * 32 + 16 + f] = sinf(ang); } }
    }
    GRID_BAR();

    {
        pg8::Gemm g{WSB(WS_MXB), WSB(WS_WMKV), MEMT, 2048, D}; pg8::StaticOrder S; S.init(MEMT, 2048, gridDim.x, blockIdx.x);
        pg8::EpiSB E{WSB(WS_MKV), MEMW, WSF(WS_MSS), 512, (size_t)MEMT * MEMW, 1.f};
        pg8::gemm_phase<pg8::EpiSB, pg8::StaticOrder, PG8_ALIGN, PG8_SP2>(L + RING_OFF, g, S, E);
    }

    for (int l = 0; l < 2; ++l) {
        {
            pg8::Gemm g{WSB(WS_XB), WSB(WS_WIN) + (size_t)l * NINW * D, T, NINW, D}; pg8::StaticOrder S; S.init(T, NINW, gridDim.x, blockIdx.x);
            pg8::EpiInProj E{WSF(WS_SS), WSB(WS_NQ), (size_t)T * 512, WSB(WS_GQ), WSB(WS_GK), WSB(WS_GV), WSF(WS_ROPE), INP(5) + l * 64, INP(6) + l * 64, QS_NA, QS_G};
            pg8::gemm_phase<pg8::EpiInProj, pg8::StaticOrder, PG8_ALIGN, PG8_SP2>(L + RING_OFF, g, S, E);
        }
        GRID_BAR();
#if NAIVE_NA
        { const Ids I = ids(); na_naive(WSB(WS_NQ), WSB(WS_NK), WSB(WS_NV), WSB(WS_OC), INP(4) + (size_t)l * 8 * 15 * 31, I.gw, I.NGW, I.lane); }
#endif
#if NAIVE_GQA
        { const Ids I = ids(); gqa_naive(WSB(WS_GQ), WSB(WS_GK), WSB(WS_GV), WSB(WS_OC), I.gw, I.NGW, I.lane); }
#else
        { const attn_body::AttnTensors AT{(const attn_body::bf16*)WSB(WS_GQ), (const attn_body::bf16*)WSB(WS_GK), (const attn_body::bf16*)WSB(WS_GV), (attn_body::bf16*)WSB(WS_OC)};
          const attn_body::StaticOrder S((int)gridDim.x, (int)blockIdx.x);
          attn_body::attn_phase<attn_body::StaticOrder>((char*)lds + RING_OFF, AT, S); }
#endif
#if !NAIVE_NA
        {
            const int G_ = gridDim.x, bx_ = blockIdx.x;
            for (int i = 0; i < 1024; ++i) {
                int u;
                if (G_ == 256) { if (i >= 4) break; const int uu = 4 * (bx_ >> 3) + i; u = ((4 * (bx_ & 7) + (uu >> 5)) << 5) + (uu & 31); }
                else { u = bx_ + i * G_; if (u >= 1024) break; }
                const int pair = u >> 5, r0 = 2 * (u & 31);
                na_body::na_unit(pair >> 3, pair & 7, r0, WSB(WS_NQ), WSB(WS_NK), WSB(WS_NV), WSB(WS_OC), INP(4) + ((size_t)l * 8 + (pair & 7)) * 15 * 31, L);
            }
        }
#endif
        GRID_BAR();
        {
            pg8::Gemm g{WSB(WS_OC), WSB(WS_WOUT) + (size_t)l * D * D, T, D, D}; pg8::StaticOrder S; S.init(T, D, gridDim.x, blockIdx.x);
            pg8::EpiRes E{l == 0 ? INP(0) : (const float*)OUTP(), OUTP(), WSB(WS_XB), WSF(WS_SS)};
            pg8::gemm_phase<pg8::EpiRes, pg8::StaticOrder, PG8_ALIGN, PG8_SP2>(L + RING_OFF, g, S, E);
        }
        GRID_BAR();
        {
            pg8::Gemm g{WSB(WS_XB), WSB(WS_WMQ) + (size_t)l * MEMW * D, T, MEMW, D}; pg8::StaticOrder S; S.init(T, MEMW, gridDim.x, blockIdx.x);
            pg8::EpiSB E{WSB(WS_QM), MEMW, WSF(WS_SS), 0, 0, 1.f};
            pg8::gemm_phase<pg8::EpiSB, pg8::StaticOrder, PG8_ALIGN, PG8_SP2>(L + RING_OFF, g, S, E);
        }
        GRID_BAR();
#if NAIVE_MEM
        { const Ids I = ids(); const bf16* MK = WSB(WS_MKV) + (size_t)l * 2 * MEMT * MEMW;
          mem_naive(WSB(WS_QM), MK, MK + (size_t)MEMT * MEMW, WSB(WS_OM), I.gw, I.NGW, I.lane); }
#else
        { const bf16* MK = WSB(WS_MKV) + (size_t)l * 2 * MEMT * MEMW; const bf16* MV = MK + (size_t)MEMT * MEMW;
          for (int u = blockIdx.x; u < 256; u += gridDim.x) {
              const int b = u >> 6, h = (u >> 4) & 3, qb = u & 15; const size_t qoff = (size_t)(b * SEQ + qb * 256) * MEMW + h * 128, koff = (size_t)(b * MEML) * MEMW + h * 128;
              memattn::attn_dense_body<memattn::bf16>((const memattn::bf16*)(WSB(WS_QM) + qoff), (const memattn::bf16*)(MK + koff), (const memattn::bf16*)(MV + koff),
                                                      (memattn::bf16*)(WSB(WS_OM) + qoff), MEML, (char*)lds + RING_OFF);
              __syncthreads(); } }
#endif
        GRID_BAR();
        {
            pg8::Gemm g{WSB(WS_OM), WSB(WS_WMO) + (size_t)l * D * MEMW, T, D, MEMW}; pg8::StaticOrder S; S.init(T, D, gridDim.x, blockIdx.x);
            pg8::EpiRes E{OUTP(), OUTP(), WSB(WS_XB), WSF(WS_SS)};
            pg8::gemm_phase<pg8::EpiRes, pg8::StaticOrder, PG8_ALIGN, PG8_SP2>(L + RING_OFF, g, S, E);
        }
        GRID_BAR();
        {
            pg8::Gemm g{WSB(WS_XB), WSB(WS_WUP) + (size_t)l * DFF2 * D, T, DFF2, D}; pg8::StaticOrder S; S.init(T, DFF2, gridDim.x, blockIdx.x);
            pg8::EpiUpConv E{WSF(WS_SS), INP(15) + (size_t)l * 3 * DFF2, INP(16) + (size_t)l * DFF2, WSB(WS_ACT), WSF(WS_EDGE)};
            pg8::gemm_phase<pg8::EpiUpConv, pg8::StaticOrder, PG8_ALIGN, PG8_SP2>(L + RING_OFF, g, S, E);
        }
        GRID_BAR();
        {
            pg8::StaticOrder S; S.init(T, D, gridDim.x, blockIdx.x); pg8::Unit uu; int tid_ = threadIdx.x; asm volatile("" : "+v"(tid_));
            for (int i = 0; S.next(i, uu); ++i) conv_edge_fix(uu.pm, WSF(WS_EDGE), INP(15) + (size_t)l * 3 * DFF2, INP(16) + (size_t)l * DFF2, WSB(WS_ACT), tid_);
            asm volatile("s_waitcnt vmcnt(0)" ::: "memory"); __syncthreads();
        }
        {
            pg8::Gemm g{WSB(WS_ACT), WSB(WS_WDN) + (size_t)l * D * DFF, T, D, DFF}; pg8::StaticOrder S; S.init(T, D, gridDim.x, blockIdx.x);
            pg8::EpiRes E{OUTP(), OUTP(), WSB(WS_XB), WSF(WS_SS)};
            pg8::gemm_phase<pg8::EpiRes, pg8::StaticOrder, PG8_ALIGN, PG8_SP2>(L + RING_OFF, g, S, E);
        }
        GRID_BAR();
    }
    {
        const Ids I = ids(); const int lane = I.lane;
        const float* gf = INP(18); float* X = OUTP();
        for (int m = I.gw; m < T; m += I.NGW) {
            GAS f32x4* xr = (GAS f32x4*)(X + (size_t)m * D) + lane;
            f32x4 v[4]; float s = 0.f;
#pragma unroll
            for (int j = 0; j < 4; ++j) { v[j] = xr[64 * j]; s += (v[j].x * v[j].x + v[j].y * v[j].y) + (v[j].z * v[j].z + v[j].w * v[j].w); }
            const float rs = 1.0f / sqrtf(wave_sum(s) * (1.0f / D) + 1e-6f);
#pragma unroll
            for (int j = 0; j < 4; ++j) { const f32x4 gg = *((const f32x4*)gf + lane + 64 * j); xr[64 * j] = v[j] * rs * gg; }
        }
    }
}

extern "C" void kernel_launch(void* const* d_in, const int* in_sizes, int n_in, void* d_out, int out_size, void* d_ws, size_t ws_size, hipStream_t stream) {
    static int grid = 0;
    if (grid == 0) {
        if (n_in != 19 || in_sizes[0] != T * D || out_size != T * D || ws_size < WS_END) { fprintf(stderr, "kernel_launch: shape mismatch n_in %d in0 %d out %d ws %zu\n", n_in, n_in > 0 ? in_sizes[0] : -1, out_size, ws_size); grid = -1; return; }
        int dev = 0, cus = 0;
        if (hipGetDevice(&dev) != hipSuccess || hipDeviceGetAttribute(&cus, hipDeviceAttributeMultiprocessorCount, dev) != hipSuccess) { grid = -1; return; }
        if (hipFuncSetAttribute((const void*)mk_fwd, hipFuncAttributeMaxDynamicSharedMemorySize, LDS_BYTES) != hipSuccess) { fprintf(stderr, "kernel_launch: hipFuncSetAttribute failed\n"); grid = -1; return; }
        int per_cu = 0;
        if (hipOccupancyMaxActiveBlocksPerMultiprocessor(&per_cu, (const void*)mk_fwd, NTHREADS, LDS_BYTES) != hipSuccess || per_cu < 1) fprintf(stderr, "kernel_launch: occupancy query says %d\n", per_cu);
        (void)hipGetLastError();
        grid = cus;
    }
    if (grid < 0) return;
    if (hipMemsetAsync((char*)d_ws + WS_CTL, 0, CTL_ZERO_BYTES, stream) != hipSuccess) { fprintf(stderr, "kernel_launch: memset failed\n"); return; }
    Args a{};
    for (int i = 0; i < 19; ++i) a.in[i] = (const float*)d_in[i];
    a.out = (float*)d_out; a.ws = (unsigned char*)d_ws;
    hipLaunchKernelGGL(mk_fwd, dim3(grid), dim3(NTHREADS), LDS_BYTES, stream, a);
    const hipError_t le = hipPeekAtLastError();
    if (le != hipSuccess) fprintf(stderr, "kernel_launch: launch failed: %s\n", hipGetErrorName(le));
}
```

```cpp
#include <hip/hip_runtime.h>
#include <hip/hip_bf16.h>
#include <cstdio>
#include <cstdint>
#include <cmath>
namespace pg8 {
#define PG8_LAS __attribute__((address_space(3)))
typedef unsigned short bf16_t;
typedef short bf16x8 __attribute__((ext_vector_type(8)));
typedef float f32x4 __attribute__((ext_vector_type(4)));
typedef unsigned u32x4 __attribute__((ext_vector_type(4)));
constexpr int BM = 256, BK = 64, HALF = 128, HTB = HALF * BK * 2  , STAGE_BYTES = 8 * HTB, NXCD = 8, WGM = 8;

__host__ __device__ __forceinline__ int lds_byte(int r, int c) { const int st = (r >> 4) * 2 + (c >> 5), rr = r & 15, cc = c & 31, ob = rr * 64 + cc * 2; return st * 1024 + (ob ^ (((ob >> 9) & 1) << 5)); }
__host__ __device__ __forceinline__ void stage_rc(int b, int& R, int& C) { const int st = b / 1024, sb = b % 1024, swz = sb ^ (((sb >> 9) & 1) << 5); R = (st >> 1) * 16 + swz / 64; C = (st & 1) * 32 + (swz % 64) / 2; }
__host__ __device__ __forceinline__ int perm32(int rho) { const int n = rho >> 4, i = rho & 15; return 8 * (i >> 2) + 4 * n + (i & 3); }

struct Unit { int pm, pn; };
struct Gemm { const bf16_t* A; const bf16_t* Bt; int M, N, K; };

struct StaticOrder {
    int nM, nN, nwg, G, c;
    __host__ __device__ void init(int M, int N, int G_, int c_) { nM = M / BM; nN = N / BM; nwg = nM * nN; G = G_; c = c_; }
    __host__ __device__ bool next(int i, Unit& u) const {
        const long L = (long)i * G + c; if (L >= nwg) return false;
        int wgid = (int)L; { const int q = nwg / NXCD, r = nwg % NXCD, xcd = wgid % NXCD, off = wgid / NXCD; wgid = (xcd < r ? xcd * (q + 1) : r * (q + 1) + (xcd - r) * q) + off; }
        const int nig = WGM * nN, gid = wgid / nig, fm = gid * WGM, gsz = (nM - fm) < WGM ? (nM - fm) : WGM;
        u.pm = fm + ((wgid % nig) % gsz); u.pn = (wgid % nig) / gsz; return true;
    }
    __device__ __forceinline__ void a_ready(const Unit&) const {}
    __device__ __forceinline__ void done(const Unit&) const {}
};

__device__ __forceinline__ unsigned cvt_pk_bf16(float lo, float hi) { unsigned r; asm volatile("v_cvt_pk_bf16_f32 %0, %1, %2" : "=v"(r) : "v"(lo), "v"(hi)); return r; }
typedef float f32x2 __attribute__((ext_vector_type(2)));
typedef unsigned u32x2 __attribute__((ext_vector_type(2)));
__device__ __forceinline__ float row_rs(const float* SS, int row, int fq) {
    const f32x4 v = *(const f32x4*)(SS + (size_t)row * 16 + fq * 4);
    float s = (v[0] + v[1]) + (v[2] + v[3]);
    s += __shfl_xor(s, 16); s += __shfl_xor(s, 32);
    return __builtin_amdgcn_rsqf(s * (1.0f / 1024.0f) + 1e-6f);
}
struct EpiSB {
    static constexpr bool PERM = true, AFTER_DRAIN = false;
    bf16_t* O; int ldc; const float* SS; int split_cols; size_t split_stride; float scale0;
    __device__ __forceinline__ void operator()(const f32x4 (&acc)[2][2][4][2], const Unit& u, int wr, int wc, int fr, int fq) const {
        const int row0 = u.pm * BM + wr * 64 + fr; int colt = u.pn * BM; bf16_t* base = O;
        float sc = 1.f; if (split_cols) { const int t = colt / split_cols; base += (size_t)t * split_stride; colt -= t * split_cols; if (t == 0) sc = scale0; }
        const int col0 = colt + wc * 32 + 8 * fq;
#pragma unroll
        for (int ai = 0; ai < 2; ++ai)
#pragma unroll
            for (int m = 0; m < 4; ++m) { const int row = row0 + ai * HALF + m * 16; const float rs = SS ? row_rs(SS, row, fq) * sc : sc;
                bf16_t* rowp = base + (size_t)row * ldc + col0;
#pragma unroll
                for (int bj = 0; bj < 2; ++bj) { const f32x4 v0 = acc[ai][bj][m][0] * rs, v1 = acc[ai][bj][m][1] * rs;
                    u32x4 w; w.x = cvt_pk_bf16(v0[0], v0[1]); w.y = cvt_pk_bf16(v0[2], v0[3]); w.z = cvt_pk_bf16(v1[0], v1[1]); w.w = cvt_pk_bf16(v1[2], v1[3]);
                    *(u32x4*)(rowp + bj * HALF) = w; } }
    }
};
struct EpiRes {
    static constexpr bool PERM = true, AFTER_DRAIN = false;
    const float* xold; float* xnew; bf16_t* xb; float* SSo;
    __device__ __forceinline__ void operator()(const f32x4 (&acc)[2][2][4][2], const Unit& u, int wr, int wc, int fr, int fq) const {
        const int row0 = u.pm * BM + wr * 64 + fr, col0 = u.pn * BM + wc * 32 + 8 * fq;
#pragma unroll
        for (int ai = 0; ai < 2; ++ai)
#pragma unroll
            for (int m = 0; m < 4; ++m) { const int row = row0 + ai * HALF + m * 16; const size_t off = (size_t)row * 1024 + col0; float ssq = 0.f;
#pragma unroll
                for (int bj = 0; bj < 2; ++bj) {
                    const f32x4 a0 = *(const f32x4*)(xold + off + bj * HALF), a1 = *(const f32x4*)(xold + off + bj * HALF + 4);
                    const f32x4 v0 = a0 + acc[ai][bj][m][0], v1 = a1 + acc[ai][bj][m][1];
                    *(f32x4*)(xnew + off + bj * HALF) = v0; *(f32x4*)(xnew + off + bj * HALF + 4) = v1;
                    u32x4 w; w.x = cvt_pk_bf16(v0[0], v0[1]); w.y = cvt_pk_bf16(v0[2], v0[3]); w.z = cvt_pk_bf16(v1[0], v1[1]); w.w = cvt_pk_bf16(v1[2], v1[3]);
                    *(u32x4*)(xb + off + bj * HALF) = w;
                    ssq += (v0[0] * v0[0] + v0[1] * v0[1]) + (v0[2] * v0[2] + v0[3] * v0[3]) + (v1[0] * v1[0] + v1[1] * v1[1]) + (v1[2] * v1[2] + v1[3] * v1[3]); }
                ssq += __shfl_xor(ssq, 16); ssq += __shfl_xor(ssq, 32);
                if (fq == 0) SSo[(size_t)row * 16 + u.pn * 4 + wc] = ssq; }
    }
};
struct EpiInProj {
    static constexpr bool PERM = true, AFTER_DRAIN = false;
    const float* SS; bf16_t* NQKV; size_t nstride; bf16_t* GQ; bf16_t* GK; bf16_t* GV; const float* rope; const float* qn; const float* kn; float qs_na, qs_g;
    __device__ __forceinline__ void operator()(const f32x4 (&acc)[2][2][4][2], const Unit& u, int wr, int wc, int fr, int fq) const {
        const int row0 = u.pm * BM + wr * 64 + fr;
        if (u.pn < 6) {
            bf16_t* base = NQKV + (size_t)(u.pn >> 1) * nstride; const int col0 = (u.pn & 1) * 256 + wc * 32 + 8 * fq; const float sc = u.pn < 2 ? qs_na : 1.f;
#pragma unroll
            for (int ai = 0; ai < 2; ++ai)
#pragma unroll
                for (int m = 0; m < 4; ++m) { const int row = row0 + ai * HALF + m * 16; const float rs = row_rs(SS, row, fq) * sc;
                    bf16_t* rowp = base + (size_t)row * 512 + col0;
#pragma unroll
                    for (int bj = 0; bj < 2; ++bj) { const f32x4 v0 = acc[ai][bj][m][0] * rs, v1 = acc[ai][bj][m][1] * rs;
                        u32x4 w; w.x = cvt_pk_bf16(v0[0], v0[1]); w.y = cvt_pk_bf16(v0[2], v0[3]); w.z = cvt_pk_bf16(v1[0], v1[1]); w.w = cvt_pk_bf16(v1[2], v1[3]);
                        *(u32x4*)(rowp + bj * HALF) = w; } }
            return;
        }
        const bool isq = u.pn < 8, isv = (u.pn == 8) && (wc >= 2);
        bf16_t* dst; int ld; const float* gain; float post;
        if (isq) { dst = GQ + (4 * (u.pn - 6) + wc) * 64; ld = 512; gain = qn; post = qs_g; }
        else if (!isv) { dst = GK + wc * 64; ld = 128; gain = kn; post = 1.f; }
        else { dst = GV + (wc - 2) * 64; ld = 128; gain = kn; post = 1.f; }
        f32x4 g[2][2];
#pragma unroll
        for (int bj = 0; bj < 2; ++bj)
#pragma unroll
            for (int n = 0; n < 2; ++n) g[bj][n] = *(const f32x4*)(gain + 32 * bj + 16 * n + 4 * fq) * post;
#pragma unroll
        for (int ai = 0; ai < 2; ++ai)
#pragma unroll
            for (int m = 0; m < 4; ++m) { const int row = row0 + ai * HALF + m * 16; const float rs = row_rs(SS, row, fq);
                f32x4 v[2][2]; float ssq = 0.f;
#pragma unroll
                for (int bj = 0; bj < 2; ++bj)
#pragma unroll
                    for (int n = 0; n < 2; ++n) { v[bj][n] = acc[ai][bj][m][n] * rs; const f32x4 x = v[bj][n]; ssq += (x[0] * x[0] + x[1] * x[1]) + (x[2] * x[2] + x[3] * x[3]); }
                bf16_t* rowp = dst + (size_t)row * ld;
                if (!isv) {
                    ssq += __shfl_xor(ssq, 16); ssq += __shfl_xor(ssq, 32);
                    const float inv = __builtin_amdgcn_rsqf(ssq * (1.0f / 64.0f) + 1e-6f);
                    const int pos0 = (row & 4095) >> 6, pos1 = row & 63;
#pragma unroll
                    for (int bj = 0; bj < 2; ++bj) { const int pos = bj == 0 ? pos0 : pos1;
                        const f32x4 c = *(const f32x4*)(rope + pos * 32 + 4 * fq), s = *(const f32x4*)(rope + pos * 32 + 16 + 4 * fq);
                        const f32x4 x1 = v[bj][0] * inv * g[bj][0], x2 = v[bj][1] * inv * g[bj][1];
                        v[bj][0] = x1 * c - x2 * s; v[bj][1] = x1 * s + x2 * c; }
                }
#pragma unroll
                for (int bj = 0; bj < 2; ++bj)
#pragma unroll
                    for (int n = 0; n < 2; ++n) { u32x2 w; w.x = cvt_pk_bf16(v[bj][n][0], v[bj][n][1]); w.y = cvt_pk_bf16(v[bj][n][2], v[bj][n][3]);
                        *(u32x2*)(rowp + 32 * bj + 16 * n + 4 * fq) = w; } }
    }
};

template <int CTRL> __device__ __forceinline__ float dppf(float old, float src) { return __int_as_float(__builtin_amdgcn_update_dpp(__float_as_int(old), __float_as_int(src), CTRL, 0xf, 0xf, false)); }
struct EpiUpConv {
    static constexpr bool PERM = true, AFTER_DRAIN = false;
    const float* SS; const float* cw; const float* cb; bf16_t* ACT; float* EDGE;
    __device__ __forceinline__ void operator()(const f32x4 (&acc)[2][2][4][2], const Unit& u, int wr, int wc, int fr, int fq) const {
        constexpr int FF = 2816, FF2 = 5632;
        const int row0 = u.pm * BM + wr * 64 + fr, ch0 = u.pn * 128 + wc * 32 + 8 * fq;
        float rs[2][4];
#pragma unroll
        for (int ai = 0; ai < 2; ++ai)
#pragma unroll
            for (int m = 0; m < 4; ++m) rs[ai][m] = row_rs(SS, row0 + ai * HALF + m * 16, fq);
        u32x2 pk0[2][4];
#pragma unroll
        for (int n = 0; n < 2; ++n) {
            const int ch = ch0 + 4 * n;
            f32x4 wg[3], wv[3];
#pragma unroll
            for (int k = 0; k < 3; ++k) { wg[k] = *(const f32x4*)(cw + k * FF2 + ch); wv[k] = *(const f32x4*)(cw + k * FF2 + FF + ch); }
            const f32x4 bg = *(const f32x4*)(cb + ch), bv = *(const f32x4*)(cb + FF + ch);
#pragma unroll
            for (int ai = 0; ai < 2; ++ai) {
                f32x4 ug[4], uv[4];
#pragma unroll
                for (int m = 0; m < 4; ++m) { ug[m] = acc[ai][0][m][n] * rs[ai][m]; uv[m] = acc[ai][1][m][n] * rs[ai][m]; }
                { const int blk = u.pm * 4 + ai * 2 + wr;
                  if (fr < 2) { float* ep = EDGE + ((size_t)blk * 4 + fr) * FF2 + ch; *(f32x4*)ep = ug[0]; *(f32x4*)(ep + FF) = uv[0]; }
                  if (fr >= 14) { float* ep = EDGE + ((size_t)blk * 4 + (fr - 12)) * FF2 + ch; *(f32x4*)ep = ug[3]; *(f32x4*)(ep + FF) = uv[3]; } }
#pragma unroll
                for (int m = 0; m < 4; ++m) {
                    float a[4];
#pragma unroll
                    for (int e = 0; e < 4; ++e) {
                        const float gp = dppf<0x111>(m > 0 ? dppf<0x121>(0.f, ug[m > 0 ? m - 1 : 0][e]) : 0.f, ug[m][e]);
                        const float gn = dppf<0x101>(m < 3 ? dppf<0x12F>(0.f, ug[m < 3 ? m + 1 : 3][e]) : 0.f, ug[m][e]);
                        const float vp = dppf<0x111>(m > 0 ? dppf<0x121>(0.f, uv[m > 0 ? m - 1 : 0][e]) : 0.f, uv[m][e]);
                        const float vn = dppf<0x101>(m < 3 ? dppf<0x12F>(0.f, uv[m < 3 ? m + 1 : 3][e]) : 0.f, uv[m][e]);
                        const float gg = wg[0][e] * gp + wg[1][e] * ug[m][e] + wg[2][e] * gn + bg[e];
                        const float vv = wv[0][e] * vp + wv[1][e] * uv[m][e] + wv[2][e] * vn + bv[e];
                        a[e] = gg * __builtin_amdgcn_rcpf(1.0f + __builtin_amdgcn_exp2f(gg * -1.4426950408889634f)) * vv;
                    }
                    u32x2 w; w.x = cvt_pk_bf16(a[0], a[1]); w.y = cvt_pk_bf16(a[2], a[3]);
                    if (n == 0) pk0[ai][m] = w;
                    else { u32x4 o; o.x = pk0[ai][m].x; o.y = pk0[ai][m].y; o.z = w.x; o.w = w.y;
                           *(u32x4*)(ACT + (size_t)(row0 + ai * HALF + m * 16) * FF + ch0) = o; }
                }
            }
        }
    }
};

template <class Epi, class Sched, bool ALIGN_EPI = false, bool SP2 = false>
__device__ __forceinline__ void gemm_phase(PG8_LAS unsigned char* lds, const Gemm g, const Sched& S, const Epi& E) {
    int tid_ = threadIdx.x; asm volatile("" : "+v"(tid_));
    const int tid = tid_, wid = __builtin_amdgcn_readfirstlane(tid >> 6), lane = tid & 63, wr = wid >> 2, wc = wid & 3, fr = lane & 15, fq = lane >> 4;
    const int K = g.K, nt = K / BK;
    unsigned voffA[2], voffB[2];
#pragma unroll
    for (int i = 0; i < 2; ++i) { int R, C; stage_rc(tid * 16 + i * 8192, R, C); const int Rb = Epi::PERM ? ((R & ~31) + perm32(R & 31)) : R;
        voffA[i] = (unsigned)(R * K + C) * 2u; voffB[i] = (unsigned)(Rb * K + C) * 2u; }
    const size_t kstep = (size_t)(BK * 2);
    const size_t hstep = (size_t)HALF * K * 2;
    const size_t tstep = 2 * hstep;
    const unsigned ldsw = (unsigned)wid * 1024u;
    const int aoff = lds_byte(wr * 64 + fr, fq * 8), boff = lds_byte(wc * 32 + fr, fq * 8);
#define PG8_SA(b, h) (((b) * 2 + (h)) * HTB)
#define PG8_SB(b, h) ((4 + (b) * 2 + (h)) * HTB)
#define PG8_STAGE(bufoff, gbase, voff) do { _Pragma("unroll") for (int _i = 0; _i < 2; ++_i) \
        __builtin_amdgcn_global_load_lds((const unsigned*)((const char*)(gbase) + (voff)[_i]), (PG8_LAS unsigned*)(lds + (bufoff) + ldsw + _i * 8192), 16, 0, 0); } while (0)
#define PG8_LDA(dst, b, h) do { _Pragma("unroll") for (int m = 0; m < 4; ++m) _Pragma("unroll") for (int k = 0; k < 2; ++k) dst[m][k] = *(const PG8_LAS bf16x8*)(lds + PG8_SA(b, h) + aoff + m * 2048 + k * 1024); } while (0)
#define PG8_LDB(dst, b, h) do { _Pragma("unroll") for (int n = 0; n < 2; ++n) _Pragma("unroll") for (int k = 0; k < 2; ++k) dst[n][k] = *(const PG8_LAS bf16x8*)(lds + PG8_SB(b, h) + boff + n * 2048 + k * 1024); } while (0)
#define PG8_MMA(ai, bj, At, Bt) do { __builtin_amdgcn_s_setprio(1); _Pragma("unroll") for (int m = 0; m < 4; ++m) _Pragma("unroll") for (int n = 0; n < 2; ++n) _Pragma("unroll") for (int k = 0; k < 2; ++k) \
        acc[ai][bj][m][n] = __builtin_amdgcn_mfma_f32_16x16x32_bf16(Bt[n][k], At[m][k], acc[ai][bj][m][n], 0, 0, 0); __builtin_amdgcn_s_setprio(0); } while (0)
#define PG8_WAIT_V(n) asm volatile("s_waitcnt vmcnt(" #n ")" ::: "memory")
#define PG8_WAIT_L(n) asm volatile("s_waitcnt lgkmcnt(" #n ")" ::: "memory")
#define PG8_BAR __builtin_amdgcn_s_barrier()
#define PG8_SCHED __builtin_amdgcn_sched_barrier(0)
    Unit cur, nxt; int ui = 0;
    if (!S.next(0, cur)) return;
    f32x4 acc[2][2][4][2];
#pragma unroll
    for (int a = 0; a < 2; ++a)
#pragma unroll
        for (int b = 0; b < 2; ++b)
#pragma unroll
            for (int m = 0; m < 4; ++m)
#pragma unroll
                for (int n = 0; n < 2; ++n) acc[a][b][m][n] = (f32x4){0.f, 0.f, 0.f, 0.f};
    bf16x8 At[4][2], B0[2][2], B1[2][2];
    const char* cA = (const char*)g.A + (size_t)cur.pm * tstep; const char* cB = (const char*)g.Bt + (size_t)cur.pn * tstep;
    S.a_ready(cur);
    if constexpr (SP2) {
        PG8_STAGE(PG8_SB(0, 0), cB, voffB); PG8_STAGE(PG8_SB(0, 1), cB + hstep, voffB); PG8_STAGE(PG8_SA(0, 0), cA, voffA); PG8_STAGE(PG8_SA(0, 1), cA + hstep, voffA);
        if (wr == 1) PG8_BAR;
        PG8_WAIT_V(2); PG8_BAR;
        PG8_STAGE(PG8_SB(1, 0), cB + kstep, voffB); PG8_STAGE(PG8_SA(1, 0), cA + kstep, voffA); PG8_STAGE(PG8_SB(1, 1), cB + hstep + kstep, voffB);
        PG8_WAIT_V(6); PG8_BAR;
    } else {
        PG8_STAGE(PG8_SB(0, 0), cB, voffB); PG8_STAGE(PG8_SA(0, 0), cA, voffA); PG8_STAGE(PG8_SB(0, 1), cB + hstep, voffB); PG8_STAGE(PG8_SA(0, 1), cA + hstep, voffA);
        if (wr == 1) PG8_BAR;
        PG8_WAIT_V(4); PG8_BAR;
        PG8_STAGE(PG8_SB(1, 0), cB + kstep, voffB); PG8_STAGE(PG8_SA(1, 0), cA + kstep, voffA); PG8_STAGE(PG8_SB(1, 1), cB + hstep + kstep, voffB);
        PG8_WAIT_V(6); PG8_BAR;
    }
    for (;;) {
        const bool has_next = S.next(ui + 1, nxt);
        const char* nA = has_next ? (const char*)g.A + (size_t)nxt.pm * tstep : cA; const char* nB = has_next ? (const char*)g.Bt + (size_t)nxt.pn * tstep : cB;
        for (int t = 0; t < nt; t += 2) {
            const bool last = (t == nt - 2);
            const char* a1 = cA + (size_t)(t + 1) * kstep;
            const char* a2 = last ? nA : cA + (size_t)(t + 2) * kstep; const char* b2 = last ? nB : cB + (size_t)(t + 2) * kstep;
            const char* a3 = a2 + kstep; const char* b3 = b2 + kstep;
            if (last && has_next) S.a_ready(nxt);
            if constexpr (SP2) {
            PG8_LDB(B0, 0, 0); PG8_LDB(B1, 0, 1); PG8_SCHED; PG8_LDA(At, 0, 0); PG8_STAGE(PG8_SA(1, 1), a1 + hstep, voffA);
            PG8_WAIT_V(8); PG8_WAIT_L(0); PG8_BAR; PG8_MMA(0, 0, At, B0); PG8_MMA(0, 1, At, B1); PG8_BAR; PG8_SCHED;
            PG8_LDA(At, 0, 1); PG8_STAGE(PG8_SB(0, 0), b2, voffB); PG8_STAGE(PG8_SB(0, 1), b2 + hstep, voffB); PG8_STAGE(PG8_SA(0, 0), a2, voffA);
            PG8_WAIT_V(8); PG8_WAIT_L(0); PG8_BAR; PG8_MMA(1, 0, At, B0); PG8_MMA(1, 1, At, B1); PG8_BAR; PG8_SCHED;
            PG8_LDB(B0, 1, 0); PG8_LDB(B1, 1, 1); PG8_SCHED; PG8_LDA(At, 1, 0); PG8_STAGE(PG8_SA(0, 1), a2 + hstep, voffA);
            PG8_WAIT_V(8); PG8_WAIT_L(0); PG8_BAR; PG8_MMA(0, 0, At, B0); PG8_MMA(0, 1, At, B1); PG8_BAR; PG8_SCHED;
            PG8_LDA(At, 1, 1); PG8_STAGE(PG8_SB(1, 0), b3, voffB); PG8_STAGE(PG8_SB(1, 1), b3 + hstep, voffB); PG8_STAGE(PG8_SA(1, 0), a3, voffA);
            PG8_WAIT_V(8); PG8_WAIT_L(0); PG8_BAR; PG8_MMA(1, 0, At, B0); PG8_MMA(1, 1, At, B1); PG8_BAR; PG8_SCHED;
            } else {
            PG8_LDB(B0, 0, 0); PG8_SCHED; PG8_LDA(At, 0, 0); PG8_STAGE(PG8_SA(1, 1), a1 + hstep, voffA);
            PG8_WAIT_L(8); PG8_BAR; PG8_WAIT_L(0); PG8_MMA(0, 0, At, B0); PG8_BAR; PG8_SCHED;
            PG8_LDB(B1, 0, 1); PG8_STAGE(PG8_SB(0, 0), b2, voffB);
            PG8_BAR; PG8_WAIT_L(0); PG8_MMA(0, 1, At, B1); PG8_BAR;
            PG8_LDA(At, 0, 1); PG8_STAGE(PG8_SA(0, 0), a2, voffA);
            PG8_BAR; PG8_WAIT_L(0); PG8_MMA(1, 0, At, B0); PG8_BAR; PG8_SCHED;
            PG8_STAGE(PG8_SB(0, 1), b2 + hstep, voffB);
            PG8_WAIT_V(6); PG8_BAR; PG8_MMA(1, 1, At, B1); PG8_BAR;
            PG8_LDB(B0, 1, 0); PG8_SCHED; PG8_LDA(At, 1, 0); PG8_STAGE(PG8_SA(0, 1), a2 + hstep, voffA);
            PG8_WAIT_L(8); PG8_BAR; PG8_WAIT_L(0); PG8_MMA(0, 0, At, B0); PG8_BAR; PG8_SCHED;
            PG8_LDB(B1, 1, 1); PG8_STAGE(PG8_SB(1, 0), b3, voffB);
            PG8_BAR; PG8_WAIT_L(0); PG8_MMA(0, 1, At, B1); PG8_BAR;
            PG8_LDA(At, 1, 1); PG8_STAGE(PG8_SA(1, 0), a3, voffA);
            PG8_BAR; PG8_WAIT_L(0); PG8_MMA(1, 0, At, B0); PG8_BAR; PG8_SCHED;
            PG8_STAGE(PG8_SB(1, 1), b3 + hstep, voffB);
            PG8_WAIT_V(6); PG8_BAR; PG8_MMA(1, 1, At, B1); PG8_BAR;
            }
        }
        if constexpr (ALIGN_EPI) { if (wr == 0) PG8_BAR; }
        if constexpr (!Epi::AFTER_DRAIN) { E(acc, cur, wr, wc, fr, fq); S.done(cur); }
        if (!has_next) break;
#pragma unroll
        for (int a = 0; a < 2; ++a)
#pragma unroll
            for (int b = 0; b < 2; ++b)
#pragma unroll
                for (int m = 0; m < 4; ++m)
#pragma unroll
                    for (int n = 0; n < 2; ++n) acc[a][b][m][n] = (f32x4){0.f, 0.f, 0.f, 0.f};
        cur = nxt; cA = nA; cB = nB; ++ui;
        if constexpr (ALIGN_EPI) { if (wr == 1) PG8_BAR; }
    }
    PG8_WAIT_V(0);
    if constexpr (!ALIGN_EPI) { if (wr == 0) PG8_BAR; }
    PG8_BAR;
    if constexpr (Epi::AFTER_DRAIN) { E.fused(acc, cur, wr, wc, fr, fq, lds, wid, lane); S.done(cur); }
#undef PG8_SA
#undef PG8_SB
#undef PG8_STAGE
#undef PG8_LDA
#undef PG8_LDB
#undef PG8_MMA
#undef PG8_WAIT_V
#undef PG8_WAIT_L
#undef PG8_BAR
#undef PG8_SCHED
}
}
namespace attn_body {
using bf16=__hip_bfloat16;
using bf16x8=__attribute__((ext_vector_type(8)))short;
using s16x4=__attribute__((ext_vector_type(4)))short;
using f32x16=__attribute__((ext_vector_type(16)))float;
using u32x4=__attribute__((ext_vector_type(4)))unsigned;
constexpr int BATCH=4,NHEAD=8,SEQ=4096,D=64;
constexpr int PQ=512,PK=128,PO=1024,OCOL=512;
constexpr int NW=8,QBLK=32,QB=QBLK*NW,KVBLK=64,NQB=SEQ/QB;
constexpr int ATTN_UNIT_ROWS=QB;
__device__ __forceinline__ int crow(int r,int hi){return (r&3)+8*(r>>2)+4*hi;}
#define SBAR() __builtin_amdgcn_sched_barrier(0)
__device__ __forceinline__ void cmask(f32x16&p0,f32x16&p1,int jb,int qrel,int hi){
  const float NEG=-INFINITY; int kb=64*jb+4*hi;
  #pragma unroll
  for(int r=0;r<16;++r){int kv=kb+(r&3)+8*(r>>2); if(kv>qrel)p0[r]=NEG; if(kv+32>qrel)p1[r]=NEG;}
}

constexpr int NSLOT=3, SLOTB=8192;
constexpr int LDS_K=0, LDS_V=NSLOT*SLOTB, LDS_WS=2*NSLOT*SLOTB, LDS_OST=LDS_WS+NW*64*4, LDS_BYTES=LDS_OST+NW*4096;
constexpr float C2=0.125f*1.4426950408889634f;
__device__ __forceinline__ void glds16(const void*gsrc,unsigned lds_dst){unsigned keep;
  asm volatile("s_mov_b32 %0, m0\n\ts_mov_b32 m0, %2\n\ts_nop 0\n\tglobal_load_lds_dwordx4 %1, off\n\ts_mov_b32 m0, %0":"=&s"(keep):"v"(gsrc),"s"(lds_dst):"memory");}
__device__ __forceinline__ float max3f(float a,float b,float c){float r;asm("v_max3_f32 %0, %1, %2, %3":"=v"(r):"v"(a),"v"(b),"v"(c));return r;}
__device__ __forceinline__ float max2f(float a,float b){float r;asm("v_max_f32_e32 %0, %1, %2":"=v"(r):"v"(a),"v"(b));return r;}
__device__ __forceinline__ float fadd_s(float a,float b){float r;asm("v_add_f32_e32 %0, %1, %2":"=v"(r):"v"(a),"v"(b));return r;}
__device__ __forceinline__ float fsub_s(float a,float b){float r;asm("v_sub_f32_e32 %0, %1, %2":"=v"(r):"v"(a),"v"(b));return r;}
typedef float f32x2_t __attribute__((ext_vector_type(2))); typedef __bf16 bf16x2_t __attribute__((ext_vector_type(2)));
__device__ __forceinline__ unsigned cvtpk_s(float lo,float hi){f32x2_t v={lo,hi};bf16x2_t b=__builtin_convertvector(v,bf16x2_t);return __builtin_bit_cast(unsigned,b);}
#define WAIT_BAR(N) asm volatile("s_waitcnt vmcnt(" #N ") lgkmcnt(0)\n\ts_barrier":::"memory")

__device__ __forceinline__ void qkt(f32x16&p0,f32x16&p1,const char*Kslot,const bf16x8*qr,const f32x16&negm,int r32,int hi){
  const char*kb=Kslot+hi*1024+r32*16;
  #pragma unroll
  for(int d0=0;d0<4;++d0){
    const bf16x8 b0=*reinterpret_cast<const bf16x8*>(kb+d0*2048);
    const bf16x8 b1=*reinterpret_cast<const bf16x8*>(kb+d0*2048+512);
    if(d0==0){p0=__builtin_amdgcn_mfma_f32_32x32x16_bf16(b0,qr[0],negm,0,0,0);p1=__builtin_amdgcn_mfma_f32_32x32x16_bf16(b1,qr[0],negm,0,0,0);}
    else{p0=__builtin_amdgcn_mfma_f32_32x32x16_bf16(b0,qr[d0],p0,0,0,0);p1=__builtin_amdgcn_mfma_f32_32x32x16_bf16(b1,qr[d0],p1,0,0,0);}}
}
typedef __attribute__((address_space(3))) const char* lds_cptr;
typedef short v4i16_t __attribute__((ext_vector_type(4)));
__device__ __forceinline__ void kload8(bf16x8*kf,lds_cptr kp){
  kf[0]=*(const __attribute__((address_space(3))) bf16x8*)(kp);      kf[1]=*(const __attribute__((address_space(3))) bf16x8*)(kp+512);
  kf[2]=*(const __attribute__((address_space(3))) bf16x8*)(kp+2048); kf[3]=*(const __attribute__((address_space(3))) bf16x8*)(kp+2560);
  kf[4]=*(const __attribute__((address_space(3))) bf16x8*)(kp+4096); kf[5]=*(const __attribute__((address_space(3))) bf16x8*)(kp+4608);
  kf[6]=*(const __attribute__((address_space(3))) bf16x8*)(kp+6144); kf[7]=*(const __attribute__((address_space(3))) bf16x8*)(kp+6656);
}
__device__ __forceinline__ void kload2(bf16x8*kf,lds_cptr kp,int j){ kf[2*j]=*(const __attribute__((address_space(3))) bf16x8*)(kp+j*2048); kf[2*j+1]=*(const __attribute__((address_space(3))) bf16x8*)(kp+j*2048+512); }
__device__ __forceinline__ s16x4 vtr(lds_cptr p){ return __builtin_bit_cast(s16x4,__builtin_amdgcn_ds_read_tr16_b64_v4i16((__attribute__((address_space(3))) v4i16_t*)p)); }
__device__ __forceinline__ float rowmax(const f32x16&p0,const f32x16&p1){
  float a=max3f(p0[0],p0[1],p1[0]),b=max3f(p0[2],p0[3],p1[1]);a=max3f(a,p1[2],p1[3]);
  #pragma unroll
  for(int r=4;r<16;r+=4){a=max3f(a,p0[r],p0[r+1]);b=max3f(b,p0[r+2],p0[r+3]);a=max3f(a,p1[r],p1[r+1]);b=max3f(b,p1[r+2],p1[r+3]);}
  const float m=max2f(a,b);
  auto rr=__builtin_amdgcn_permlane32_swap(__float_as_uint(m),__float_as_uint(m),false,false);
  return max2f(__uint_as_float(rr[0]),__uint_as_float(rr[1]));
}
__device__ __forceinline__ void pv(f32x16*o,int vb,bf16x8 pa0,bf16x8 pa1,bf16x8 pa2,bf16x8 pa3){
  #pragma unroll
  for(int d0=0;d0<2;++d0){s16x4 lo[4],hi[4];
    #pragma unroll
    for(int ks=0;ks<4;++ks){
      asm volatile("ds_read_b64_tr_b16 %0,%1 offset:%c2":"=&v"(lo[ks]):"v"(vb),"i"(d0*4096+ks*1024):"memory");
      asm volatile("ds_read_b64_tr_b16 %0,%1 offset:%c2":"=&v"(hi[ks]):"v"(vb),"i"(d0*4096+ks*1024+512):"memory");}
    asm volatile("s_waitcnt lgkmcnt(0)":::"memory");SBAR();
    #define PK(k) (bf16x8){lo[k][0],lo[k][1],lo[k][2],lo[k][3],hi[k][0],hi[k][1],hi[k][2],hi[k][3]}
    o[d0]=__builtin_amdgcn_mfma_f32_32x32x16_bf16(pa0,PK(0),o[d0],0,0,0);
    o[d0]=__builtin_amdgcn_mfma_f32_32x32x16_bf16(pa1,PK(1),o[d0],0,0,0);
    o[d0]=__builtin_amdgcn_mfma_f32_32x32x16_bf16(pa2,PK(2),o[d0],0,0,0);
    o[d0]=__builtin_amdgcn_mfma_f32_32x32x16_bf16(pa3,PK(3),o[d0],0,0,0);
    #undef PK
  }
}

#ifndef ATTN_STORE16
#define ATTN_STORE16(p,v) (*(u32x4*)(p)=(v))
#endif
template<int THRL> __device__ __forceinline__ void attn_unit(int b,int h,int qb,const bf16*Q,const bf16*__restrict__ K,const bf16*__restrict__ V,bf16*O,char*shm){
  int tid_=threadIdx.x; asm volatile("":"+v"(tid_));
  const int tid=tid_,lane=tid&63,r32=lane&31,hi=lane>>5; const int wid=__builtin_amdgcn_readfirstlane(tid>>6);
  const long rowbase=(long)b*SEQ; const int q0=qb*QB;
  const bf16*Qw=Q+(rowbase+q0+wid*QBLK)*PQ+h*D;
  const bf16*Kh=K+rowbase*PK+(h>>2)*D,*Vh=V+rowbase*PK+(h>>2)*D;
  const unsigned lds0=(unsigned)(uintptr_t)shm;
  float*wsf=(float*)(shm+LDS_WS)+wid*64;
  const bf16*ksrc=Kh+(long)lane*PK+wid*8;
  const bf16*vsrc=Vh+(long)(16*(wid&3)+(lane>>2))*PK+(wid>>2)*32+(lane&3)*8;
  const unsigned kdst=lds0+LDS_K+wid*1024, vdst=lds0+LDS_V+wid*1024;
  #define DMA_K(t,slot) glds16(ksrc+(long)(t)*KVBLK*PK,(unsigned)__builtin_amdgcn_readfirstlane(kdst+(slot)))
  #define DMA_V(t,slot) glds16(vsrc+(long)(t)*KVBLK*PK,(unsigned)__builtin_amdgcn_readfirstlane(vdst+(slot)))
  const int vb0=(int)(lds0+LDS_V)+((lane>>4)&1)*32+(lane&3)*8+(4*hi+((lane&15)>>2))*64;
  const char*Kbase=shm+LDS_K; bf16x8 kf[8];
  const lds_cptr shm3=(lds_cptr)shm; const lds_cptr kp0=shm3+LDS_K+hi*1024+r32*16; const lds_cptr vp0=shm3+LDS_V+((lane>>4)&1)*32+(lane&3)*8+(4*hi+((lane&15)>>2))*64;
  constexpr int NT=SEQ/KVBLK;
  DMA_K(0,0);DMA_V(0,0);DMA_K(1,SLOTB);
  bf16x8 qr[4];
  #pragma unroll
  for(int d0=0;d0<4;++d0)qr[d0]=*reinterpret_cast<const bf16x8*>(&Qw[(long)r32*PQ+d0*16+hi*8]);
  float mhat=0.f,l_reg=0.f;f32x16 o[2];o[0]=f32x16{};o[1]=f32x16{};f32x16 negm=f32x16{};asm volatile("":"+v"(negm));
  #define CMASK(P0,P1,t) do{}while(0)
  bool resc=false;
  #define START(P0,P1) do{ const float rm=rowmax(P0,P1); resc=false; \
    { const float dl=rm; mhat=fadd_s(mhat,dl); \
      _Pragma("unroll") for(int r=0;r<16;++r){P0[r]=fsub_s(P0[r],dl);P1[r]=fsub_s(P1[r],dl);} \
      _Pragma("unroll") for(int r=0;r<16;++r)negm[r]=-mhat; asm volatile("":"+v"(negm)); } \
    _Pragma("unroll") for(int r=0;r<16;++r)P0[r]=__builtin_amdgcn_exp2f(P0[r]); }while(0)
  #define RESC() do{ if(resc){ asm volatile("s_waitcnt lgkmcnt(0)":::"memory"); \
      _Pragma("unroll") for(int d_=0;d_<2;++d_) _Pragma("unroll") for(int r=0;r<16;++r)o[d_][r]*=wsf[crow(r,hi)]; } }while(0)
  f32x16 pA0,pA1,pB0,pB1;
  int sl_prev=0,sl_cur=0,sl_next=SLOTB;
  #define ROT() do{sl_prev=sl_cur;sl_cur=sl_next;sl_next=(sl_next==(NSLOT-1)*SLOTB)?0:sl_next+SLOTB;}while(0)
  DMA_K(2,2*SLOTB);
  WAIT_BAR(3);
  qkt(pA0,pA1,Kbase,qr,negm,r32,hi);asm volatile("s_nop 15\n\ts_nop 7":"+v"(pA0),"+v"(pA1));CMASK(pA0,pA1,0);
  START(pA0,pA1);
  _Pragma("unroll") for(int r=0;r<16;++r)pA1[r]=__builtin_amdgcn_exp2f(pA1[r]);
  WAIT_BAR(0);
  DMA_K(3,0);DMA_V(1,SLOTB);
  ROT();
  kload8(kf,kp0+sl_cur);
  WAIT_BAR(2);
  s16x4 vlo[8],vhi[8]; u32x4 pw0,pw1,pw2,pw3;
  #define PKW(P,B) cvtpk_s(P[B],P[B+1])
  #define PAF(k) __builtin_bit_cast(bf16x8,pw##k)
  #define VFR(i) (bf16x8){vlo[i][0],vlo[i][1],vlo[i][2],vlo[i][3],vhi[i][0],vhi[i][1],vhi[i][2],vhi[i][3]}
  #define PIN(x) asm volatile("":"+v"(x))
  #define MX3(a,b,c) __builtin_fmaxf(__builtin_fmaxf((a),(b)),(c))
  #define GAPA(MF,A0,A1,A2,A3,W0,W1,PW) do{ MF; sacc+=A0; sacc+=A1; sacc+=A2; sacc+=A3; PIN(sacc); W0; W1; PIN(PW); SBAR(); }while(0)
  #define EX(v) __builtin_amdgcn_exp2f(v)
  #define GAPB(MF,X,B) do{ MF; X[B]=EX(X[B]); X[B+1]=EX(X[B+1]); X[B+2]=EX(X[B+2]); X[B+3]=EX(X[B+3]); PIN(X); SBAR(); }while(0)
  #define VRD(i) do{ vlo[i]=vtr(vp_+(((i)>>2)*4096+((i)&3)*1024)); vhi[i]=vtr(vp_+(((i)>>2)*4096+((i)&3)*1024+512)); }while(0)
  #define KRD(G,j) do{ if(G){ kload2(kf,kp0+sl_next,j); SBAR(); } }while(0)
  #define STEP(C0,C1,P0,P1,t,GK,GV,GL) do{ SBAR(); \
    const lds_cptr vp_=vp0+sl_prev; \
    VRD(0); SBAR(); float sacc=(P0[0]+P0[1]); \
    GAPA(C0=__builtin_amdgcn_mfma_f32_32x32x16_bf16(kf[0],qr[0],negm,0,0,0), P0[2],P0[3],P0[4],P0[5],     pw0[0]=PKW(P0,0), pw0[1]=PKW(P0,2), pw0); \
    VRD(4); SBAR(); GAPA(C1=__builtin_amdgcn_mfma_f32_32x32x16_bf16(kf[1],qr[0],negm,0,0,0), P0[6],P0[7],P0[8],P0[9],     pw0[2]=PKW(P0,4), pw0[3]=PKW(P0,6), pw0); \
    VRD(1); SBAR(); GAPA(C0=__builtin_amdgcn_mfma_f32_32x32x16_bf16(kf[2],qr[1],C0,0,0,0),   P0[10],P0[11],P0[12],P0[13], pw1[0]=PKW(P0,8), pw1[1]=PKW(P0,10), pw1); \
    VRD(5); SBAR(); GAPA(C1=__builtin_amdgcn_mfma_f32_32x32x16_bf16(kf[3],qr[1],C1,0,0,0),   P0[14],P0[15],P1[0],P1[1],   pw1[2]=PKW(P0,12),pw1[3]=PKW(P0,14), pw1); \
    VRD(2); SBAR(); GAPA(C0=__builtin_amdgcn_mfma_f32_32x32x16_bf16(kf[4],qr[2],C0,0,0,0),   P1[2],P1[3],P1[4],P1[5],     pw2[0]=PKW(P1,0), pw2[1]=PKW(P1,2), pw2); \
    VRD(6); SBAR(); GAPA(C1=__builtin_amdgcn_mfma_f32_32x32x16_bf16(kf[5],qr[2],C1,0,0,0),   P1[6],P1[7],P1[8],P1[9],     pw2[2]=PKW(P1,4), pw2[3]=PKW(P1,6), pw2); \
    VRD(3); SBAR(); GAPA(C0=__builtin_amdgcn_mfma_f32_32x32x16_bf16(kf[6],qr[3],C0,0,0,0),   P1[10],P1[11],P1[12],P1[13], pw3[0]=PKW(P1,8), pw3[1]=PKW(P1,10), pw3); \
    VRD(7); SBAR(); GAPA(C1=__builtin_amdgcn_mfma_f32_32x32x16_bf16(kf[7],qr[3],C1,0,0,0),   P1[14],P1[15],0.f,0.f,       pw3[2]=PKW(P1,12),pw3[3]=PKW(P1,14), pw3); \
    l_reg+=sacc; \
    if(GK){DMA_K((t)+3,sl_cur);} if(GV){DMA_V((t)+1,sl_next);} \
    CMASK(C0,C1,t); \
    { float a=MX3(C0[0],C0[1],C1[0]),b=MX3(C0[2],C0[3],C1[1]); a=MX3(a,C1[2],C1[3]); \
      _Pragma("unroll") for(int r=4;r<16;r+=4){a=MX3(a,C0[r],C0[r+1]);b=MX3(b,C0[r+2],C0[r+3]);a=MX3(a,C1[r],C1[r+1]);b=MX3(b,C1[r+2],C1[r+3]);} \
      float rm=__builtin_fmaxf(a,b); { auto rr=__builtin_amdgcn_permlane32_swap(__float_as_uint(rm),__float_as_uint(rm),false,false); rm=__builtin_fmaxf(__uint_as_float(rr[0]),__uint_as_float(rr[1])); } \
      resc=false; \
      if(__builtin_expect(__any(rm>(float)THRL),0)){ const float dl=__builtin_fmaxf(rm,0.f); mhat+=dl; \
        _Pragma("unroll") for(int r=0;r<16;++r){C0[r]-=dl;C1[r]-=dl;} \
        _Pragma("unroll") for(int r=0;r<16;++r)negm[r]=-mhat; asm volatile("":"+v"(negm)); \
        const float f=__builtin_amdgcn_exp2f(-dl); l_reg*=f; if(hi==0)wsf[r32]=f; resc=true; } } \
    SBAR(); \
    GAPB(o[0]=__builtin_amdgcn_mfma_f32_32x32x16_bf16(PAF(0),VFR(0),o[0],0,0,0), C0,0); \
    GAPB(o[1]=__builtin_amdgcn_mfma_f32_32x32x16_bf16(PAF(0),VFR(4),o[1],0,0,0), C0,4); \
    KRD(GL,0); GAPB(o[0]=__builtin_amdgcn_mfma_f32_32x32x16_bf16(PAF(1),VFR(1),o[0],0,0,0), C0,8); \
    KRD(GL,1); GAPB(o[1]=__builtin_amdgcn_mfma_f32_32x32x16_bf16(PAF(1),VFR(5),o[1],0,0,0), C0,12); \
    KRD(GL,2); GAPB(o[0]=__builtin_amdgcn_mfma_f32_32x32x16_bf16(PAF(2),VFR(2),o[0],0,0,0), C1,0); \
    KRD(GL,3); GAPB(o[1]=__builtin_amdgcn_mfma_f32_32x32x16_bf16(PAF(2),VFR(6),o[1],0,0,0), C1,4); \
    GAPB(o[0]=__builtin_amdgcn_mfma_f32_32x32x16_bf16(PAF(3),VFR(3),o[0],0,0,0), C1,8); \
    GAPB(o[1]=__builtin_amdgcn_mfma_f32_32x32x16_bf16(PAF(3),VFR(7),o[1],0,0,0), C1,12); \
    }while(0)
  int t=1;
  #undef CMASK
  #define CMASK(P0,P1,t) do{}while(0)
  for(;t+5<NT;t+=2){
    STEP(pB0,pB1,pA0,pA1,t,true,true,true);     WAIT_BAR(2); RESC(); ROT();
    STEP(pA0,pA1,pB0,pB1,t+1,true,true,true);   WAIT_BAR(2); RESC(); ROT();
  }
  #undef CMASK
  #define CMASK(P0,P1,t) do{}while(0)
  #define ENDW(tt) do{ if((tt)+3<NT){WAIT_BAR(2);} else if((tt)+2<NT){WAIT_BAR(1);} else {WAIT_BAR(0);} }while(0)
  for(;t+1<NT;t+=2){
    STEP(pB0,pB1,pA0,pA1,t,(t+3<NT),(t+1<NT),(t+1<NT));       ENDW(t);   RESC(); ROT();
    STEP(pA0,pA1,pB0,pB1,t+1,(t+4<NT),(t+2<NT),(t+2<NT));     ENDW(t+1); RESC(); ROT();
  }
  STEP(pB0,pB1,pA0,pA1,NT-1,false,false,false); RESC();
  { float sacc=pB0[0]+pB0[1]; _Pragma("unroll") for(int r=2;r<16;++r)sacc+=pB0[r]; _Pragma("unroll") for(int r=0;r<16;++r)sacc+=pB1[r]; l_reg+=sacc;
    pw0=(u32x4){PKW(pB0,0),PKW(pB0,2),PKW(pB0,4),PKW(pB0,6)};pw1=(u32x4){PKW(pB0,8),PKW(pB0,10),PKW(pB0,12),PKW(pB0,14)};pw2=(u32x4){PKW(pB1,0),PKW(pB1,2),PKW(pB1,4),PKW(pB1,6)};pw3=(u32x4){PKW(pB1,8),PKW(pB1,10),PKW(pB1,12),PKW(pB1,14)};
    SBAR(); pv(o,vb0+sl_cur,PAF(0),PAF(1),PAF(2),PAF(3)); }
  #undef PKW
  #undef PAF
  #undef VFR
  #undef PIN
  #undef MX3
  #undef GAPA
  #undef GAPB
  #undef EX
  #undef VRD
  #undef KRD
  #undef STEP
  #undef ENDW
  {auto rr=__builtin_amdgcn_permlane32_swap(__float_as_uint(l_reg),__float_as_uint(l_reg),false,false);l_reg=__uint_as_float(rr[0])+__uint_as_float(rr[1]);}
  if(hi==0)wsf[32+r32]=l_reg;asm volatile("s_waitcnt lgkmcnt(0)":::"memory");
  float rli[16];
  #pragma unroll
  for(int r=0;r<16;++r)rli[r]=__builtin_amdgcn_rcpf(wsf[32+crow(r,hi)]);
  bf16*Ow=O+(rowbase+q0+wid*QBLK)*PO+OCOL+h*D;
  { bf16*stg=(bf16*)(shm+LDS_OST)+wid*2048;
    #pragma unroll
    for(int r=0;r<16;++r){const int orow=crow(r,hi);
      #pragma unroll
      for(int d0=0;d0<2;++d0)stg[orow*64+d0*32+r32]=__float2bfloat16(o[d0][r]*rli[r]);}
    asm volatile("s_waitcnt lgkmcnt(0)":::"memory");
    #pragma unroll
    for(int i=0;i<4;++i){const int row=i*8+(lane>>3),ch=lane&7; const u32x4 v=*(const u32x4*)(stg+row*64+ch*8); ATTN_STORE16(Ow+(long)row*PO+ch*8,v);} }
  asm volatile("s_waitcnt lgkmcnt(0)\n\ts_barrier":::"memory");
  #undef DMA_K
  #undef DMA_V
  #undef CMASK
  #undef START
  #undef RESC
  #undef ROT
}
constexpr int ATTN_LDS_BYTES=LDS_BYTES;
struct AttnTensors { const bf16* Q; const bf16* K; const bf16* V; bf16* O; };
struct AttnUnit { int bh; int qb; };
struct StaticOrder {
  int x, j;
  __device__ __forceinline__ explicit StaticOrder(int grid,int block):x(block%8),j(block/8){}
  __device__ __forceinline__ bool next(int i,AttnUnit&u)const{ if(i>=2||j>=32)return false; const int uu=2*j+i; u.bh=(x>>1)*NHEAD+(x&1)*4+(uu>>4); u.qb=uu&15; return true; }
  __device__ __forceinline__ void a_ready(const AttnUnit&)const{}
  __device__ __forceinline__ void done(const AttnUnit&)const{}
};
template<class Sched,int THRL=8> __device__ __forceinline__ void attn_phase(char*lds,const AttnTensors&T,const Sched&S){
  AttnUnit u;
  for(int i=0;S.next(i,u);++i){ S.a_ready(u); attn_unit<THRL>(u.bh/NHEAD,u.bh%NHEAD,u.qb,T.Q,T.K,T.V,T.O,lds); S.done(u); }
}
#undef SBAR
#undef WAIT_BAR
}
namespace memattn {
using bf16 = __hip_bfloat16;
constexpr int   D = 128, NW = 8, QBLK = 32, KVBLK = 64;
constexpr float SCALE = 0.088388347648318440f;
constexpr float THR = 0.f;
constexpr int SDEPTH = 2;
constexpr int LDQ = 512, LDK = 512, LDO = 512;
constexpr size_t SHM_V = KVBLK * D * 2, SHM_K = KVBLK * D * 2, SHM_ATTN = 2 * SHM_V + 2 * SHM_K + NW * 64 * 4;
using bf16x8 = __attribute__((ext_vector_type(8))) short;
using s16x4  = __attribute__((ext_vector_type(4))) short;
using f32x16 = __attribute__((ext_vector_type(16))) float;
using f32x8  = __attribute__((ext_vector_type(8))) float;
using u32x4  = __attribute__((ext_vector_type(4))) unsigned;
#define KSWZ(row, colB) ((row) * 256 + ((colB) ^ (((row) & 7) << 4)))
#define SBAR() __builtin_amdgcn_sched_barrier(0)
__device__ __forceinline__ int crow(int r, int hi) { return (r & 3) + 8 * (r >> 2) + 4 * hi; }
__device__ __forceinline__ unsigned cvtpk(float lo, float hi) {
  unsigned r; asm volatile("v_cvt_pk_bf16_f32 %0, %1, %2" : "=v"(r) : "v"(lo), "v"(hi)); return r;
}
template <typename TIn> struct Stage;
template <> struct Stage<bf16>  { using T = bf16x8;
  __device__ static __forceinline__ T ld8(const bf16* p) { return *reinterpret_cast<const bf16x8*>(p); }
  __device__ static __forceinline__ bf16x8 tobf(T x) { return x; } };
template <> struct Stage<float> { using T = f32x8;
  __device__ static __forceinline__ T ld8(const float* p) { return *reinterpret_cast<const f32x8*>(p); }
  __device__ static __forceinline__ bf16x8 tobf(T x) {
    u32x4 w = {cvtpk(x[0], x[1]), cvtpk(x[2], x[3]), cvtpk(x[4], x[5]), cvtpk(x[6], x[7])}; return *reinterpret_cast<bf16x8*>(&w); } };

__device__ __forceinline__ void partialSM(f32x16& p0, f32x16& p1, float& m_reg, float& mn, float& alpha) {
  constexpr float C = SCALE * 1.4426950408889634f;
  float pmax = p0[0]; for (int r = 1; r < 16; ++r) pmax = fmaxf(pmax, p0[r]); for (int r = 0; r < 16; ++r) pmax = fmaxf(pmax, p1[r]);
  { auto rr = __builtin_amdgcn_permlane32_swap(__float_as_uint(pmax), __float_as_uint(pmax), false, false);
    pmax = fmaxf(__uint_as_float(rr[0]), __uint_as_float(rr[1])); }
  if (__builtin_expect(__all(pmax - m_reg <= THR / SCALE), 1)) { mn = m_reg; alpha = 1.f; }
  else { mn = fmaxf(m_reg, pmax); alpha = __builtin_amdgcn_exp2f((m_reg - mn) * C); m_reg = mn; }
  float mnC = -mn * C;
  for (int r = 0; r < 16; ++r) p0[r] = fmaf(p0[r], C, mnC); for (int r = 0; r < 16; ++r) p1[r] = fmaf(p1[r], C, mnC);
  for (int r = 0; r < 16; ++r) p0[r] = __builtin_amdgcn_exp2f(p0[r]);
}
__device__ __forceinline__ void finishSM(f32x16& p0, f32x16& p1, float alpha, float& l_reg, bf16x8& pa0, bf16x8& pa1, bf16x8& pa2, bf16x8& pa3) {
  for (int r = 0; r < 16; ++r) p1[r] = __builtin_amdgcn_exp2f(p1[r]);
  float ps = 0; for (int r = 0; r < 16; ++r) ps += p0[r]; for (int r = 0; r < 16; ++r) ps += p1[r];
  { auto rr = __builtin_amdgcn_permlane32_swap(__float_as_uint(ps), __float_as_uint(ps), false, false);
    ps = __uint_as_float(rr[0]) + __uint_as_float(rr[1]); }
  l_reg = l_reg * alpha + ps;
#define PK4(P, BASE, OUT) do { unsigned a0 = cvtpk(P[BASE + 0], P[BASE + 1]), a1 = cvtpk(P[BASE + 2], P[BASE + 3]);   \
    unsigned b0 = cvtpk(P[BASE + 4], P[BASE + 5]), b1 = cvtpk(P[BASE + 6], P[BASE + 7]);                              \
    auto r0 = __builtin_amdgcn_permlane32_swap(a0, b0, false, false); auto r1 = __builtin_amdgcn_permlane32_swap(a1, b1, false, false); \
    u32x4 w = {r0[0], r1[0], r0[1], r1[1]}; OUT = *reinterpret_cast<bf16x8*>(&w); } while (0)
  PK4(p0, 0, pa0); PK4(p0, 8, pa1); PK4(p1, 0, pa2); PK4(p1, 8, pa3);
#undef PK4
}
__device__ __forceinline__ void qkt(f32x16& p0, f32x16& p1, const bf16* Ks, const bf16x8* qr, int r32, int hi) {
  p0 = f32x16{}; p1 = f32x16{};
  for (int d0 = 0; d0 < 8; ++d0) { int cb = (d0 * 16 + hi * 8) * 2;
    bf16x8 b0 = *reinterpret_cast<const bf16x8*>((const char*)Ks + KSWZ(r32, cb));
    bf16x8 b1 = *reinterpret_cast<const bf16x8*>((const char*)Ks + KSWZ(32 + r32, cb));
    p0 = __builtin_amdgcn_mfma_f32_32x32x16_bf16(b0, qr[d0], p0, 0, 0, 0);
    p1 = __builtin_amdgcn_mfma_f32_32x32x16_bf16(b1, qr[d0], p1, 0, 0, 0); }
}
__device__ __forceinline__ int v_st(int k, int c) { const int kk = (k & ~0xC) | ((k & 4) << 1) | ((k & 8) >> 1); return ((kk >> 3) * 4 + (c >> 5)) * 512 + ((kk & 7) * 32 + (c & 31)) * 2; }
__device__ __forceinline__ int v_rd_base(int lane) { return ((lane & 3) << 3) | (((lane >> 2) & 3) << 6) | (((lane >> 4) & 1) << 5) | (((lane >> 5) & 1) << 8); }
constexpr int v_rd_off(int d0, int ks, int half) { return d0 * 512 + ks * 4096 + half * 2048; }
template <int OFF> __device__ __forceinline__ s16x4 tr_read(int vb) {
  s16x4 r; asm volatile("ds_read_b64_tr_b16 %0, %1 offset:%2" : "=&v"(r) : "v"(vb), "i"(OFF) : "memory"); return r;
}
template <int D0> __device__ __forceinline__ void pv_one(f32x16& od, int vb, bf16x8 pa0, bf16x8 pa1, bf16x8 pa2, bf16x8 pa3) {
  const s16x4 l0 = tr_read<v_rd_off(D0, 0, 0)>(vb), h0 = tr_read<v_rd_off(D0, 0, 1)>(vb), l1 = tr_read<v_rd_off(D0, 1, 0)>(vb), h1 = tr_read<v_rd_off(D0, 1, 1)>(vb);
  const s16x4 l2 = tr_read<v_rd_off(D0, 2, 0)>(vb), h2 = tr_read<v_rd_off(D0, 2, 1)>(vb), l3 = tr_read<v_rd_off(D0, 3, 0)>(vb), h3 = tr_read<v_rd_off(D0, 3, 1)>(vb);
  asm volatile("s_waitcnt lgkmcnt(0)" ::: "memory"); SBAR();
#define PK(L, H) (bf16x8){L[0], L[1], L[2], L[3], H[0], H[1], H[2], H[3]}
  od = __builtin_amdgcn_mfma_f32_32x32x16_bf16(pa0, PK(l0, h0), od, 0, 0, 0);
  od = __builtin_amdgcn_mfma_f32_32x32x16_bf16(pa1, PK(l1, h1), od, 0, 0, 0);
  od = __builtin_amdgcn_mfma_f32_32x32x16_bf16(pa2, PK(l2, h2), od, 0, 0, 0);
  od = __builtin_amdgcn_mfma_f32_32x32x16_bf16(pa3, PK(l3, h3), od, 0, 0, 0);
#undef PK
}
__device__ __forceinline__ void pv_d0(f32x16* o, int vb, bf16x8 pa0, bf16x8 pa1, bf16x8 pa2, bf16x8 pa3) {
  pv_one<0>(o[0], vb, pa0, pa1, pa2, pa3); pv_one<1>(o[1], vb, pa0, pa1, pa2, pa3); pv_one<2>(o[2], vb, pa0, pa1, pa2, pa3); pv_one<3>(o[3], vb, pa0, pa1, pa2, pa3);
}

template <typename TQ>
__device__ __forceinline__ void attn_dense_body(const TQ* __restrict__ Qb, const bf16* __restrict__ Kh, const bf16* __restrict__ Vh,
                                                bf16* __restrict__ Ob, int seq, char* lds) {
  using St = Stage<bf16>; using SQ = Stage<TQ>;
  int tid_ = threadIdx.x; asm volatile("" : "+v"(tid_));
  const int tid = tid_, wid = tid >> 6, lane = tid & 63, r32 = lane & 31, hi = lane >> 5;
  bf16* V_lds = (bf16*)lds; bf16* K_lds = (bf16*)(lds + 2 * SHM_V);
  float* ws = (float*)(lds + 2 * SHM_V + 2 * SHM_K) + wid * 64; float* li_l = ws; float* al_l = ws + 32;
  float m_reg = -1e30f, l_reg = 0; f32x16 o[4] = {}; bf16x8 qr[8];
  const TQ* Qw = Qb + (long)(wid * QBLK + r32) * LDQ + hi * 8;
#pragma unroll
  for (int d0 = 0; d0 < 8; ++d0) qr[d0] = SQ::tobf(SQ::ld8(Qw + d0 * 16));
  const int sr = tid >> 4, sc = (tid & 15) * 8, vst0 = v_st(sr, sc), vst1 = v_st(32 + sr, sc);
  const int vb0 = (int)(uintptr_t)V_lds + v_rd_base(lane);
  struct { typename St::T vs0, vs1, ks0, ks1; } sr_[SDEPTH];
#define SLOAD(i, k0) do { sr_[i].vs0 = St::ld8(&Vh[(long)((k0) + sr) * LDK + sc]); sr_[i].vs1 = St::ld8(&Vh[(long)((k0) + 32 + sr) * LDK + sc]); \
    sr_[i].ks0 = St::ld8(&Kh[(long)((k0) + sr) * LDK + sc]); sr_[i].ks1 = St::ld8(&Kh[(long)((k0) + 32 + sr) * LDK + sc]); } while (0)
#define SWRITE(b, i) do { *(bf16x8*)((char*)V_lds + (b) * SHM_V + vst0) = St::tobf(sr_[i].vs0);          \
    *(bf16x8*)((char*)V_lds + (b) * SHM_V + vst1) = St::tobf(sr_[i].vs1); int kc = sc * 2;               \
    *(bf16x8*)((char*)K_lds + (b) * SHM_K + KSWZ(sr, kc)) = St::tobf(sr_[i].ks0);                       \
    *(bf16x8*)((char*)K_lds + (b) * SHM_K + KSWZ(32 + sr, kc)) = St::tobf(sr_[i].ks1); } while (0)
#define SWAIT() do { if constexpr (SDEPTH == 2) asm volatile("s_waitcnt vmcnt(4)" ::: "memory"); else asm volatile("s_waitcnt vmcnt(0)" ::: "memory"); } while (0)
#define RESC(a) do { if (__any((a) < 1.f)) { if (hi == 0) al_l[r32] = (a); asm volatile("s_waitcnt lgkmcnt(0)" ::: "memory"); \
    for (int d = 0; d < 4; ++d) for (int r = 0; r < 16; ++r) o[d][r] *= al_l[crow(r, hi)]; } } while (0)
  f32x16 pA0, pA1, pB0, pB1; float mnA, mnB, alA, alB; bf16x8 pa0, pa1, pa2, pa3; const int NT = seq / KVBLK;
  constexpr int SE = 0, SO = SDEPTH - 1;
  SLOAD(SE, 0); asm volatile("s_waitcnt vmcnt(0)" ::: "memory"); SWRITE(0, SE); __syncthreads();
  qkt(pA0, pA1, K_lds, qr, r32, hi); partialSM(pA0, pA1, m_reg, mnA, alA);
  SLOAD(SO, KVBLK); if constexpr (SDEPTH == 2) { if (2 < NT) SLOAD(SE, 2 * KVBLK); }
  SWAIT(); SWRITE(1, SO); __syncthreads();
  for (int j = 1; j + 1 < NT; j += 2) {
    SBAR(); qkt(pB0, pB1, (bf16*)((char*)K_lds + SHM_K), qr, r32, hi);
    finishSM(pA0, pA1, alA, l_reg, pa0, pa1, pa2, pa3); SBAR();
    SLOAD(SO, (j + SDEPTH) * KVBLK); SBAR();
    pv_d0(o, vb0, pa0, pa1, pa2, pa3); partialSM(pB0, pB1, m_reg, mnB, alB);
    __syncthreads(); SWAIT(); SWRITE(0, SE);
    RESC(alB); __syncthreads();
    SBAR(); qkt(pA0, pA1, K_lds, qr, r32, hi);
    finishSM(pB0, pB1, alB, l_reg, pa0, pa1, pa2, pa3); SBAR();
    if (SDEPTH == 1 || j + 3 < NT) SLOAD(SE, (j + 1 + SDEPTH) * KVBLK); SBAR();
    pv_d0(o, vb0 + (int)SHM_V, pa0, pa1, pa2, pa3); partialSM(pA0, pA1, m_reg, mnA, alA);
    __syncthreads(); SWAIT(); SWRITE(1, SO);
    RESC(alA); __syncthreads();
  }
  SBAR(); qkt(pB0, pB1, (bf16*)((char*)K_lds + SHM_K), qr, r32, hi);
  finishSM(pA0, pA1, alA, l_reg, pa0, pa1, pa2, pa3); SBAR();
  pv_d0(o, vb0, pa0, pa1, pa2, pa3); partialSM(pB0, pB1, m_reg, mnB, alB);
  __syncthreads(); RESC(alB);
  finishSM(pB0, pB1, alB, l_reg, pa0, pa1, pa2, pa3); SBAR();
  pv_d0(o, vb0 + (int)SHM_V, pa0, pa1, pa2, pa3);
  if (hi == 0) li_l[r32] = l_reg; asm volatile("s_waitcnt lgkmcnt(0)" ::: "memory");
  float rli[16];
#pragma unroll
  for (int r = 0; r < 16; ++r) rli[r] = __builtin_amdgcn_rcpf(li_l[crow(r, hi)]);
  bf16* Ow = Ob + (long)(wid * QBLK) * LDO;
#pragma unroll
  for (int r = 0; r < 16; ++r) { int orow = crow(r, hi);
    for (int d0 = 0; d0 < 4; ++d0) Ow[(long)orow * LDO + d0 * 32 + r32] = __float2bfloat16(o[d0][r] * rli[r]); }
#undef SLOAD
#undef SWRITE
#undef SWAIT
#undef RESC
}

#undef KSWZ
#undef SBAR
}
namespace na_body {
typedef short bf16x8 __attribute__((ext_vector_type(8)));
typedef short s16x4 __attribute__((ext_vector_type(4)));
typedef float f32x4 __attribute__((ext_vector_type(4)));
typedef unsigned u32x2 __attribute__((ext_vector_type(2)));
typedef unsigned short bf16;
#define NA_LAS __attribute__((address_space(3)))
constexpr int SLOT = 8192, NSLOT = 9, LDS_K = 0, LDS_V = NSLOT * SLOT, LDS_TBL = 2 * NSLOT * SLOT, NA_LDS_BYTES = LDS_TBL + 4096;
__device__ __forceinline__ s16x4 vtr(const NA_LAS unsigned char* p) { typedef short v4i16_t __attribute__((ext_vector_type(4)));
  return __builtin_bit_cast(s16x4, __builtin_amdgcn_ds_read_tr16_b64_v4i16((NA_LAS v4i16_t*)p)); }
__device__ __forceinline__ void na_unit(int b, int h, int r0, const bf16* NQ, const bf16* NK, const bf16* NV, bf16* OC, const float* rpb_h, NA_LAS unsigned char* L) {
  int tid_ = threadIdx.x; asm volatile("" : "+v"(tid_));
  const int tid = tid_, lane = tid & 63; const int wid = __builtin_amdgcn_readfirstlane(tid >> 6);
  const int kr0 = min(max(r0 - 4, 0), 56), rs1 = min(max(r0 - 3, 0), 56), nrows = rs1 + 8 - kr0;
  asm volatile("s_waitcnt lgkmcnt(0)\n\ts_barrier" ::: "memory");
  const unsigned lds0 = (unsigned)(uintptr_t)L;
  {
    const size_t tok0 = (size_t)b * 4096 + kr0 * 64;
    const bf16* ksrc = NK + (tok0 + lane) * 512 + h * 64 + wid * 8;
    const bf16* vsrc = NV + (tok0 + 16 * (wid & 3) + (lane >> 2)) * 512 + h * 64 + (wid >> 2) * 32 + (lane & 3) * 8;
    for (int s = 0; s < nrows; ++s) {
      attn_body::glds16(ksrc + (size_t)s * 64 * 512, (unsigned)__builtin_amdgcn_readfirstlane(lds0 + LDS_K + s * SLOT + wid * 1024));
      attn_body::glds16(vsrc + (size_t)s * 64 * 512, (unsigned)__builtin_amdgcn_readfirstlane(lds0 + LDS_V + s * SLOT + wid * 1024));
    }
  }
  NA_LAS float* tbl = (NA_LAS float*)(L + LDS_TBL);
  for (int i = tid; i < 960; i += 512) { const int ro = i >> 6, co = (i & 63) - 16; tbl[i] = (co >= 0 && co < 31) ? rpb_h[ro * 31 + co] * 1.4426950408889634f : 0.f; }
  const int qr = wid >> 2, cb = wid & 3, r = r0 + qr, c0 = 16 * cb, kc0 = min(max(c0 - 8, 0), 32);
  const int ql = lane & 15, g = lane >> 4;
  const int rsr = min(max(r - 4, 0), 56), so = rsr - kr0, ro0 = rsr - r + 7;
  const size_t tokq = (size_t)b * 4096 + r * 64 + c0 + ql;
  bf16x8 qf[2];
#pragma unroll
  for (int ks = 0; ks < 2; ++ks) qf[ks] = *(const bf16x8*)(NQ + tokq * 512 + h * 64 + 32 * ks + 8 * g);
  asm volatile("s_waitcnt vmcnt(0) lgkmcnt(0)\n\ts_barrier" ::: "memory");
  const NA_LAS unsigned char* kb = L + LDS_K + so * SLOT + g * 1024 + (kc0 + ql) * 16;
  f32x4 s[8][2];
#pragma unroll
  for (int i = 0; i < 8; ++i)
#pragma unroll
    for (int sb = 0; sb < 2; ++sb) { f32x4 a = {0.f, 0.f, 0.f, 0.f};
#pragma unroll
      for (int ks = 0; ks < 2; ++ks) { const bf16x8 kf = *(const NA_LAS bf16x8*)(kb + i * SLOT + ks * 4096 + sb * 256); a = __builtin_amdgcn_mfma_f32_16x16x32_bf16(kf, qf[ks], a, 0, 0, 0); }
      s[i][sb] = a; }
  const int c = c0 + ql, cs = min(max(c - 8, 0), 48), e0 = kc0 + 4 * g - cs;
  const NA_LAS float* tb = tbl + ro0 * 64 + (kc0 - c0 + 4 * g - ql + 31);
  float m = -1e30f;
#pragma unroll
  for (int i = 0; i < 8; ++i)
#pragma unroll
    for (int sb = 0; sb < 2; ++sb)
#pragma unroll
      for (int j = 0; j < 4; ++j) { const int e = e0 + 16 * sb + j; float v = s[i][sb][j] + tb[i * 64 + sb * 16 + j]; v = ((unsigned)e < 16u) ? v : -1e30f; s[i][sb][j] = v; m = fmaxf(m, v); }
  m = fmaxf(m, __shfl_xor(m, 16)); m = fmaxf(m, __shfl_xor(m, 32));
  float l = 0.f;
#pragma unroll
  for (int i = 0; i < 8; ++i)
#pragma unroll
    for (int sb = 0; sb < 2; ++sb)
#pragma unroll
      for (int j = 0; j < 4; ++j) { const float p = __builtin_amdgcn_exp2f(s[i][sb][j] - m); s[i][sb][j] = p; l += p; }
  l += __shfl_xor(l, 16); l += __shfl_xor(l, 32);
  const NA_LAS unsigned char* vb = L + LDS_V + so * SLOT + (kc0 + 4 * g + ((lane & 15) >> 2)) * 64 + (lane & 3) * 8;
  f32x4 o[4];
#pragma unroll
  for (int d = 0; d < 4; ++d) o[d] = (f32x4){0.f, 0.f, 0.f, 0.f};
#pragma unroll
  for (int i = 0; i < 8; ++i) {
    typedef unsigned u32x4_t __attribute__((ext_vector_type(4)));
    u32x4_t pw; pw.x = pg8::cvt_pk_bf16(s[i][0][0], s[i][0][1]); pw.y = pg8::cvt_pk_bf16(s[i][0][2], s[i][0][3]); pw.z = pg8::cvt_pk_bf16(s[i][1][0], s[i][1][1]); pw.w = pg8::cvt_pk_bf16(s[i][1][2], s[i][1][3]);
    const bf16x8 pf = __builtin_bit_cast(bf16x8, pw);
#pragma unroll
    for (int d = 0; d < 4; ++d) { const NA_LAS unsigned char* p = vb + i * SLOT + (d >> 1) * 4096 + (d & 1) * 32;
      const s16x4 lo = vtr(p), hi = vtr(p + 16 * 64);
      const bf16x8 vf = (bf16x8){lo[0], lo[1], lo[2], lo[3], hi[0], hi[1], hi[2], hi[3]};
      o[d] = __builtin_amdgcn_mfma_f32_16x16x32_bf16(vf, pf, o[d], 0, 0, 0); }
  }
  const float rl = 1.0f / l;
  bf16* op = OC + tokq * 1024 + h * 64 + 4 * g;
#pragma unroll
  for (int d = 0; d < 4; ++d) { u32x2 w; w.x = pg8::cvt_pk_bf16(o[d][0] * rl, o[d][1] * rl); w.y = pg8::cvt_pk_bf16(o[d][2] * rl, o[d][3] * rl); *(u32x2*)(op + 16 * d) = w; }
}
}
#define GAS __attribute__((address_space(1)))
#define LAS __attribute__((address_space(3)))
typedef unsigned short bf16;
typedef unsigned v4u __attribute__((ext_vector_type(4)));
typedef float f32x4 __attribute__((ext_vector_type(4)));
typedef short bf16x8 __attribute__((ext_vector_type(8)));
typedef GAS unsigned gu32;
typedef GAS unsigned long long gu64;
#define RLX_AGENT __ATOMIC_RELAXED, __HIP_MEMORY_SCOPE_AGENT
#define LDS_WAIT() asm volatile("s_waitcnt lgkmcnt(0)" ::: "memory")
#define VM_WAIT() asm volatile("s_waitcnt vmcnt(0)" ::: "memory")
__device__ __forceinline__ unsigned long long rt() { return __builtin_amdgcn_s_memrealtime(); }
__device__ __forceinline__ unsigned f2bf(float f) { unsigned u = __builtin_bit_cast(unsigned, f); return (u + 0x7fffu + ((u >> 16) & 1u)) >> 16; }
__device__ __forceinline__ unsigned pk2(float lo, float hi) { return f2bf(lo) | (f2bf(hi) << 16); }

#define XB_TMO      128
#define XB_XCNT(j)  (256  + 64 * (j))
#define XB_XSUB(j)  (1280 + 64 * (j))
#define XB_XGEN(j)  (2304 + 64 * (j))
#define XB_TOP      3328
#define XB_TOPGEN   3392
#define XCD_BAR_WORDS 3456
#define XB_SPIN_CAP (1u << 18)

__device__ __forceinline__ unsigned xb_ld(unsigned* p)              { return __hip_atomic_load(p, __ATOMIC_RELAXED, __HIP_MEMORY_SCOPE_AGENT); }
__device__ __forceinline__ unsigned xb_add(unsigned* p, unsigned v) { return __hip_atomic_fetch_add(p, v, __ATOMIC_RELAXED, __HIP_MEMORY_SCOPE_AGENT); }
__device__ __forceinline__ unsigned xb_xcc_id() { return (unsigned)__builtin_amdgcn_s_getreg((3 << 11) | 20) & 0xFu; }
#define XB_SPIN(cond, bar) do { unsigned _sp = 0; while (cond) { __builtin_amdgcn_s_sleep(1); \
    if ((++_sp & 255u) == 0u) { if (xb_ld(&(bar)[XB_TMO])) break; if (_sp > XB_SPIN_CAP) { atomicAdd(&(bar)[XB_TMO], 1u); break; } } } } while (0)

struct XcdBarrier {
    unsigned* bar; unsigned x;
    volatile LAS unsigned* st;
};

__device__ __forceinline__ XcdBarrier xcd_barrier_post(unsigned* bar, volatile LAS unsigned* st) {
    XcdBarrier b; b.bar = bar; b.x = xb_xcc_id(); b.st = st;
    if (threadIdx.x == 0) (void)xb_add(&bar[XB_XCNT(b.x)], 1u);
    return b;
}
__device__ __forceinline__ void xcd_barrier_complete(unsigned* bar, unsigned x, unsigned& nloc, unsigned& nx) {
    const unsigned G = gridDim.x * gridDim.y * gridDim.z;
    unsigned sum, cnt, mine, sp = 0u;
    for (;;) {
        sum = 0u; cnt = 0u; mine = 0u;
#pragma unroll
        for (unsigned j = 0; j < 16; ++j) { const unsigned c = xb_ld(&bar[XB_XCNT(j)]); sum += c; cnt += (c > 0u) ? 1u : 0u; mine = (j == x) ? c : mine; }
        if (sum == G) break;
        __builtin_amdgcn_s_sleep(1);
        if ((++sp & 255u) == 0u) { if (xb_ld(&bar[XB_TMO])) break; if (sp > XB_SPIN_CAP) { atomicAdd(&bar[XB_TMO], 1u); break; } }
    }
    nloc = mine > 0u ? mine : 1u; nx = cnt > 0u ? cnt : 1u;
}

__device__ __forceinline__ void xcd_barrier(const XcdBarrier& b) {
    asm volatile("s_waitcnt vmcnt(0)" ::: "memory");
    __syncthreads();
    if (threadIdx.x == 0) {
        unsigned* bar = b.bar;
        __builtin_amdgcn_s_waitcnt(0);
        unsigned nloc = b.st[0], nx = b.st[1];
        if (nloc == 0u) { xcd_barrier_complete(bar, b.x, nloc, nx); b.st[0] = nloc; b.st[1] = nx; }
        const unsigned old = xb_add(&bar[XB_XSUB(b.x)], 1u);
        const unsigned gen = old / nloc;
        if (old + 1u == (gen + 1u) * nloc) {
            __builtin_amdgcn_fence(__ATOMIC_RELEASE, "agent");
            asm volatile("s_waitcnt vmcnt(0)" ::: "memory");
            const unsigned og = xb_add(&bar[XB_TOP], 1u);
            const unsigned tg = og / nx;
            if (og + 1u == (tg + 1u) * nx) xb_add(&bar[XB_TOPGEN], 1u);
            else XB_SPIN(xb_ld(&bar[XB_TOPGEN]) == tg, bar);
            __builtin_amdgcn_fence(__ATOMIC_ACQUIRE, "agent");
            xb_add(&bar[XB_XGEN(b.x)], 1u);
            asm volatile("s_waitcnt vmcnt(0)" ::: "memory");
        } else {
            XB_SPIN(xb_ld(&bar[XB_XGEN(b.x)]) == gen, bar);
            __builtin_amdgcn_fence(__ATOMIC_ACQUIRE, "agent");
            asm volatile("s_waitcnt vmcnt(0)" ::: "memory");
        }
    }
    __syncthreads();
}
#ifndef NAIVE_GQA
#define NAIVE_GQA 0
#endif
#ifndef NAIVE_NA
#define NAIVE_NA 0
#endif
#ifndef NAIVE_MEM
#define NAIVE_MEM 0
#endif
#ifndef PG8_SP2
#define PG8_SP2 true
#endif
#ifndef PG8_ALIGN
#define PG8_ALIGN true
#endif

constexpr int NB = 4, SEQ = 4096, D = 1024, T = NB * SEQ;
constexpr int GW = 64;
constexpr int NINW = 2304, NAW = 512, GQW = 512, KVW = 128;
constexpr int MEML = 256, MEMT = NB * MEML, MEMW = 512;
constexpr int DFF = 2816, DFF2 = 5632;
constexpr float LOG2E = 1.4426950408889634f;
constexpr float QS_NA = 0.125f * LOG2E;
constexpr float QS_G = 0.125f * LOG2E;
constexpr float QS_M = 0.08838834764831845f * LOG2E;
constexpr int NTHREADS = 512, NWAVES = 8;

constexpr size_t MiB = 1u << 20;
constexpr size_t WS_CTL = 0, CTL_ZERO_BYTES = 1 * MiB;
constexpr size_t WS_ROPE = 1 * MiB, WS_SS = 2 * MiB, WS_MSS = 3 * MiB;
constexpr size_t WS_WIN = 4 * MiB, WS_WOUT = 13 * MiB, WS_WMQ = 17 * MiB, WS_WMKV = 19 * MiB, WS_WMO = 23 * MiB, WS_WUP = 25 * MiB, WS_WDN = 47 * MiB;
constexpr size_t WS_XB = 58 * MiB, WS_MXB = 90 * MiB, WS_MKV = 92 * MiB;
constexpr size_t WS_R = 96 * MiB;
constexpr size_t WS_NQ = WS_R, WS_NK = WS_R + 16 * MiB, WS_NV = WS_R + 32 * MiB, WS_GQ = WS_R + 48 * MiB, WS_GK = WS_R + 64 * MiB, WS_GV = WS_R + 68 * MiB, WS_OC = WS_R + 72 * MiB;
constexpr size_t WS_QM = WS_R, WS_OM = WS_R + 16 * MiB;
constexpr size_t WS_EDGE = WS_R, WS_ACT = WS_R + 64 * MiB, WS_END = 256 * MiB;
static_assert(WS_ACT + (size_t)T * DFF * 2 <= WS_END, "ws map");
constexpr int CW_BAR = 4096;

constexpr int RING_OFF = 0, RING_BYTES = 131072;
constexpr int LDSCTL_OFF = 151552, MISC_OFF = LDSCTL_OFF + 320;
constexpr int LDS_BYTES = 155648;

__device__ __forceinline__ float wave_sum(float v) {
#pragma unroll
    for (int o = 1; o < 64; o <<= 1) v += __shfl_xor(v, o);
    return v;
}
__device__ __forceinline__ float wave_max(float v) {
#pragma unroll
    for (int o = 1; o < 64; o <<= 1) v = fmaxf(v, __shfl_xor(v, o));
    return v;
}
__device__ __forceinline__ float bf_lo(unsigned w) { return __uint_as_float(w << 16); }
__device__ __forceinline__ float bf_hi(unsigned w) { return __uint_as_float(w & 0xffff0000u); }
__device__ __forceinline__ float bf2f(bf16 h) { return __uint_as_float((unsigned)h << 16); }
__device__ __forceinline__ float rdlane(float v, int l) { return __int_as_float(__builtin_amdgcn_readlane(__float_as_int(v), l)); }

__device__ __forceinline__ int rowmap(int kind, int n) {
    if (kind == 1) {
        if (n < 1536) return n;
        int pn, wc;
        if (n < 2048) { const int hh = (n - 1536) >> 6; pn = 6 + (hh >> 2); wc = hh & 3; }
        else if (n < 2176) { pn = 8; wc = (n - 2048) >> 6; }
        else { pn = 8; wc = 2 + ((n - 2176) >> 6); }
        const int d = n & 63, bj = d >> 5, nn = (d >> 4) & 1, fq = (d >> 2) & 3, e = d & 3;
        return 256 * pn + 128 * bj + 32 * wc + 8 * fq + 4 * nn + e;
    }
    if (kind == 2) { if (n < DFF) return 256 * (n >> 7) + (n & 127); const int ch = n - DFF; return 256 * (ch >> 7) + 128 + (ch & 127); }
    return n;
}
__device__ __forceinline__ void p0_transpose_item(const float* W, int K, int N, const float* gain, int kind, bf16* WT, LAS float* scr, int item, int lane) {
    const int nblk = N / 64, kb = item / nblk, nb = item % nblk, k0 = 64 * kb, n0 = 64 * nb;
    const float* src = W + (size_t)(k0 + (lane >> 4)) * N + n0 + 4 * (lane & 15);
    LAS float* dst = scr + (lane >> 4) * 65 + 4 * (lane & 15);
#pragma unroll 8
    for (int i = 0; i < 16; ++i) { const f32x4 v = *(const f32x4*)(src + (size_t)(4 * i) * N); LAS float* d = dst + 4 * i * 65; d[0] = v[0]; d[1] = v[1]; d[2] = v[2]; d[3] = v[3]; }
    LDS_WAIT(); asm volatile("" ::: "memory");
    const int c = lane & 7;
    f32x4 g0 = {1.f, 1.f, 1.f, 1.f}, g1 = g0;
    if (gain) { g0 = *(const f32x4*)(gain + k0 + 8 * c); g1 = *(const f32x4*)(gain + k0 + 8 * c + 4); }
#pragma unroll
    for (int j = 0; j < 8; ++j) { const int n = (lane >> 3) + 8 * j; const LAS float* s = scr + (8 * c) * 65 + n;
        v4u o; o.x = pk2(s[0 * 65] * g0[0], s[1 * 65] * g0[1]); o.y = pk2(s[2 * 65] * g0[2], s[3 * 65] * g0[3]); o.z = pk2(s[4 * 65] * g1[0], s[5 * 65] * g1[1]); o.w = pk2(s[6 * 65] * g1[2], s[7 * 65] * g1[3]);
        *(GAS v4u*)(WT + (size_t)rowmap(kind, n0 + n) * K + k0 + 8 * c) = o; }
    LDS_WAIT(); asm volatile("" ::: "memory");
}
constexpr int I_IN = 16 * (NINW / 64), I_OUT = 16 * 16, I_MQ = 16 * 8, I_MKV = 16 * 16, I_MO = 8 * 16, I_UP = 16 * (DFF2 / 64), I_DN = 44 * 16;
constexpr int I_L = I_IN + I_OUT + I_MQ + I_MKV + I_MO + I_UP + I_DN;
__device__ __forceinline__ void row_to_bf16_ss(const float* xrow, bf16* orow, float* ssrow, int lane) {
    const GAS f32x4* xr = (const GAS f32x4*)xrow + lane;
    f32x4 v[4]; float s = 0.f;
#pragma unroll
    for (int j = 0; j < 4; ++j) { v[j] = xr[64 * j]; s += (v[j].x * v[j].x + v[j].y * v[j].y) + (v[j].z * v[j].z + v[j].w * v[j].w); }
    s = wave_sum(s);
    GAS unsigned long long* o8 = (GAS unsigned long long*)orow + lane;
#pragma unroll
    for (int j = 0; j < 4; ++j) o8[64 * j] = (unsigned long long)pk2(v[j].x, v[j].y) | ((unsigned long long)pk2(v[j].z, v[j].w) << 32);
    if (lane < 16) ssrow[lane] = lane == 0 ? s : 0.f;
}

struct Args { const float* in[19]; float* out; unsigned char* ws; };

__device__ __forceinline__ void na_naive(const bf16* NQ, const bf16* NK, const bf16* NV, bf16* OC, const float* rpb, int gw, int NGW, int lane) {
    for (int task = gw; task < T * 8; task += NGW) {
        const int h = task & 7, t = task >> 3;
        const int b = t >> 12, r = (t >> 6) & 63, c = t & 63;
        const int rs = min(max(r - 4, 0), 56), cs = min(max(c - 8, 0), 48);
        const float q = bf2f(NQ[(size_t)t * 512 + h * 64 + lane]);
        float s[2];
#pragma unroll
        for (int half = 0; half < 2; ++half) {
            const int kk = lane + 64 * half, i = kk >> 4, jj = kk & 15;
            const int tk = (b << 12) + ((rs + i) << 6) + cs + jj;
            const v4u* kp = (const v4u*)(NK + (size_t)tk * 512 + h * 64);
            v4u kv[8];
#pragma unroll
            for (int j = 0; j < 8; ++j) kv[j] = kp[j];
            float a = 0.f;
#pragma unroll
            for (int d = 0; d < 64; d += 2) { const unsigned w = kv[d >> 3][(d >> 1) & 3]; a += rdlane(q, d) * bf_lo(w) + rdlane(q, d + 1) * bf_hi(w); }
            s[half] = a + rpb[(h * 15 + (rs + i - r + 7)) * 31 + (cs + jj - c + 15)] * LOG2E;
        }
        const float m = wave_max(fmaxf(s[0], s[1]));
        const float p0 = exp2f(s[0] - m), p1 = exp2f(s[1] - m);
        const float l = wave_sum(p0 + p1);
        float o = 0.f;
        for (int kk = 0; kk < 64; ++kk) { const int i = kk >> 4, jj = kk & 15; const int tk = (b << 12) + ((rs + i) << 6) + cs + jj;
            o += rdlane(p0, kk) * bf2f(NV[(size_t)tk * 512 + h * 64 + lane]); }
        for (int kk = 0; kk < 64; ++kk) { const int i = 4 + (kk >> 4), jj = kk & 15; const int tk = (b << 12) + ((rs + i) << 6) + cs + jj;
            o += rdlane(p1, kk) * bf2f(NV[(size_t)tk * 512 + h * 64 + lane]); }
        OC[(size_t)t * 1024 + h * 64 + lane] = (bf16)f2bf(o / l);
    }
}
__device__ __forceinline__ void gqa_naive(const bf16* GQ, const bf16* GK, const bf16* GV, bf16* OC, int gw, int NGW, int lane) {
    for (int task = gw; task < T * 8; task += NGW) {
        const int h = task & 7, t = task >> 3, b = t >> 12, kvh = h >> 2;
        const float q = bf2f(GQ[(size_t)t * 512 + h * 64 + lane]);
        float m = -1e30f, l = 0.f, o = 0.f;
        for (int ch = 0; ch < 64; ++ch) {
            const int tk = (b << 12) + ch * 64 + lane;
            const v4u* kp = (const v4u*)(GK + (size_t)tk * 128 + kvh * 64);
            v4u kv[8];
#pragma unroll
            for (int j = 0; j < 8; ++j) kv[j] = kp[j];
            float a = 0.f;
#pragma unroll
            for (int d = 0; d < 64; d += 2) { const unsigned w = kv[d >> 3][(d >> 1) & 3]; a += rdlane(q, d) * bf_lo(w) + rdlane(q, d + 1) * bf_hi(w); }
            const float cm = wave_max(a), mn = fmaxf(m, cm), alpha = exp2f(m - mn), p = exp2f(a - mn);
            l = l * alpha + wave_sum(p); o *= alpha; m = mn;
            const bf16* vp = GV + (size_t)((b << 12) + ch * 64) * 128 + kvh * 64 + lane;
            for (int kk = 0; kk < 64; ++kk) o += rdlane(p, kk) * bf2f(vp[(size_t)kk * 128]);
        }
        OC[(size_t)t * 1024 + 512 + h * 64 + lane] = (bf16)f2bf(o / l);
    }
}
__device__ __forceinline__ void mem_naive(const bf16* QM, const bf16* MK, const bf16* MV, bf16* OM, int gw, int NGW, int lane) {
    for (int task = gw; task < T * 4; task += NGW) {
        const int h = task & 3, t = task >> 2, b = t >> 12;
        const float q0 = bf2f(QM[(size_t)t * 512 + h * 128 + lane]), q1 = bf2f(QM[(size_t)t * 512 + h * 128 + 64 + lane]);
        float s[4];
#pragma unroll
        for (int j = 0; j < 4; ++j) {
            const int row = b * 256 + 64 * j + lane;
            const v4u* kp = (const v4u*)(MK + (size_t)row * 512 + h * 128);
            v4u kv[16];
#pragma unroll
            for (int i = 0; i < 16; ++i) kv[i] = kp[i];
            float a = 0.f;
#pragma unroll
            for (int d = 0; d < 64; d += 2) { const unsigned w = kv[d >> 3][(d >> 1) & 3]; a += rdlane(q0, d) * bf_lo(w) + rdlane(q0, d + 1) * bf_hi(w); }
#pragma unroll
            for (int d = 0; d < 64; d += 2) { const unsigned w = kv[8 + (d >> 3)][(d >> 1) & 3]; a += rdlane(q1, d) * bf_lo(w) + rdlane(q1, d + 1) * bf_hi(w); }
            s[j] = a * QS_M;
        }
        const float m = wave_max(fmaxf(fmaxf(s[0], s[1]), fmaxf(s[2], s[3])));
        float p[4], ps = 0.f;
#pragma unroll
        for (int j = 0; j < 4; ++j) { p[j] = exp2f(s[j] - m); ps += p[j]; }
        const float l = wave_sum(ps);
        float o0 = 0.f, o1 = 0.f;
#pragma unroll
        for (int j = 0; j < 4; ++j) {
            const bf16* vp = MV + (size_t)(b * 256 + 64 * j) * 512 + h * 128 + lane;
            for (int kk = 0; kk < 64; ++kk) { const float pk = rdlane(p[j], kk); o0 += pk * bf2f(vp[(size_t)kk * 512]); o1 += pk * bf2f(vp[(size_t)kk * 512 + 64]); }
        }
        OM[(size_t)t * 512 + h * 128 + lane] = (bf16)f2bf(o0 / l); OM[(size_t)t * 512 + h * 128 + 64 + lane] = (bf16)f2bf(o1 / l);
    }
}
__device__ __forceinline__ void conv_act_pass(const bf16* U, int ntp, int tp0, const float* cw, const float* cb, bf16* ACT, int gtid, int NGT) {
    const int ldu = ntp * 256, nitem = T * ntp * 16;
    for (int it = gtid; it < nitem; it += NGT) {
        const int g8 = it & 15, j = (it >> 4) % ntp, t = (it >> 4) / ntp;
        const int ch = 128 * (tp0 + j) + 8 * g8;
        const bf16* ug = U + (size_t)t * ldu + 256 * j + 8 * g8; const bf16* uv = ug + 128;
        const bool hp = (t & 4095) != 0, hn = (t & 4095) != 4095;
        const v4u z = {0u, 0u, 0u, 0u};
        const v4u g0 = hp ? *(const v4u*)(ug - ldu) : z, g1 = *(const v4u*)ug, g2 = hn ? *(const v4u*)(ug + ldu) : z;
        const v4u v0 = hp ? *(const v4u*)(uv - ldu) : z, v1 = *(const v4u*)uv, v2 = hn ? *(const v4u*)(uv + ldu) : z;
        float r[8];
#pragma unroll
        for (int e = 0; e < 8; ++e) {
            const int c = ch + e; const unsigned sh = e >> 1;
            const float a0 = (e & 1) ? bf_hi(g0[sh]) : bf_lo(g0[sh]), a1 = (e & 1) ? bf_hi(g1[sh]) : bf_lo(g1[sh]), a2 = (e & 1) ? bf_hi(g2[sh]) : bf_lo(g2[sh]);
            const float b0 = (e & 1) ? bf_hi(v0[sh]) : bf_lo(v0[sh]), b1 = (e & 1) ? bf_hi(v1[sh]) : bf_lo(v1[sh]), b2 = (e & 1) ? bf_hi(v2[sh]) : bf_lo(v2[sh]);
            const float gg = a0 * cw[c] + a1 * cw[DFF2 + c] + a2 * cw[2 * DFF2 + c] + cb[c];
            const float vv = b0 * cw[DFF + c] + b1 * cw[DFF2 + DFF + c] + b2 * cw[2 * DFF2 + DFF + c] + cb[DFF + c];
            r[e] = gg / (1.f + __expf(-gg)) * vv;
        }
        v4u o; o.x = pk2(r[0], r[1]); o.y = pk2(r[2], r[3]); o.z = pk2(r[4], r[5]); o.w = pk2(r[6], r[7]);
        *(v4u*)(ACT + (size_t)t * DFF + ch) = o;
    }
}

__device__ __forceinline__ void conv_edge_fix(int pm, const float* EDGE, const float* cw, const float* cb, bf16* ACT, int tid) {
    const f32x4 z = {0.f, 0.f, 0.f, 0.f};
    for (int it = tid; it < 8 * (DFF / 4); it += NTHREADS) {
        const int c4 = it % (DFF / 4), e8 = it / (DFF / 4), blk = pm * 4 + (e8 >> 1), last = e8 & 1, ch = 4 * c4;
        const int row = blk * 64 + (last ? 63 : 0);
        const float* eb = EDGE + (size_t)blk * 4 * DFF2 + ch;
        f32x4 g0, g1, g2, v0, v1, v2;
        if (!last) { const bool hp = (row & 4095) != 0;
            g0 = hp ? *(const f32x4*)(eb - DFF2) : z; v0 = hp ? *(const f32x4*)(eb - DFF2 + DFF) : z;
            g1 = *(const f32x4*)eb; v1 = *(const f32x4*)(eb + DFF); g2 = *(const f32x4*)(eb + DFF2); v2 = *(const f32x4*)(eb + DFF2 + DFF); }
        else { const bool hn = (row & 4095) != 4095;
            g0 = *(const f32x4*)(eb + 2 * DFF2); v0 = *(const f32x4*)(eb + 2 * DFF2 + DFF); g1 = *(const f32x4*)(eb + 3 * DFF2); v1 = *(const f32x4*)(eb + 3 * DFF2 + DFF);
            g2 = hn ? *(const f32x4*)(eb + 4 * DFF2) : z; v2 = hn ? *(const f32x4*)(eb + 4 * DFF2 + DFF) : z; }
        const f32x4 gg = *(const f32x4*)(cw + ch) * g0 + *(const f32x4*)(cw + DFF2 + ch) * g1 + *(const f32x4*)(cw + 2 * DFF2 + ch) * g2 + *(const f32x4*)(cb + ch);
        const f32x4 vv = *(const f32x4*)(cw + DFF + ch) * v0 + *(const f32x4*)(cw + DFF2 + DFF + ch) * v1 + *(const f32x4*)(cw + 2 * DFF2 + DFF + ch) * v2 + *(const f32x4*)(cb + DFF + ch);
        float a[4];
#pragma unroll
        for (int e = 0; e < 4; ++e) a[e] = gg[e] * __builtin_amdgcn_rcpf(1.0f + __builtin_amdgcn_exp2f(gg[e] * -LOG2E)) * vv[e];
        pg8::u32x2 w; w.x = pg8::cvt_pk_bf16(a[0], a[1]); w.y = pg8::cvt_pk_bf16(a[2], a[3]);
        *(pg8::u32x2*)(ACT + (size_t)row * DFF + ch) = w;
    }
}

__device__ __forceinline__ const void* karg(int i) {
    unsigned off = (unsigned)i * 8u; asm volatile("" : "+s"(off));
    return *(const void* const __attribute__((address_space(4)))*)((const char __attribute__((address_space(4)))*)__builtin_amdgcn_kernarg_segment_ptr() + off);
}
#define WSP() ((unsigned char*)karg(20))
#define OUTP() ((float*)karg(19))
#define INP(i) ((const float*)karg(i))
#define WSB(off) ((bf16*)(WSP() + (off)))
#define WSF(off) ((float*)(WSP() + (off)))
__device__ __forceinline__ void convert_item(int l, int r, LAS float* scr, int lane) {
    if (r < I_IN) { p0_transpose_item(INP(3) + (size_t)l * D * NINW, D, NINW, INP(2) + l * D, 1, WSB(WS_WIN) + (size_t)l * NINW * D, scr, r, lane); return; } r -= I_IN;
    if (r < I_OUT) { p0_transpose_item(INP(7) + (size_t)l * D * D, D, D, nullptr, 0, WSB(WS_WOUT) + (size_t)l * D * D, scr, r, lane); return; } r -= I_OUT;
    if (r < I_MQ) { p0_transpose_item(INP(10) + (size_t)l * D * MEMW, D, MEMW, INP(8) + l * D, 0, WSB(WS_WMQ) + (size_t)l * MEMW * D, scr, r, lane); return; } r -= I_MQ;
    if (r < I_MKV) { p0_transpose_item(INP(11) + (size_t)l * D * 1024, D, 1024, INP(9) + l * D, 0, WSB(WS_WMKV) + (size_t)l * 1024 * D, scr, r, lane); return; } r -= I_MKV;
    if (r < I_MO) { p0_transpose_item(INP(12) + (size_t)l * MEMW * D, MEMW, D, nullptr, 0, WSB(WS_WMO) + (size_t)l * D * MEMW, scr, r, lane); return; } r -= I_MO;
    if (r < I_UP) { p0_transpose_item(INP(14) + (size_t)l * D * DFF2, D, DFF2, INP(13) + l * D, 2, WSB(WS_WUP) + (size_t)l * DFF2 * D, scr, r, lane); return; } r -= I_UP;
    p0_transpose_item(INP(17) + (size_t)l * DFF * D, DFF, D, nullptr, 0, WSB(WS_WDN) + (size_t)l * D * DFF, scr, r, lane);
}
struct Ids { int tid, lane, wave, vcu, gw, NGW, gtid, NGT, G, bx; };
__device__ __forceinline__ Ids ids() {
    Ids I; int t = threadIdx.x; asm volatile("" : "+v"(t)); I.tid = t; I.lane = t & 63; I.wave = __builtin_amdgcn_readfirstlane(t >> 6);
    I.G = gridDim.x; I.bx = blockIdx.x; I.vcu = (I.G % 8 == 0) ? (I.bx % 8) * (I.G / 8) + I.bx / 8 : I.bx;
    I.gw = I.vcu * NWAVES + I.wave; I.NGW = I.G * NWAVES; I.gtid = I.vcu * NTHREADS + I.tid; I.NGT = I.G * NTHREADS; return I;
}
__device__ __forceinline__ void grid_bar(LAS unsigned char* L) {
    XcdBarrier b; b.bar = (unsigned*)(WSP() + WS_CTL) + CW_BAR; b.x = xb_xcc_id(); b.st = (volatile LAS unsigned*)(L + MISC_OFF) + 8;
    xcd_barrier(b);
}
__global__ void __launch_bounds__(NTHREADS, 2) mk_fwd(Args args) {
    extern __shared__ __attribute__((aligned(16))) unsigned char lds[];
    LAS unsigned char* L = (LAS unsigned char*)lds;
    {
        const int tid = threadIdx.x;
        for (int u = tid; u < (LDS_BYTES - LDSCTL_OFF) / 4; u += NTHREADS) ((LAS unsigned*)(L + LDSCTL_OFF))[u] = 0u;
        __syncthreads();
        (void)xcd_barrier_post((unsigned*)(WSP() + WS_CTL) + CW_BAR, (volatile LAS unsigned*)(L + MISC_OFF) + 8);
    }
#define GRID_BAR() grid_bar(L)

    {
        const Ids I = ids(); const int lane = I.lane;
        LAS float* scr = (LAS float*)(L + RING_OFF + I.wave * 16896);
        for (int it = I.gw; it < I_IN; it += I.NGW) convert_item(0, it, scr, lane);
        { const float* x_in = INP(0); bf16* XB = WSB(WS_XB); float* SS = WSF(WS_SS);
          for (int m = I.gw; m < T; m += I.NGW) row_to_bf16_ss(x_in + (size_t)m * D, XB + (size_t)m * D, SS + (size_t)m * 16, lane); }
        { const float* mem_in = INP(1); bf16* MXB = WSB(WS_MXB); float* MSS = WSF(WS_MSS);
          for (int m = I.gw; m < MEMT; m += I.NGW) row_to_bf16_ss(mem_in + (size_t)m * D, MXB + (size_t)m * D, MSS + (size_t)m * 16, lane); }
        if (I.bx == 0) { float* ROPE = WSF(WS_ROPE); for (int i = I.tid; i < 1024; i += NTHREADS) { const int pos = i >> 4, f = i & 15;
            const float inv_freq = powf(10000.0f, -(float)f / 16.0f); const float ang = (float)pos * inv_freq;
            ROPE[pos * 32 + f] = cosf(ang); ROPE[pos * 32 + 16 + f] = sinf(ang); } }
    }
    GRID_BAR();

    for (int l = 0; l < 2; ++l) {
        {
            pg8::Gemm g{WSB(WS_XB), WSB(WS_WIN) + (size_t)l * NINW * D, T, NINW, D}; pg8::StaticOrder S; S.init(T, NINW, gridDim.x, blockIdx.x);
            pg8::EpiInProj E{WSF(WS_SS), WSB(WS_NQ), (size_t)T * 512, WSB(WS_GQ), WSB(WS_GK), WSB(WS_GV), WSF(WS_ROPE), INP(5) + l * 64, INP(6) + l * 64, QS_NA, QS_G};
            pg8::gemm_phase<pg8::EpiInProj, pg8::StaticOrder, PG8_ALIGN, PG8_SP2>(L + RING_OFF, g, S, E);
        }
        if (l == 0 && (int)gridDim.x == 256 ? (int)blockIdx.x >= 64 : l == 0) {
            const Ids I = ids(); LAS float* scr = (LAS float*)(L + RING_OFF + I.wave * 16896);
            const int nfw = ((int)gridDim.x == 256 ? 192 : (int)gridDim.x) * NWAVES, fw = ((int)gridDim.x == 256 ? (int)blockIdx.x - 64 : (int)blockIdx.x) * NWAVES + I.wave;
            for (int it = I_IN + fw; it < 2 * I_L; it += nfw) convert_item(it / I_L, it % I_L, scr, I.lane);
        }
        GRID_BAR();
#if NAIVE_NA
        { const Ids I = ids(); na_naive(WSB(WS_NQ), WSB(WS_NK), WSB(WS_NV), WSB(WS_OC), INP(4) + (size_t)l * 8 * 15 * 31, I.gw, I.NGW, I.lane); }
#endif
#if NAIVE_GQA
        { const Ids I = ids(); gqa_naive(WSB(WS_GQ), WSB(WS_GK), WSB(WS_GV), WSB(WS_OC), I.gw, I.NGW, I.lane); }
#else
        { const attn_body::AttnTensors AT{(const attn_body::bf16*)WSB(WS_GQ), (const attn_body::bf16*)WSB(WS_GK), (const attn_body::bf16*)WSB(WS_GV), (attn_body::bf16*)WSB(WS_OC)};
          const attn_body::StaticOrder S((int)gridDim.x, (int)blockIdx.x);
          attn_body::attn_phase<attn_body::StaticOrder>((char*)lds + RING_OFF, AT, S); }
#endif
#if !NAIVE_NA
        {
            const int G_ = gridDim.x, bx_ = blockIdx.x;
            for (int i = 0; i < 1024; ++i) {
                int u;
                if (G_ == 256) { if (i >= 4) break; const int uu = 4 * (bx_ >> 3) + i; u = ((4 * (bx_ & 7) + (uu >> 5)) << 5) + (uu & 31); }
                else { u = bx_ + i * G_; if (u >= 1024) break; }
                const int pair = u >> 5, r0 = 2 * (u & 31);
                na_body::na_unit(pair >> 3, pair & 7, r0, WSB(WS_NQ), WSB(WS_NK), WSB(WS_NV), WSB(WS_OC), INP(4) + ((size_t)l * 8 + (pair & 7)) * 15 * 31, L);
            }
        }
#endif
        GRID_BAR();
        {
            pg8::Gemm g{WSB(WS_OC), WSB(WS_WOUT) + (size_t)l * D * D, T, D, D}; pg8::StaticOrder S; S.init(T, D, gridDim.x, blockIdx.x);
            pg8::EpiRes E{l == 0 ? INP(0) : (const float*)OUTP(), OUTP(), WSB(WS_XB), WSF(WS_SS)};
            pg8::gemm_phase<pg8::EpiRes, pg8::StaticOrder, PG8_ALIGN, PG8_SP2>(L + RING_OFF, g, S, E);
        }
        GRID_BAR();
        {
            pg8::Gemm g{WSB(WS_XB), WSB(WS_WMQ) + (size_t)l * MEMW * D, T, MEMW, D}; pg8::StaticOrder S; S.init(T, MEMW, gridDim.x, blockIdx.x);
            pg8::EpiSB E{WSB(WS_QM), MEMW, WSF(WS_SS), 0, 0, 1.f};
            pg8::gemm_phase<pg8::EpiSB, pg8::StaticOrder, PG8_ALIGN, PG8_SP2>(L + RING_OFF, g, S, E);
        }
        if (l == 0) {
            const int bx_ = blockIdx.x;
            pg8::Gemm g{WSB(WS_MXB), WSB(WS_WMKV), MEMT, 2048, D}; pg8::StaticOrder S; S.init(MEMT, 2048, gridDim.x, bx_ >= 128 ? bx_ - 128 : (1 << 20));
            pg8::EpiSB E{WSB(WS_MKV), MEMW, WSF(WS_MSS), 512, (size_t)MEMT * MEMW, 1.f};
            pg8::gemm_phase<pg8::EpiSB, pg8::StaticOrder, PG8_ALIGN, PG8_SP2>(L + RING_OFF, g, S, E);
        }
        GRID_BAR();
#if NAIVE_MEM
        { const Ids I = ids(); const bf16* MK = WSB(WS_MKV) + (size_t)l * 2 * MEMT * MEMW;
          mem_naive(WSB(WS_QM), MK, MK + (size_t)MEMT * MEMW, WSB(WS_OM), I.gw, I.NGW, I.lane); }
#else
        { const bf16* MK = WSB(WS_MKV) + (size_t)l * 2 * MEMT * MEMW; const bf16* MV = MK + (size_t)MEMT * MEMW;
          for (int u = blockIdx.x; u < 256; u += gridDim.x) {
              const int b = u >> 6, h = (u >> 4) & 3, qb = u & 15; const size_t qoff = (size_t)(b * SEQ + qb * 256) * MEMW + h * 128, koff = (size_t)(b * MEML) * MEMW + h * 128;
              memattn::attn_dense_body<memattn::bf16>((const memattn::bf16*)(WSB(WS_QM) + qoff), (const memattn::bf16*)(MK + koff), (const memattn::bf16*)(MV + koff),
                                                      (memattn::bf16*)(WSB(WS_OM) + qoff), MEML, (char*)lds + RING_OFF);
              __syncthreads(); } }
#endif
        GRID_BAR();
        {
            pg8::Gemm g{WSB(WS_OM), WSB(WS_WMO) + (size_t)l * D * MEMW, T, D, MEMW}; pg8::StaticOrder S; S.init(T, D, gridDim.x, blockIdx.x);
            pg8::EpiRes E{OUTP(), OUTP(), WSB(WS_XB), WSF(WS_SS)};
            pg8::gemm_phase<pg8::EpiRes, pg8::StaticOrder, PG8_ALIGN, PG8_SP2>(L + RING_OFF, g, S, E);
        }
        GRID_BAR();
        {
            pg8::Gemm g{WSB(WS_XB), WSB(WS_WUP) + (size_t)l * DFF2 * D, T, DFF2, D}; pg8::StaticOrder S; S.init(T, DFF2, gridDim.x, blockIdx.x);
            pg8::EpiUpConv E{WSF(WS_SS), INP(15) + (size_t)l * 3 * DFF2, INP(16) + (size_t)l * DFF2, WSB(WS_ACT), WSF(WS_EDGE)};
            pg8::gemm_phase<pg8::EpiUpConv, pg8::StaticOrder, PG8_ALIGN, PG8_SP2>(L + RING_OFF, g, S, E);
        }
        GRID_BAR();
        {
            pg8::StaticOrder S; S.init(T, D, gridDim.x, blockIdx.x); pg8::Unit uu; int tid_ = threadIdx.x; asm volatile("" : "+v"(tid_));
            for (int i = 0; S.next(i, uu); ++i) conv_edge_fix(uu.pm, WSF(WS_EDGE), INP(15) + (size_t)l * 3 * DFF2, INP(16) + (size_t)l * DFF2, WSB(WS_ACT), tid_);
            asm volatile("s_waitcnt vmcnt(0)" ::: "memory"); __syncthreads();
        }
        {
            pg8::Gemm g{WSB(WS_ACT), WSB(WS_WDN) + (size_t)l * D * DFF, T, D, DFF}; pg8::StaticOrder S; S.init(T, D, gridDim.x, blockIdx.x);
            pg8::EpiRes E{OUTP(), OUTP(), WSB(WS_XB), WSF(WS_SS)};
            pg8::gemm_phase<pg8::EpiRes, pg8::StaticOrder, PG8_ALIGN, PG8_SP2>(L + RING_OFF, g, S, E);
        }
        GRID_BAR();
    }
    {
        const Ids I = ids(); const int lane = I.lane;
        const float* gf = INP(18); float* X = OUTP();
        for (int m = I.gw; m < T; m += I.NGW) {
            GAS f32x4* xr = (GAS f32x4*)(X + (size_t)m * D) + lane;
            f32x4 v[4]; float s = 0.f;
#pragma unroll
            for (int j = 0; j < 4; ++j) { v[j] = xr[64 * j]; s += (v[j].x * v[j].x + v[j].y * v[j].y) + (v[j].z * v[j].z + v[j].w * v[j].w); }
            const float rs = 1.0f / sqrtf(wave_sum(s) * (1.0f / D) + 1e-6f);
#pragma unroll
            for (int j = 0; j < 4; ++j) { const f32x4 gg = *((const f32x4*)gf + lane + 64 * j); xr[64 * j] = v[j] * rs * gg; }
        }
    }
}

extern "C" void kernel_launch(void* const* d_in, const int* in_sizes, int n_in, void* d_out, int out_size, void* d_ws, size_t ws_size, hipStream_t stream) {
    static int grid = 0;
    if (grid == 0) {
        if (n_in != 19 || in_sizes[0] != T * D || out_size != T * D || ws_size < WS_END) { fprintf(stderr, "kernel_launch: shape mismatch n_in %d in0 %d out %d ws %zu\n", n_in, n_in > 0 ? in_sizes[0] : -1, out_size, ws_size); grid = -1; return; }
        int dev = 0, cus = 0;
        if (hipGetDevice(&dev) != hipSuccess || hipDeviceGetAttribute(&cus, hipDeviceAttributeMultiprocessorCount, dev) != hipSuccess) { grid = -1; return; }
        if (hipFuncSetAttribute((const void*)mk_fwd, hipFuncAttributeMaxDynamicSharedMemorySize, LDS_BYTES) != hipSuccess) { fprintf(stderr, "kernel_launch: hipFuncSetAttribute failed\n"); grid = -1; return; }
        int per_cu = 0;
        if (hipOccupancyMaxActiveBlocksPerMultiprocessor(&per_cu, (const void*)mk_fwd, NTHREADS, LDS_BYTES) != hipSuccess || per_cu < 1) fprintf(stderr, "kernel_launch: occupancy query says %d\n", per_cu);
        (void)hipGetLastError();
        grid = cus;
    }
    if (grid < 0) return;
    if (hipMemsetAsync((char*)d_ws + WS_CTL, 0, CTL_ZERO_BYTES, stream) != hipSuccess) { fprintf(stderr, "kernel_launch: memset failed\n"); return; }
    Args a{};
    for (int i = 0; i < 19; ++i) a.in[i] = (const float*)d_in[i];
    a.out = (float*)d_out; a.ws = (unsigned char*)d_ws;
    hipLaunchKernelGGL(mk_fwd, dim3(grid), dim3(NTHREADS), LDS_BYTES, stream, a);
    const hipError_t le = hipPeekAtLastError();
    if (le != hipSuccess) fprintf(stderr, "kernel_launch: launch failed: %s\n", hipGetErrorName(le));
}
```
